# Optimizing an MI355X kernel written in HIP

```python
import jax, jax.numpy as jnp
from jax import lax
import numpy as np

D_MODEL = 1024
BATCH = 8
SEQ = 4096
DEPTH = 2

SB_HEADS = 8
SB_HEAD_DIM = 64
SB_WIDTH = SB_HEADS * SB_HEAD_DIM
SB_BLOCK = 128
SG_GROUPS = 8
SG_GROUP_DIM = 64
SG_WIDTH = SG_GROUPS * SG_GROUP_DIM
SG_CHUNK = 128
GLA_HEADS = 4
GLA_DK = 64
GLA_DV = 128
GLA_KW = GLA_HEADS * GLA_DK
GLA_VW = GLA_HEADS * GLA_DV
GLA_GATE_RANK = 16
GLA_GATE_NORM = 16.0
GLA_CHUNK = 64
D_FF = 2816
CONV_W = 3
N_BRANCH = 3
EPS = 1e-6

IN_SPLITS = (SB_WIDTH, SB_WIDTH, SB_WIDTH,
             SG_WIDTH, SG_WIDTH,
             GLA_KW, GLA_KW, GLA_VW, GLA_VW,
             GLA_GATE_RANK,
             N_BRANCH * D_MODEL)
IN_WIDTH = sum(IN_SPLITS)
SPLIT_POINTS = tuple(int(p) for p in np.cumsum(IN_SPLITS)[:-1])

kernel_name = "hybrid_sb_sgmlp_gla_convffn"


def rmsnorm(x, g):
    x32 = x.astype(jnp.float32)
    y = x32 * lax.rsqrt(jnp.mean(x32 * x32, axis=-1, keepdims=True) + EPS) * g.astype(jnp.float32)
    return y.astype(x.dtype)


def split_heads(t, n_heads):
    b, s, w = t.shape
    return t.reshape(b, s, n_heads, w // n_heads).transpose(0, 2, 1, 3)


def merge_heads(t):
    b, h, s, d = t.shape
    return t.transpose(0, 2, 1, 3).reshape(b, s, h * d)


def stick_breaking_attention(q, k, v):
    seq = q.shape[2]
    scale = SB_HEAD_DIM ** -0.5
    outs = []
    for i in range(seq // SB_BLOCK):
        end = (i + 1) * SB_BLOCK
        qb = q[:, :, i * SB_BLOCK:end].astype(jnp.float32)
        kb = k[:, :, :end].astype(jnp.float32)
        vb = v[:, :, :end].astype(jnp.float32)
        z = jnp.einsum('bhtd,bhsd->bhts', qb, kb) * scale
        t_pos = i * SB_BLOCK + jnp.arange(SB_BLOCK)
        s_pos = jnp.arange(end)
        mask = s_pos[None, :] < t_pos[:, None]
        log_1m = jnp.where(mask, jax.nn.log_sigmoid(-z), 0.0)
        tail = lax.cumsum(log_1m, axis=3, reverse=True) - log_1m
        w = jnp.where(mask, jnp.exp(jax.nn.log_sigmoid(z) + tail), 0.0)
        outs.append(jnp.einsum('bhts,bhsd->bhtd', w, vb))
    return jnp.concatenate(outs, axis=2).astype(q.dtype)


def chunked_spatial_gating(u, v, ln_g, ln_b, w_s, b_s):
    b, s, _ = u.shape
    v32 = v.astype(jnp.float32)
    mu = jnp.mean(v32, axis=-1, keepdims=True)
    var = jnp.mean(jnp.square(v32 - mu), axis=-1, keepdims=True)
    vn = (v32 - mu) * lax.rsqrt(var + EPS) * ln_g.astype(jnp.float32) + ln_b.astype(jnp.float32)
    vn = vn.reshape(b, s // SG_CHUNK, SG_CHUNK, SG_GROUPS, SG_GROUP_DIM)
    causal = jnp.tril(jnp.ones((SG_CHUNK, SG_CHUNK), dtype=bool))
    w = jnp.where(causal[None], w_s.astype(jnp.float32), 0.0)
    sp = jnp.einsum('gts,bnsgd->bntgd', w, vn) + b_s.astype(jnp.float32).T[None, None, :, :, None]
    return (u.astype(jnp.float32) * sp.reshape(b, s, SG_WIDTH)).astype(u.dtype)


def gla_chunked(q, k, v, log_a):
    b, h, s, dk = q.shape
    dv = v.shape[-1]
    n, c = s // GLA_CHUNK, GLA_CHUNK
    q, k, log_a = (t.reshape(b, h, n, c, dk) for t in (q, k, log_a))
    v = v.reshape(b, h, n, c, dv)
    cum = jnp.cumsum(log_a, axis=3)
    cum_last = cum[:, :, :, -1:]
    q_dec = q * jnp.exp(cum)
    k_inv = k * jnp.exp(-cum)
    k_to_end = k * jnp.exp(cum_last - cum)
    causal = jnp.tril(jnp.ones((c, c), dtype=bool))
    attn = jnp.where(causal, jnp.einsum('bhntk,bhnsk->bhnts', q_dec, k_inv), 0.0)
    o_intra = jnp.einsum('bhnts,bhnsv->bhntv', attn, v)
    chunk_upd = jnp.einsum('bhnsk,bhnsv->bhnkv', k_to_end, v)
    chunk_dec = jnp.exp(cum_last[:, :, :, 0])

    def step(state, inp):
        dec, upd = inp
        return dec[..., None] * state + upd, state

    _, states_before = lax.scan(step, jnp.zeros((b, h, dk, dv), jnp.float32),
                                (jnp.moveaxis(chunk_dec, 2, 0), jnp.moveaxis(chunk_upd, 2, 0)))
    states_before = jnp.moveaxis(states_before, 0, 2)
    o_inter = jnp.einsum('bhntk,bhnkv->bhntv', q_dec, states_before)
    return (o_intra + o_inter).reshape(b, h, s, dv)


def hybrid_mixer(xn, w_in, sg_ln_g, sg_ln_b, sg_w, sg_b, gla_w_gup, gla_b_gate, gla_norm_g,
                 p_a, p_b, p_c, w_out):
    b, s, _ = xn.shape
    proj = xn @ w_in
    (sb_q, sb_k, sb_v, sg_u, sg_v, g_q, g_k, g_v, g_r, g_down, gates) = jnp.split(proj, SPLIT_POINTS, axis=-1)

    y_a = merge_heads(stick_breaking_attention(split_heads(sb_q, SB_HEADS), split_heads(sb_k, SB_HEADS),
                                               split_heads(sb_v, SB_HEADS)))
    y_b = chunked_spatial_gating(jax.nn.gelu(sg_u), jax.nn.gelu(sg_v), sg_ln_g, sg_ln_b, sg_w, sg_b)
    log_a = jax.nn.log_sigmoid((g_down @ gla_w_gup + gla_b_gate).astype(jnp.float32)) / GLA_GATE_NORM
    o = gla_chunked(split_heads(g_q.astype(jnp.float32), GLA_HEADS) * (GLA_DK ** -0.5),
                    split_heads(g_k.astype(jnp.float32), GLA_HEADS),
                    split_heads(g_v.astype(jnp.float32), GLA_HEADS),
                    split_heads(log_a, GLA_HEADS))
    o = o * lax.rsqrt(jnp.mean(o * o, axis=-1, keepdims=True) + EPS) * gla_norm_g.astype(jnp.float32)
    y_c = (merge_heads(o) * jax.nn.silu(g_r.astype(jnp.float32))).astype(xn.dtype)

    g = jax.nn.sigmoid(gates).reshape(b, s, N_BRANCH, D_MODEL)
    merged = g[:, :, 0] * (y_a @ p_a) + g[:, :, 1] * (y_b @ p_b) + g[:, :, 2] * (y_c @ p_c)
    return merged @ w_out


def conv_gated_ffn(xn, w_up, conv_w, conv_b, w_down):
    s = xn.shape[1]
    hid = xn @ w_up
    hp = jnp.pad(hid, ((0, 0), (CONV_W - 1, 0), (0, 0)))
    conv = conv_b + hp[:, 0:s] * conv_w[0]
    for j in range(1, CONV_W):
        conv = conv + hp[:, j:j + s] * conv_w[j]
    a, u = jnp.split(conv, 2, axis=-1)
    return (jax.nn.gelu(a, approximate=True) * u) @ w_down


def setup_inputs(seed: int = 0) -> dict:
    key = jax.random.key(seed)
    ks = jax.random.split(key, 24)
    f32 = jnp.float32
    nrm = lambda k, shape, scale: jax.random.normal(k, shape, f32) * scale
    gain = lambda k, shape: 1.0 + 0.02 * jax.random.normal(k, shape, f32)
    L = DEPTH
    return {
        "x": jax.random.normal(ks[0], (BATCH, SEQ, D_MODEL), f32),
        "mix_pre_g": gain(ks[1], (L, D_MODEL)),
        "mix_post_g": gain(ks[2], (L, D_MODEL)),
        "w_in": nrm(ks[3], (L, D_MODEL, IN_WIDTH), D_MODEL ** -0.5),
        "sg_ln_g": gain(ks[4], (L, SG_WIDTH)),
        "sg_ln_b": nrm(ks[5], (L, SG_WIDTH), 0.02),
        "sg_w": nrm(ks[6], (L, SG_GROUPS, SG_CHUNK, SG_CHUNK), SG_CHUNK ** -0.5),
        "sg_b": 1.0 + nrm(ks[7], (L, SG_GROUPS, SG_CHUNK), 0.01),
        "gla_w_gup": nrm(ks[8], (L, GLA_GATE_RANK, GLA_KW), GLA_GATE_RANK ** -0.5),
        "gla_b_gate": nrm(ks[9], (L, GLA_KW), 0.1),
        "gla_norm_g": gain(ks[10], (L, GLA_DV)),
        "p_a": nrm(ks[11], (L, SB_WIDTH, D_MODEL), SB_WIDTH ** -0.5),
        "p_b": nrm(ks[12], (L, SG_WIDTH, D_MODEL), SG_WIDTH ** -0.5),
        "p_c": nrm(ks[13], (L, GLA_VW, D_MODEL), GLA_VW ** -0.5),
        "w_out": nrm(ks[14], (L, D_MODEL, D_MODEL), D_MODEL ** -0.5),
        "ffn_pre_g": gain(ks[15], (L, D_MODEL)),
        "ffn_post_g": gain(ks[16], (L, D_MODEL)),
        "ffn_w_up": nrm(ks[17], (L, D_MODEL, 2 * D_FF), D_MODEL ** -0.5),
        "ffn_conv_w": nrm(ks[18], (L, CONV_W, 2 * D_FF), CONV_W ** -0.5),
        "ffn_conv_b": nrm(ks[19], (L, 2 * D_FF), 0.02),
        "ffn_w_down": nrm(ks[20], (L, D_FF, D_MODEL), D_FF ** -0.5),
    }


def reference(x, mix_pre_g, mix_post_g, w_in, sg_ln_g, sg_ln_b, sg_w, sg_b, gla_w_gup, gla_b_gate,
              gla_norm_g, p_a, p_b, p_c, w_out, ffn_pre_g, ffn_post_g, ffn_w_up, ffn_conv_w,
              ffn_conv_b, ffn_w_down):
    h = x
    for l in range(DEPTH):
        y = hybrid_mixer(rmsnorm(h, mix_pre_g[l]), w_in[l], sg_ln_g[l], sg_ln_b[l], sg_w[l], sg_b[l],
                         gla_w_gup[l], gla_b_gate[l], gla_norm_g[l], p_a[l], p_b[l], p_c[l], w_out[l])
        h = h + rmsnorm(y, mix_post_g[l])
        y = conv_gated_ffn(rmsnorm(h, ffn_pre_g[l]), ffn_w_up[l], ffn_conv_w[l], ffn_conv_b[l], ffn_w_down[l])
        h = h + rmsnorm(y, ffn_post_g[l])
    return h
```

```cpp
#include <hip/hip_runtime.h>
#include <hip/hip_cooperative_groups.h>
#include <cstdio>
#include <cstdint>
namespace cg = cooperative_groups;

#define LAS __attribute__((address_space(3)))
typedef unsigned short bf16_t;
typedef short bf16x8 __attribute__((ext_vector_type(8)));
typedef float f32x4 __attribute__((ext_vector_type(4)));
typedef unsigned u32x4 __attribute__((ext_vector_type(4)));
typedef unsigned u32x2 __attribute__((ext_vector_type(2)));

constexpr int BATCH = 8, SEQ = 4096, DM = 1024, MTOK = BATCH * SEQ;
constexpr int INW = 7184, DFF = 2816, DFF2 = 5632;
constexpr float EPS = 1e-6f;
constexpr float SB_THR = -106.0f;

constexpr size_t MiB = 1u << 20;
constexpr size_t WS_GDOWN = 1 * MiB;
constexpr size_t WS_DEC = 3 * MiB;
constexpr size_t WS_WIN = 4 * MiB;
constexpr size_t WS_WP = 19 * MiB;
constexpr size_t WS_WOUT = 22 * MiB;
constexpr size_t WS_WUP = 24 * MiB;
constexpr size_t WS_WDN = 35 * MiB;
constexpr size_t WS_XN = 41 * MiB;
constexpr size_t WS_QA = 105 * MiB, WS_U = 137 * MiB, WS_GR = 169 * MiB;
constexpr size_t WS_KA = 201 * MiB, WS_VA = 233 * MiB, WS_SV = 265 * MiB, WS_GV = 297 * MiB;
constexpr size_t WS_GQ = 329 * MiB, WS_GK = 345 * MiB;
constexpr size_t WS_UPD = 361 * MiB;
constexpr size_t WS_GATES = 201 * MiB;
constexpr size_t WS_Y32 = 105 * MiB;
constexpr size_t WS_ACT = 105 * MiB;
constexpr size_t WS_HEAD = 282 * MiB;
constexpr size_t WS_TAIL = 288 * MiB;
constexpr size_t WS_Y32B = 300 * MiB;
constexpr size_t WS_END = 428 * MiB;

constexpr int LDS_BYTES = 147456;
constexpr int XT_OFF = 131072;

typedef float f32x2_t __attribute__((ext_vector_type(2)));
typedef __bf16 bf16x2_t __attribute__((ext_vector_type(2)));
__device__ __forceinline__ unsigned cvt_pk_bf16(float lo, float hi) { const f32x2_t v = {lo, hi}; const bf16x2_t b = __builtin_convertvector(v, bf16x2_t); return __builtin_bit_cast(unsigned, b); }
__device__ __forceinline__ float bf2f(unsigned short h) { return __uint_as_float(((unsigned)h) << 16); }
__device__ __forceinline__ float bflo(unsigned w) { return __uint_as_float(w << 16); }
__device__ __forceinline__ float bfhi(unsigned w) { return __uint_as_float(w & 0xffff0000u); }
__device__ __forceinline__ unsigned short f2bf(float f) { return (unsigned short)(cvt_pk_bf16(f, 0.f) & 0xffffu); }
__device__ __forceinline__ bf16x8 pack8(f32x4 a, f32x4 b) {
    u32x4 w; w.x = cvt_pk_bf16(a[0], a[1]); w.y = cvt_pk_bf16(a[2], a[3]); w.z = cvt_pk_bf16(b[0], b[1]); w.w = cvt_pk_bf16(b[2], b[3]);
    return __builtin_bit_cast(bf16x8, w);
}
__device__ __forceinline__ float rcpf_(float x) { return __builtin_amdgcn_rcpf(x); }
__device__ __forceinline__ float gelu_tanh_f(float x) { const float u = 0.7978845608f * (x + 0.044715f * x * x * x); return x * rcpf_(1.f + __expf(-2.f * u)); }
__device__ __forceinline__ float sigmoid_f(float x) { return rcpf_(1.f + __expf(-x)); }
__device__ __forceinline__ float logsig_f(float x) { return fminf(x, 0.f) - __logf(1.f + __expf(-fabsf(x))); }
__device__ __forceinline__ f32x4 mfma16(bf16x8 a, bf16x8 b, f32x4 c) { return __builtin_amdgcn_mfma_f32_16x16x32_bf16(a, b, c, 0, 0, 0); }
__device__ __forceinline__ float wave_sum(float v) {
#pragma unroll
    for (int o = 1; o < 64; o <<= 1) v += __shfl_xor(v, o);
    return v;
}
#define LDS_WAIT() asm volatile("s_waitcnt lgkmcnt(0)" ::: "memory")
template <class T> __device__ __forceinline__ T* launder(T* p) { asm volatile("" : "+s"(p)); return p; }
__device__ __forceinline__ int vlaunder(int x) { asm volatile("" : "+v"(x)); return x; }
__device__ __forceinline__ float dpp_shr1(float v) { return __builtin_bit_cast(float, __builtin_amdgcn_update_dpp(0, __builtin_bit_cast(int, v), 0x111, 0xf, 0xf, true)); }
__device__ __forceinline__ float dpp_shr2(float v) { return __builtin_bit_cast(float, __builtin_amdgcn_update_dpp(0, __builtin_bit_cast(int, v), 0x112, 0xf, 0xf, true)); }
__device__ __forceinline__ float dpp_shl14(float v) { return __builtin_bit_cast(float, __builtin_amdgcn_update_dpp(0, __builtin_bit_cast(int, v), 0x10E, 0xf, 0xf, true)); }
__device__ __forceinline__ float dpp_shl15(float v) { return __builtin_bit_cast(float, __builtin_amdgcn_update_dpp(0, __builtin_bit_cast(int, v), 0x10F, 0xf, 0xf, true)); }

struct Params {
    const float* x; const float* mix_pre_g; const float* mix_post_g; const float* w_in; const float* sg_ln_g; const float* sg_ln_b; const float* sg_w; const float* sg_b;
    const float* gla_w_gup; const float* gla_b_gate; const float* gla_norm_g; const float* p_a; const float* p_b; const float* p_c; const float* w_out;
    const float* ffn_pre_g; const float* ffn_post_g; const float* ffn_w_up; const float* ffn_conv_w; const float* ffn_conv_b; const float* ffn_w_down;
    float* out; unsigned char* ws;
};

namespace pg8 {
constexpr int BM = 256, BK = 64, HALF = 128, HTB = HALF * BK * 2, NXCD = 8, WGM = 8;
__device__ __forceinline__ int lds_byte(int r, int c) { const int st = (r >> 4) * 2 + (c >> 5), rr = r & 15, cc = c & 31, ob = rr * 64 + cc * 2; return st * 1024 + (ob ^ (((ob >> 9) & 1) << 5)); }
__device__ __forceinline__ void stage_rc(int b, int& R, int& C) { const int st = b / 1024, sb = b % 1024, swz = sb ^ (((sb >> 9) & 1) << 5); R = (st >> 1) * 16 + swz / 64; C = (st & 1) * 32 + (swz % 64) / 2; }
__device__ __forceinline__ int perm32(int rho) { const int n = rho >> 4, i = rho & 15; return 8 * (i >> 2) + 4 * n + (i & 3); }

struct Unit { int pm, pn; };
struct Gemm { const bf16_t* A; const bf16_t* Bt; int K, lda, ldb, adiv; size_t astride; };

struct StaticOrder {
    int nM, nN, nwg, G, c;
    __device__ __forceinline__ void init(int M, int N, int G_, int c_) { nM = M / BM; nN = N / BM; nwg = nM * nN; G = G_; c = c_; }
    __device__ __forceinline__ bool next(int i, Unit& u) const {
        const long L = (long)i * G + c; if (L >= nwg) return false;
        int wgid = (int)L; { const int q = nwg / NXCD, r = nwg % NXCD, xcd = wgid % NXCD, off = wgid / NXCD; wgid = (xcd < r ? xcd * (q + 1) : r * (q + 1) + (xcd - r) * q) + off; }
        const int nig = WGM * nN, gid = wgid / nig, fm = gid * WGM, gsz = (nM - fm) < WGM ? (nM - fm) : WGM;
        u.pm = fm + ((wgid % nig) % gsz); u.pn = (wgid % nig) / gsz; return true;
    }
};
struct MergeOrder {
    StaticOrder base;
    __device__ __forceinline__ bool next(int i, Unit& u) const { const int br = i % 3; Unit t; if (!base.next(i / 3, t)) return false; u.pm = t.pm; u.pn = t.pn + 4 * br; return true; }
};

template <class Epi, class Sched>
__device__ __forceinline__ void gemm_phase(LAS unsigned char* lds, const Gemm g, const Sched& S, const Epi& E) {
    const int tid = vlaunder((int)threadIdx.x), wid = __builtin_amdgcn_readfirstlane(tid >> 6), lane = tid & 63, wr = wid >> 2, wc = wid & 3, fr = lane & 15, fq = lane >> 4;
    const int K = g.K, nt = K / BK;
    unsigned voffA[2], voffB[2];
#pragma unroll
    for (int i = 0; i < 2; ++i) { int R, C; stage_rc(tid * 16 + i * 8192, R, C); const int Rb = Epi::PERM ? ((R & ~31) + perm32(R & 31)) : R;
        voffA[i] = (unsigned)(R * g.lda + C) * 2u; voffB[i] = (unsigned)(Rb * g.ldb + C) * 2u; }
    const size_t kstep = (size_t)(BK * 2);
    const size_t hstepA = (size_t)HALF * g.lda * 2, hstepB = (size_t)HALF * g.ldb * 2;
    const size_t tstepA = 2 * hstepA, tstepB = 2 * hstepB;
    const unsigned ldsw = (unsigned)wid * 1024u;
    const int aoff = lds_byte(wr * 64 + fr, fq * 8), boff = lds_byte(wc * 32 + fr, fq * 8);
#define PG8_SA(b, h) (((b) * 2 + (h)) * HTB)
#define PG8_SB(b, h) ((4 + (b) * 2 + (h)) * HTB)
#define PG8_STAGE(bufoff, gbase, voff) do { _Pragma("unroll") for (int _i = 0; _i < 2; ++_i) \
        __builtin_amdgcn_global_load_lds((const unsigned*)((const char*)(gbase) + (voff)[_i]), (LAS unsigned*)(lds + (bufoff) + ldsw + _i * 8192), 16, 0, 0); } while (0)
#define PG8_LDA(dst, b, h) do { _Pragma("unroll") for (int m = 0; m < 4; ++m) _Pragma("unroll") for (int k = 0; k < 2; ++k) dst[m][k] = *(const LAS bf16x8*)(lds + PG8_SA(b, h) + aoff + m * 2048 + k * 1024); } while (0)
#define PG8_LDB(dst, b, h) do { _Pragma("unroll") for (int n = 0; n < 2; ++n) _Pragma("unroll") for (int k = 0; k < 2; ++k) dst[n][k] = *(const LAS bf16x8*)(lds + PG8_SB(b, h) + boff + n * 2048 + k * 1024); } while (0)
#define PG8_MMA(ai, bj, At, Bt) do { __builtin_amdgcn_s_setprio(1); _Pragma("unroll") for (int m = 0; m < 4; ++m) _Pragma("unroll") for (int n = 0; n < 2; ++n) _Pragma("unroll") for (int k = 0; k < 2; ++k) \
        acc[ai][bj][m][n] = __builtin_amdgcn_mfma_f32_16x16x32_bf16(Bt[n][k], At[m][k], acc[ai][bj][m][n], 0, 0, 0); __builtin_amdgcn_s_setprio(0); } while (0)
#define PG8_WAIT_V(n) asm volatile("s_waitcnt vmcnt(" #n ")" ::: "memory")
#define PG8_WAIT_L(n) asm volatile("s_waitcnt lgkmcnt(" #n ")" ::: "memory")
#define PG8_BAR __builtin_amdgcn_s_barrier()
#define PG8_SCHED __builtin_amdgcn_sched_barrier(0)
    Unit cur, nxt; int ui = 0;
    if (!S.next(0, cur)) return;
    f32x4 acc[2][2][4][2];
#pragma unroll
    for (int a = 0; a < 2; ++a)
#pragma unroll
        for (int b = 0; b < 2; ++b)
#pragma unroll
            for (int m = 0; m < 4; ++m)
#pragma unroll
                for (int n = 0; n < 2; ++n) acc[a][b][m][n] = (f32x4){0.f, 0.f, 0.f, 0.f};
    bf16x8 At[4][2], B0[2][2], B1[2][2];
    const char* cA = (const char*)g.A + (size_t)cur.pm * tstepA + (g.adiv ? (size_t)(cur.pn / g.adiv) * g.astride : 0);
    const char* cB = (const char*)g.Bt + (size_t)cur.pn * tstepB;
    PG8_STAGE(PG8_SB(0, 0), cB, voffB); PG8_STAGE(PG8_SB(0, 1), cB + hstepB, voffB); PG8_STAGE(PG8_SA(0, 0), cA, voffA); PG8_STAGE(PG8_SA(0, 1), cA + hstepA, voffA);
    if (wr == 1) PG8_BAR;
    PG8_WAIT_V(2); PG8_BAR;
    PG8_STAGE(PG8_SB(1, 0), cB + kstep, voffB); PG8_STAGE(PG8_SA(1, 0), cA + kstep, voffA); PG8_STAGE(PG8_SB(1, 1), cB + hstepB + kstep, voffB);
    PG8_WAIT_V(6); PG8_BAR;
    for (;;) {
        const bool has_next = S.next(ui + 1, nxt);
        const char* nA = has_next ? (const char*)g.A + (size_t)nxt.pm * tstepA + (g.adiv ? (size_t)(nxt.pn / g.adiv) * g.astride : 0) : cA;
        const char* nB = has_next ? (const char*)g.Bt + (size_t)nxt.pn * tstepB : cB;
        for (int t = 0; t < nt; t += 2) {
            const bool last = (t == nt - 2);
            const char* a1 = cA + (size_t)(t + 1) * kstep;
            const char* a2 = last ? nA : cA + (size_t)(t + 2) * kstep; const char* b2 = last ? nB : cB + (size_t)(t + 2) * kstep;
            const char* a3 = a2 + kstep; const char* b3 = b2 + kstep;
            PG8_LDB(B0, 0, 0); PG8_LDB(B1, 0, 1); PG8_SCHED; PG8_LDA(At, 0, 0); PG8_STAGE(PG8_SA(1, 1), a1 + hstepA, voffA);
            PG8_WAIT_V(8); PG8_WAIT_L(0); PG8_BAR; PG8_MMA(0, 0, At, B0); PG8_MMA(0, 1, At, B1); PG8_BAR; PG8_SCHED;
            PG8_LDA(At, 0, 1); PG8_STAGE(PG8_SB(0, 0), b2, voffB); PG8_STAGE(PG8_SB(0, 1), b2 + hstepB, voffB); PG8_STAGE(PG8_SA(0, 0), a2, voffA);
            PG8_WAIT_V(8); PG8_WAIT_L(0); PG8_BAR; PG8_MMA(1, 0, At, B0); PG8_MMA(1, 1, At, B1); PG8_BAR; PG8_SCHED;
            PG8_LDB(B0, 1, 0); PG8_LDB(B1, 1, 1); PG8_SCHED; PG8_LDA(At, 1, 0); PG8_STAGE(PG8_SA(0, 1), a2 + hstepA, voffA);
            PG8_WAIT_V(8); PG8_WAIT_L(0); PG8_BAR; PG8_MMA(0, 0, At, B0); PG8_MMA(0, 1, At, B1); PG8_BAR; PG8_SCHED;
            PG8_LDA(At, 1, 1); PG8_STAGE(PG8_SB(1, 0), b3, voffB); PG8_STAGE(PG8_SB(1, 1), b3 + hstepB, voffB); PG8_STAGE(PG8_SA(1, 0), a3, voffA);
            PG8_WAIT_V(8); PG8_WAIT_L(0); PG8_BAR; PG8_MMA(1, 0, At, B0); PG8_MMA(1, 1, At, B1); PG8_BAR; PG8_SCHED;
        }
        if (wr == 0) PG8_BAR;
        E(acc, cur, wr, wc, fr, fq, lds);
        if (!has_next) break;
#pragma unroll
        for (int a = 0; a < 2; ++a)
#pragma unroll
            for (int b = 0; b < 2; ++b)
#pragma unroll
                for (int m = 0; m < 4; ++m)
#pragma unroll
                    for (int n = 0; n < 2; ++n) acc[a][b][m][n] = (f32x4){0.f, 0.f, 0.f, 0.f};
        cur = nxt; cA = nA; cB = nB; ++ui;
        if (wr == 1) PG8_BAR;
    }
    PG8_WAIT_V(0);
    PG8_BAR;
#undef PG8_SA
#undef PG8_SB
#undef PG8_STAGE
#undef PG8_LDA
#undef PG8_LDB
#undef PG8_MMA
#undef PG8_WAIT_V
#undef PG8_WAIT_L
#undef PG8_BAR
#undef PG8_SCHED
}

typedef const f32x4 (&AccRef)[2][2][4][2];

struct EpiG1 {
    static constexpr bool PERM = true;
    unsigned char* ws;
    __device__ __forceinline__ void operator()(f32x4 (&acc)[2][2][4][2], const Unit& u, int wr, int wc, int fr, int fq, LAS unsigned char*) const {
        const int pn = u.pn;
        const int row0 = u.pm * BM + wr * 64 + fr;
        if (pn == 16) {
            if (wc == 0 && fq < 2) { float* G = (float*)(ws + WS_GDOWN);
#pragma unroll
                for (int ai = 0; ai < 2; ++ai)
#pragma unroll
                    for (int m = 0; m < 4; ++m)
#pragma unroll
                        for (int n = 0; n < 2; ++n) *(f32x4*)(G + (size_t)(row0 + ai * HALF + m * 16) * 16 + 8 * fq + 4 * n) = acc[ai][0][m][n]; }
            return;
        }
        size_t off; int ldc = 512, colt, act = 0;
        if (pn < 2) { off = WS_QA; colt = pn * 256; }
        else if (pn < 4) { off = WS_KA; colt = (pn - 2) * 256; }
        else if (pn < 6) { off = WS_VA; colt = (pn - 4) * 256; }
        else if (pn < 8) { off = WS_U; colt = (pn - 6) * 256; act = 1; }
        else if (pn < 10) { off = WS_SV; colt = (pn - 8) * 256; act = 1; }
        else if (pn == 10) { off = WS_GQ; colt = 0; ldc = 256; }
        else if (pn == 11) { off = WS_GK; colt = 0; ldc = 256; }
        else if (pn < 14) { off = WS_GV; colt = (pn - 12) * 256; }
        else { off = WS_GR; colt = (pn - 14) * 256; act = 2; }
        bf16_t* base = (bf16_t*)(ws + off);
        const int col0 = colt + wc * 32 + 8 * fq;
#pragma unroll
        for (int ai = 0; ai < 2; ++ai)
#pragma unroll
            for (int m = 0; m < 4; ++m) { bf16_t* rowp = base + (size_t)(row0 + ai * HALF + m * 16) * ldc + col0;
#pragma unroll
                for (int bj = 0; bj < 2; ++bj) { f32x4 v0 = acc[ai][bj][m][0], v1 = acc[ai][bj][m][1];
                    if (act == 1) {
#pragma unroll
                        for (int e = 0; e < 4; ++e) { v0[e] = gelu_tanh_f(v0[e]); v1[e] = gelu_tanh_f(v1[e]); }
                    } else if (act == 2) {
#pragma unroll
                        for (int e = 0; e < 4; ++e) { v0[e] = v0[e] * sigmoid_f(v0[e]); v1[e] = v1[e] * sigmoid_f(v1[e]); }
                    }
                    u32x4 w; w.x = cvt_pk_bf16(v0[0], v0[1]); w.y = cvt_pk_bf16(v0[2], v0[3]); w.z = cvt_pk_bf16(v1[0], v1[1]); w.w = cvt_pk_bf16(v1[2], v1[3]);
                    *(u32x4*)(rowp + bj * HALF) = w; } }
    }
};
struct EpiGates {
    static constexpr bool PERM = true;
    bf16_t* O;
    __device__ __forceinline__ void operator()(f32x4 (&acc)[2][2][4][2], const Unit& u, int wr, int wc, int fr, int fq, LAS unsigned char*) const {
        const int row0 = u.pm * BM + wr * 64 + fr, col0 = u.pn * BM + wc * 32 + 8 * fq;
#pragma unroll
        for (int ai = 0; ai < 2; ++ai)
#pragma unroll
            for (int m = 0; m < 4; ++m) { bf16_t* rowp = O + (size_t)(row0 + ai * HALF + m * 16) * 3072 + col0;
#pragma unroll
                for (int bj = 0; bj < 2; ++bj) { f32x4 v0 = acc[ai][bj][m][0], v1 = acc[ai][bj][m][1];
#pragma unroll
                    for (int e = 0; e < 4; ++e) { v0[e] = sigmoid_f(v0[e]); v1[e] = sigmoid_f(v1[e]); }
                    u32x4 w; w.x = cvt_pk_bf16(v0[0], v0[1]); w.y = cvt_pk_bf16(v0[2], v0[3]); w.z = cvt_pk_bf16(v1[0], v1[1]); w.w = cvt_pk_bf16(v1[2], v1[3]);
                    *(u32x4*)(rowp + bj * HALF) = w; } }
    }
};
struct EpiMerge {
    static constexpr bool PERM = true;
    const bf16_t* gates; bf16_t* O;
    __device__ __forceinline__ void operator()(f32x4 (&acc)[2][2][4][2], const Unit& u, int wr, int wc, int fr, int fq, LAS unsigned char*) const {
        const int br = u.pn >> 2, ct = u.pn & 3;
        const int row0 = u.pm * BM + wr * 64 + fr, col0 = ct * BM + wc * 32 + 8 * fq;
#pragma unroll
        for (int ai = 0; ai < 2; ++ai)
#pragma unroll
            for (int m = 0; m < 4; ++m) { const size_t row = (size_t)(row0 + ai * HALF + m * 16);
#pragma unroll
                for (int bj = 0; bj < 2; ++bj) { f32x4 v0 = acc[ai][bj][m][0], v1 = acc[ai][bj][m][1];
                    const u32x4 gw = *(const u32x4*)(gates + row * 3072 + br * 1024 + col0 + bj * HALF);
                    v0[0] *= bflo(gw.x); v0[1] *= bfhi(gw.x); v0[2] *= bflo(gw.y); v0[3] *= bfhi(gw.y);
                    v1[0] *= bflo(gw.z); v1[1] *= bfhi(gw.z); v1[2] *= bflo(gw.w); v1[3] *= bfhi(gw.w);
                    bf16_t* op = O + row * 1024 + col0 + bj * HALF;
                    if (br > 0) { const u32x4 pw = *(const u32x4*)op;
                        v0[0] += bflo(pw.x); v0[1] += bfhi(pw.x); v0[2] += bflo(pw.y); v0[3] += bfhi(pw.y);
                        v1[0] += bflo(pw.z); v1[1] += bfhi(pw.z); v1[2] += bflo(pw.w); v1[3] += bfhi(pw.w); }
                    u32x4 w; w.x = cvt_pk_bf16(v0[0], v0[1]); w.y = cvt_pk_bf16(v0[2], v0[3]); w.z = cvt_pk_bf16(v1[0], v1[1]); w.w = cvt_pk_bf16(v1[2], v1[3]);
                    *(u32x4*)op = w; } }
    }
};
struct EpiF32 {
    static constexpr bool PERM = false;
    float* O;
    __device__ __forceinline__ void operator()(f32x4 (&acc)[2][2][4][2], const Unit& u, int wr, int wc, int fr, int fq, LAS unsigned char*) const {
        const int row0 = u.pm * BM + wr * 64 + fr, col0 = u.pn * BM + wc * 32 + 4 * fq;
#pragma unroll
        for (int ai = 0; ai < 2; ++ai)
#pragma unroll
            for (int m = 0; m < 4; ++m) { float* rowp = O + (size_t)(row0 + ai * HALF + m * 16) * 1024 + col0;
#pragma unroll
                for (int bj = 0; bj < 2; ++bj)
#pragma unroll
                    for (int n = 0; n < 2; ++n) *(f32x4*)(rowp + bj * HALF + n * 16) = acc[ai][bj][m][n]; }
    }
};
struct EpiConv {
    static constexpr bool PERM = true;
    const float* cw; const float* cb; bf16_t* act; float* head; float* tail;
    __device__ __forceinline__ void operator()(f32x4 (&acc)[2][2][4][2], const Unit& u, int wr, int wc, int fr, int fq, LAS unsigned char* lds) const {
        LAS float* XT = (LAS float*)(lds + XT_OFF);
        const int ccol = wc * 32 + 8 * fq;
        if (fr >= 14) {
#pragma unroll
            for (int ai = 0; ai < 2; ++ai)
#pragma unroll
                for (int bj = 0; bj < 2; ++bj)
#pragma unroll
                    for (int n = 0; n < 2; ++n) *(LAS f32x4*)(XT + ((ai * 2 + wr) * 2 + (fr - 14)) * 256 + bj * HALF + ccol + 4 * n) = acc[ai][bj][3][n];
            if (wr == 1) {
#pragma unroll
                for (int bj = 0; bj < 2; ++bj)
#pragma unroll
                    for (int n = 0; n < 2; ++n) *(f32x4*)(tail + ((size_t)u.pm * 2 + (fr - 14)) * DFF2 + u.pn * BM + bj * HALF + ccol + 4 * n) = acc[1][bj][3][n];
            }
        }
        if (fr < 2 && wr == 0) {
#pragma unroll
            for (int bj = 0; bj < 2; ++bj)
#pragma unroll
                for (int n = 0; n < 2; ++n) *(f32x4*)(head + ((size_t)u.pm * 2 + fr) * DFF2 + u.pn * BM + bj * HALF + ccol + 4 * n) = acc[0][bj][0][n];
        }
        asm volatile("s_waitcnt lgkmcnt(0)" ::: "memory"); __builtin_amdgcn_s_barrier(); asm volatile("" ::: "memory");
#pragma unroll
        for (int n = 0; n < 2; ++n) {
            const int ch = u.pn * HALF + ccol + 4 * n;
            const f32x4 wa0 = *(const f32x4*)(cw + ch), wa1 = *(const f32x4*)(cw + DFF2 + ch), wa2 = *(const f32x4*)(cw + 2 * DFF2 + ch), ba = *(const f32x4*)(cb + ch);
            const f32x4 wu0 = *(const f32x4*)(cw + DFF + ch), wu1 = *(const f32x4*)(cw + DFF2 + DFF + ch), wu2 = *(const f32x4*)(cw + 2 * DFF2 + DFF + ch), bu = *(const f32x4*)(cb + DFF + ch);
#pragma unroll
            for (int ai = 1; ai >= 0; --ai)
#pragma unroll
                for (int m = 3; m >= 0; --m) {
                    f32x4 pa, pu;
                    if (m > 0) { pa = acc[ai][0][m - 1][n]; pu = acc[ai][1][m - 1][n]; }
                    else {
                        const int slot = ai * 2 + wr - 1;
                        if (slot >= 0) { pa = *(const LAS f32x4*)(XT + (slot * 2 + (fr & 1)) * 256 + ccol + 4 * n); pu = *(const LAS f32x4*)(XT + (slot * 2 + (fr & 1)) * 256 + HALF + ccol + 4 * n); }
                        else { pa = (f32x4){0.f, 0.f, 0.f, 0.f}; pu = pa; }
                    }
                    f32x4 xa = acc[ai][0][m][n], xu = acc[ai][1][m][n];
                    asm volatile("" : "+v"(xa), "+v"(xu), "+v"(pa), "+v"(pu));
                    f32x4 res;
#pragma unroll
                    for (int e = 0; e < 4; ++e) {
                        const float a1 = dpp_shr1(xa[e]) + dpp_shl15(pa[e]), a2 = dpp_shr2(xa[e]) + dpp_shl14(pa[e]);
                        const float u1 = dpp_shr1(xu[e]) + dpp_shl15(pu[e]), u2 = dpp_shr2(xu[e]) + dpp_shl14(pu[e]);
                        const float ca = ba[e] + wa0[e] * a2 + wa1[e] * a1 + wa2[e] * xa[e];
                        const float cu = bu[e] + wu0[e] * u2 + wu1[e] * u1 + wu2[e] * xu[e];
                        res[e] = gelu_tanh_f(ca) * cu;
                    }
                    asm volatile("" : "+v"(res));
                    acc[ai][0][m][n] = res;
                }
        }
        const int row0 = u.pm * BM + wr * 64 + fr;
#pragma unroll
        for (int ai = 0; ai < 2; ++ai)
#pragma unroll
            for (int m = 0; m < 4; ++m) { const f32x4 v0 = acc[ai][0][m][0], v1 = acc[ai][0][m][1];
                u32x4 w; w.x = cvt_pk_bf16(v0[0], v0[1]); w.y = cvt_pk_bf16(v0[2], v0[3]); w.z = cvt_pk_bf16(v1[0], v1[1]); w.w = cvt_pk_bf16(v1[2], v1[3]);
                *(u32x4*)(act + (size_t)(row0 + ai * HALF + m * 16) * DFF + u.pn * HALF + ccol) = w; }
    }
};
}

__device__ __forceinline__ void transpose_item(const float* W, int ldsrc, int k0, int nsrc0, bf16_t* WT, int K, int ndst0, LAS float* scr, int lane) {
#pragma unroll 8
    for (int i = 0; i < 32; ++i) { const int kk = 2 * i + (lane >> 5); scr[kk * 33 + (lane & 31)] = W[(size_t)(k0 + kk) * ldsrc + nsrc0 + (lane & 31)]; }
    LDS_WAIT(); asm volatile("" ::: "memory");
    const int c = lane & 7;
#pragma unroll
    for (int j = 0; j < 4; ++j) { const int n = (lane >> 3) + 8 * j; const LAS float* s = scr + (8 * c) * 33 + n;
        u32x4 o; o.x = cvt_pk_bf16(s[0 * 33], s[1 * 33]); o.y = cvt_pk_bf16(s[2 * 33], s[3 * 33]); o.z = cvt_pk_bf16(s[4 * 33], s[5 * 33]); o.w = cvt_pk_bf16(s[6 * 33], s[7 * 33]);
        *(u32x4*)(WT + (size_t)(ndst0 + n) * K + k0 + 8 * c) = o; }
    LDS_WAIT(); asm volatile("" ::: "memory");
}
__device__ __forceinline__ void convert_weights(const Params& p, int l, LAS unsigned char* lds, int gw, int ngw, int wave, int lane) {
    lane = vlaunder(lane);
    LAS float* scr = (LAS float*)(lds + wave * 16384);
    unsigned char* ws = launder(p.ws);
    bf16_t* Win = (bf16_t*)(ws + WS_WIN); bf16_t* WP = (bf16_t*)(ws + WS_WP); bf16_t* WO = (bf16_t*)(ws + WS_WOUT); bf16_t* WU = (bf16_t*)(ws + WS_WUP); bf16_t* WD = (bf16_t*)(ws + WS_WDN);
    const float* w_in = launder(p.w_in) + (size_t)l * DM * INW;
    constexpr int I0 = 16 * 128, I1 = 16 * 96, I2 = 8 * 32, I5 = 16 * 32, I6 = 16 * 176, I7 = 44 * 32;
    constexpr int NITEMS = I0 + I1 + 3 * I2 + I5 + I6 + I7;
    for (int it = gw; it < NITEMS; it += ngw) {
        int r = it;
        if (r < I0) { const int kb = r / 128, nb = r % 128; transpose_item(w_in, INW, 64 * kb, 32 * nb, Win, 1024, 32 * nb, scr, lane); continue; } r -= I0;
        if (r < I1) { const int kb = r / 96, nb = r % 96; transpose_item(w_in, INW, 64 * kb, 4112 + 32 * nb, Win, 1024, 4352 + 32 * nb, scr, lane); continue; } r -= I1;
        if (r < 3 * I2) { const int br = r / I2, q = r % I2, kb = q / 32, nb = q % 32;
            const float* src = launder(br == 0 ? p.p_a : (br == 1 ? p.p_b : p.p_c)) + (size_t)l * 512 * 1024;
            transpose_item(src, 1024, 64 * kb, 32 * nb, WP, 512, 1024 * br + 32 * nb, scr, lane); continue; } r -= 3 * I2;
        if (r < I5) { const int kb = r / 32, nb = r % 32; transpose_item(launder(p.w_out) + (size_t)l * 1024 * 1024, 1024, 64 * kb, 32 * nb, WO, 1024, 32 * nb, scr, lane); continue; } r -= I5;
        if (r < I6) { const int kb = r / 176, nb = r % 176, j = nb >> 3, half = (nb >> 2) & 1, q = nb & 3;
            transpose_item(launder(p.ffn_w_up) + (size_t)l * 1024 * DFF2, DFF2, 64 * kb, DFF * half + 128 * j + 32 * q, WU, 1024, 256 * j + 128 * half + 32 * q, scr, lane); continue; } r -= I6;
        { const int kb = r / 32, nb = r % 32; transpose_item(launder(p.ffn_w_down) + (size_t)l * DFF * 1024, 1024, 64 * kb, 32 * nb, WD, DFF, 32 * nb, scr, lane); }
    }
    for (int idx = gw * 64 + lane; idx < 256 * 1024; idx += ngw * 64) { const int n = idx >> 10, k = idx & 1023;
        const float v = (n < 16) ? w_in[(size_t)k * INW + 4096 + n] : 0.f; Win[(size_t)(4096 + n) * 1024 + k] = f2bf(v); }
}

__device__ __forceinline__ void row_phase(const float* hin, const float* y, const float* gpost, float* hout, const float* gpre, bf16_t* xn, int gw, int ngw, int lane) {
    hin = launder(hin); y = launder(y); hout = launder(hout); xn = launder(xn); gpost = launder(gpost); gpre = launder(gpre); lane = vlaunder(lane);
    for (int m = gw; m < MTOK; m += ngw) {
        const f32x4* hr = (const f32x4*)(hin + (size_t)m * DM) + lane;
        f32x4 v[4];
#pragma unroll
        for (int j = 0; j < 4; ++j) v[j] = hr[64 * j];
        if (y) {
            const f32x4* yr = (const f32x4*)(y + (size_t)m * DM) + lane; f32x4 yv[4]; float s = 0.f;
#pragma unroll
            for (int j = 0; j < 4; ++j) { yv[j] = yr[64 * j]; s += (yv[j].x * yv[j].x + yv[j].y * yv[j].y) + (yv[j].z * yv[j].z + yv[j].w * yv[j].w); }
            const float r = 1.0f / sqrtf(wave_sum(s) * (1.f / DM) + EPS);
#pragma unroll
            for (int j = 0; j < 4; ++j) { const f32x4 gp = *((const f32x4*)gpost + lane + 64 * j); v[j] += yv[j] * r * gp; }
        }
        f32x4* ho = (f32x4*)(hout + (size_t)m * DM) + lane;
#pragma unroll
        for (int j = 0; j < 4; ++j) ho[64 * j] = v[j];
        if (xn) {
            float s = 0.f;
#pragma unroll
            for (int j = 0; j < 4; ++j) s += (v[j].x * v[j].x + v[j].y * v[j].y) + (v[j].z * v[j].z + v[j].w * v[j].w);
            const float r = 1.0f / sqrtf(wave_sum(s) * (1.f / DM) + EPS);
            u32x2* xo = (u32x2*)(xn + (size_t)m * DM) + lane;
#pragma unroll
            for (int j = 0; j < 4; ++j) { const f32x4 g = *((const f32x4*)gpre + lane + 64 * j); const f32x4 o = v[j] * r * g; u32x2 w; w.x = cvt_pk_bf16(o.x, o.y); w.y = cvt_pk_bf16(o.z, o.w); xo[64 * j] = w; }
        }
    }
}

__device__ __forceinline__ void sb_phase(LAS unsigned char* lds, unsigned char* ws, int tid, int wave, int lane) {
    ws = launder(ws); tid = vlaunder(tid); lane = tid & 63;
    bf16_t* QA = (bf16_t*)(ws + WS_QA); const bf16_t* KA = (const bf16_t*)(ws + WS_KA); const bf16_t* VA = (const bf16_t*)(ws + WS_VA);
    LAS bf16_t* sK = (LAS bf16_t*)lds;
    LAS bf16_t* sVt = (LAS bf16_t*)(lds + 9216);
    const int r = lane & 15, g = lane >> 4;
    for (int u = blockIdx.x; u < BATCH * 8 * 32; u += gridDim.x) {
        const int b = u >> 8, h = (u >> 5) & 7, qb = u & 31;
        const int tq0 = qb * 128 + wave * 16, t = tq0 + r;
        const size_t rowbase = (size_t)b * SEQ;
        bf16x8 qf[2];
#pragma unroll
        for (int ks = 0; ks < 2; ++ks) qf[ks] = *(const bf16x8*)(QA + (rowbase + t) * 512 + h * 64 + 32 * ks + 8 * g);
        f32x4 o[4];
#pragma unroll
        for (int i = 0; i < 4; ++i) o[i] = (f32x4){0.f, 0.f, 0.f, 0.f};
        float carry = 0.f;
        for (int kt = qb * 2 + 1; kt >= 0; --kt) {
            {
                const int key = tid >> 3, ch = tid & 7;
                const size_t goff = (rowbase + kt * 64 + key) * 512 + h * 64 + 8 * ch;
                const u32x4 kv = *(const u32x4*)(KA + goff); const u32x4 vv = *(const u32x4*)(VA + goff);
                *(LAS u32x4*)(sK + key * 72 + 8 * ch) = kv;
                LAS bf16_t* vd = sVt + (8 * ch) * 68 + key;
                vd[0 * 68] = (bf16_t)(vv.x & 0xffff); vd[1 * 68] = (bf16_t)(vv.x >> 16); vd[2 * 68] = (bf16_t)(vv.y & 0xffff); vd[3 * 68] = (bf16_t)(vv.y >> 16);
                vd[4 * 68] = (bf16_t)(vv.z & 0xffff); vd[5 * 68] = (bf16_t)(vv.z >> 16); vd[6 * 68] = (bf16_t)(vv.w & 0xffff); vd[7 * 68] = (bf16_t)(vv.w >> 16);
            }
            __syncthreads();
            const bool active = (kt * 64) < (tq0 + 15);
            if (active) {
                f32x4 s[4];
#pragma unroll
                for (int kb = 0; kb < 4; ++kb) { s[kb] = (f32x4){0.f, 0.f, 0.f, 0.f};
#pragma unroll
                    for (int ks = 0; ks < 2; ++ks) { const bf16x8 a = *(const LAS bf16x8*)(sK + (16 * kb + r) * 72 + 32 * ks + 8 * g); s[kb] = mfma16(a, qf[ks], s[kb]); } }
                f32x4 w[4];
#pragma unroll
                for (int kb = 3; kb >= 0; --kb) {
                    float l[4], ls[4]; bool mk[4];
#pragma unroll
                    for (int j = 0; j < 4; ++j) { const int key = kt * 64 + 16 * kb + 4 * g + j; const float z = s[kb][j] * 0.125f; mk[j] = key < t;
                        const float lsz = logsig_f(z); ls[j] = lsz; l[j] = mk[j] ? (lsz - z) : 0.f; }
                    const float sg = (l[0] + l[1]) + (l[2] + l[3]);
                    const float a_ = __shfl_xor(sg, 16); const float b_ = sg + a_; const float c_ = __shfl_xor(b_, 32);
                    const float suf = ((g & 1) == 0 ? a_ : 0.f) + ((g & 2) == 0 ? c_ : 0.f);
                    const float t3 = carry + suf, t2 = t3 + l[3], t1 = t2 + l[2], t0 = t1 + l[1];
                    w[kb][0] = mk[0] ? __expf(ls[0] + t0) : 0.f; w[kb][1] = mk[1] ? __expf(ls[1] + t1) : 0.f;
                    w[kb][2] = mk[2] ? __expf(ls[2] + t2) : 0.f; w[kb][3] = mk[3] ? __expf(ls[3] + t3) : 0.f;
                    carry += b_ + c_;
                }
#pragma unroll
                for (int sI = 0; sI < 2; ++sI) {
                    const bf16x8 pb = pack8(w[2 * sI], w[2 * sI + 1]);
#pragma unroll
                    for (int dvb = 0; dvb < 4; ++dvb) {
                        const LAS bf16_t* vp = sVt + (16 * dvb + r) * 68 + 32 * sI + 4 * g;
                        const u32x2 lo = *(const LAS u32x2*)vp, hi = *(const LAS u32x2*)(vp + 16);
                        u32x4 av; av.x = lo.x; av.y = lo.y; av.z = hi.x; av.w = hi.y;
                        o[dvb] = mfma16(__builtin_bit_cast(bf16x8, av), pb, o[dvb]);
                    }
                }
            }
            const int done = __all(carry < SB_THR) ? 1 : 0;
            if (__syncthreads_and(done)) break;
        }
#pragma unroll
        for (int dvb = 0; dvb < 4; ++dvb) { u32x2 w2; w2.x = cvt_pk_bf16(o[dvb][0], o[dvb][1]); w2.y = cvt_pk_bf16(o[dvb][2], o[dvb][3]);
            *(u32x2*)(QA + (rowbase + t) * 512 + h * 64 + 16 * dvb + 4 * g) = w2; }
        __syncthreads();
    }
}

__device__ __forceinline__ void sg_phase(LAS unsigned char* lds, const Params& p, int l, int tid, int wave, int lane) {
    unsigned char* ws = launder(p.ws); tid = vlaunder(tid); lane = tid & 63;
    bf16_t* U = (bf16_t*)(ws + WS_U); const bf16_t* SV = (const bf16_t*)(ws + WS_SV);
    LAS bf16_t* sVn = (LAS bf16_t*)(lds + wave * (64 * 136 * 2));
    LAS float* sSt = (LAS float*)(lds + 8 * 64 * 136 * 2);
    const int r = lane & 15, gq = lane >> 4;
    const float* lng = launder(p.sg_ln_g) + l * 512; const float* lnb = launder(p.sg_ln_b) + l * 512;
    const float* W = launder(p.sg_w) + ((size_t)(l * 8 + wave)) * 128 * 128;
    const float* Bs = launder(p.sg_b) + (l * 8 + wave) * 128;
    for (int u = blockIdx.x; u < BATCH * 32; u += gridDim.x) {
        const size_t row0 = (size_t)u * 128;
        for (int i = 0; i < 16; ++i) {
            const int tok = wave * 16 + i;
            const u32x4 vv = *(const u32x4*)(SV + (row0 + tok) * 512 + 8 * lane);
            float x[8] = {bflo(vv.x), bfhi(vv.x), bflo(vv.y), bfhi(vv.y), bflo(vv.z), bfhi(vv.z), bflo(vv.w), bfhi(vv.w)};
            float s = 0.f;
#pragma unroll
            for (int e = 0; e < 8; ++e) s += x[e];
            const float mu = wave_sum(s) * (1.f / 512.f);
            float q = 0.f;
#pragma unroll
            for (int e = 0; e < 8; ++e) { const float d = x[e] - mu; q += d * d; }
            const float rs = 1.0f / sqrtf(wave_sum(q) * (1.f / 512.f) + EPS);
            if (lane == 0) { sSt[tok * 2] = mu; sSt[tok * 2 + 1] = rs; }
        }
        __syncthreads();
#pragma unroll
        for (int i = 0; i < 2; ++i) {
            const int s = lane + 64 * i; const float mu = sSt[s * 2], rs = sSt[s * 2 + 1];
#pragma unroll
            for (int c = 0; c < 8; ++c) {
                const u32x4 vv = *(const u32x4*)(SV + (row0 + s) * 512 + wave * 64 + 8 * c);
                const float x[8] = {bflo(vv.x), bfhi(vv.x), bflo(vv.y), bfhi(vv.y), bflo(vv.z), bfhi(vv.z), bflo(vv.w), bfhi(vv.w)};
                const f32x4 g0 = *(const f32x4*)(lng + wave * 64 + 8 * c), g1 = *(const f32x4*)(lng + wave * 64 + 8 * c + 4);
                const f32x4 b0 = *(const f32x4*)(lnb + wave * 64 + 8 * c), b1 = *(const f32x4*)(lnb + wave * 64 + 8 * c + 4);
#pragma unroll
                for (int e = 0; e < 8; ++e) { const float gg = e < 4 ? g0[e & 3] : g1[e & 3], bb = e < 4 ? b0[e & 3] : b1[e & 3];
                    sVn[(8 * c + e) * 136 + s] = f2bf((x[e] - mu) * rs * gg + bb); }
            }
        }
        __syncthreads();
        for (int tb = 0; tb < 8; ++tb) {
            f32x4 acc[4];
#pragma unroll
            for (int i = 0; i < 4; ++i) acc[i] = (f32x4){0.f, 0.f, 0.f, 0.f};
            const int t = 16 * tb + r;
            for (int ks = 0; ks <= (tb >> 1); ++ks) {
                const int s0 = 32 * ks + 8 * gq;
                f32x4 w0 = *(const f32x4*)(W + t * 128 + s0), w1 = *(const f32x4*)(W + t * 128 + s0 + 4);
#pragma unroll
                for (int e = 0; e < 4; ++e) { if (s0 + e > t) w0[e] = 0.f; if (s0 + 4 + e > t) w1[e] = 0.f; }
                const bf16x8 a = pack8(w0, w1);
#pragma unroll
                for (int db = 0; db < 4; ++db) { const bf16x8 bb = *(const LAS bf16x8*)(sVn + (16 * db + r) * 136 + s0); acc[db] = mfma16(a, bb, acc[db]); }
            }
#pragma unroll
            for (int j = 0; j < 4; ++j) { const int tt = 16 * tb + 4 * gq + j; const float bsv = Bs[tt];
#pragma unroll
                for (int db = 0; db < 4; ++db) { bf16_t* up = U + (row0 + tt) * 512 + wave * 64 + 16 * db + r; *up = f2bf(bf2f(*up) * (acc[db][j] + bsv)); } }
        }
        __syncthreads();
    }
}

template <bool PASS_C>
__device__ __forceinline__ void gla_phase(LAS unsigned char* lds, const Params& p, int l, int tid, int wave, int lane) {
    unsigned char* ws = launder(p.ws); tid = vlaunder(tid); lane = tid & 63;
    const bf16_t* GQ = (const bf16_t*)(ws + WS_GQ); const bf16_t* GK = (const bf16_t*)(ws + WS_GK); const bf16_t* GV = (const bf16_t*)(ws + WS_GV);
    bf16_t* GR = (bf16_t*)(ws + WS_GR); const float* GD = (const float*)(ws + WS_GDOWN); float* UPD = (float*)(ws + WS_UPD); float* DEC = (float*)(ws + WS_DEC);
    LAS float* sCum = (LAS float*)lds;
    LAS float* sTot = (LAS float*)(lds + 16384);
    LAS bf16_t* sQD = (LAS bf16_t*)(lds + 18432);
    LAS bf16_t* sKI = (LAS bf16_t*)(lds + 27648);
    LAS bf16_t* sKEt = (LAS bf16_t*)(lds + 36864);
    LAS bf16_t* sVt = (LAS bf16_t*)(lds + 46080);
    LAS bf16_t* sAT = (LAS bf16_t*)(lds + 64512);
    LAS bf16_t* sSt = (LAS bf16_t*)(lds + 73728);
    LAS float* sSS = (LAS float*)(lds + 92160);
    const int r = lane & 15, gq = lane >> 4;
    const float* wgup = launder(p.gla_w_gup) + l * 16 * 256; const float* bgate = launder(p.gla_b_gate) + l * 256; const float* ng = launder(p.gla_norm_g) + l * 128;
    for (int u = blockIdx.x; u < BATCH * 4 * 64; u += gridDim.x) {
        const int b = u >> 8, h = (u >> 6) & 3, n = u & 63;
        const size_t r0 = (size_t)b * SEQ + n * 64;
        const int t_ = tid >> 3, k8 = (tid & 7) * 8;
        {
            const f32x4* gdp = (const f32x4*)(GD + (r0 + t_) * 16);
            const f32x4 g0 = gdp[0], g1 = gdp[1], g2 = gdp[2], g3 = gdp[3];
            const float gd[16] = {g0[0], g0[1], g0[2], g0[3], g1[0], g1[1], g1[2], g1[3], g2[0], g2[1], g2[2], g2[3], g3[0], g3[1], g3[2], g3[3]};
            f32x4 a0 = *(const f32x4*)(bgate + h * 64 + k8), a1 = *(const f32x4*)(bgate + h * 64 + k8 + 4);
#pragma unroll
            for (int rr = 0; rr < 16; ++rr) { const f32x4 w0 = *(const f32x4*)(wgup + rr * 256 + h * 64 + k8), w1 = *(const f32x4*)(wgup + rr * 256 + h * 64 + k8 + 4); a0 += w0 * gd[rr]; a1 += w1 * gd[rr]; }
            f32x4 o0, o1;
#pragma unroll
            for (int e = 0; e < 4; ++e) { o0[e] = logsig_f(a0[e]) * 0.0625f; o1[e] = logsig_f(a1[e]) * 0.0625f; }
            *(LAS f32x4*)(sCum + t_ * 64 + k8) = o0; *(LAS f32x4*)(sCum + t_ * 64 + k8 + 4) = o1;
        }
        __syncthreads();
        {
            const int k = tid & 63, seg = tid >> 6; float run = 0.f;
#pragma unroll
            for (int i = 0; i < 8; ++i) { run += sCum[(8 * seg + i) * 64 + k]; sCum[(8 * seg + i) * 64 + k] = run; }
            sTot[seg * 64 + k] = run;
            __syncthreads();
            float pre = 0.f;
#pragma unroll
            for (int s = 0; s < 7; ++s) pre += (s < seg) ? sTot[s * 64 + k] : 0.f;
#pragma unroll
            for (int i = 0; i < 8; ++i) sCum[(8 * seg + i) * 64 + k] += pre;
        }
        __syncthreads();
        {
            const f32x4 c0 = *(const LAS f32x4*)(sCum + t_ * 64 + k8), c1 = *(const LAS f32x4*)(sCum + t_ * 64 + k8 + 4);
            const f32x4 e0 = *(const LAS f32x4*)(sCum + 63 * 64 + k8), e1 = *(const LAS f32x4*)(sCum + 63 * 64 + k8 + 4);
            const u32x4 kw = *(const u32x4*)(GK + (r0 + t_) * 256 + h * 64 + k8);
            const float kk[8] = {bflo(kw.x), bfhi(kw.x), bflo(kw.y), bfhi(kw.y), bflo(kw.z), bfhi(kw.z), bflo(kw.w), bfhi(kw.w)};
            const float cm[8] = {c0[0], c0[1], c0[2], c0[3], c1[0], c1[1], c1[2], c1[3]};
            const float ce[8] = {e0[0], e0[1], e0[2], e0[3], e1[0], e1[1], e1[2], e1[3]};
            if (PASS_C) {
                const u32x4 qw = *(const u32x4*)(GQ + (r0 + t_) * 256 + h * 64 + k8);
                const float qq[8] = {bflo(qw.x), bfhi(qw.x), bflo(qw.y), bfhi(qw.y), bflo(qw.z), bfhi(qw.z), bflo(qw.w), bfhi(qw.w)};
                f32x4 qa, qb, ka, kb;
#pragma unroll
                for (int e = 0; e < 4; ++e) { qa[e] = qq[e] * 0.125f * __expf(cm[e]); qb[e] = qq[e + 4] * 0.125f * __expf(cm[e + 4]); ka[e] = kk[e] * __expf(-cm[e]); kb[e] = kk[e + 4] * __expf(-cm[e + 4]); }
                *(LAS bf16x8*)(sQD + t_ * 72 + k8) = pack8(qa, qb); *(LAS bf16x8*)(sKI + t_ * 72 + k8) = pack8(ka, kb);
                const int dv = tid >> 2, kq = (tid & 3) * 16; const f32x4* sp = (const f32x4*)(UPD + ((size_t)u * 128 + dv) * 64 + kq);
                const f32x4 s0 = sp[0], s1 = sp[1], s2 = sp[2], s3 = sp[3];
                *(LAS bf16x8*)(sSt + dv * 72 + kq) = pack8(s0, s1); *(LAS bf16x8*)(sSt + dv * 72 + kq + 8) = pack8(s2, s3);
            } else {
#pragma unroll
                for (int e = 0; e < 8; ++e) sKEt[(k8 + e) * 72 + t_] = f2bf(kk[e] * __expf(ce[e] - cm[e]));
                if (t_ == 63) {
#pragma unroll
                    for (int e = 0; e < 8; ++e) DEC[(size_t)u * 64 + k8 + e] = __expf(ce[e]);
                }
            }
            const int s = tid >> 3, c = tid & 7;
            const u32x4 v0 = *(const u32x4*)(GV + (r0 + s) * 512 + h * 128 + 16 * c), v1 = *(const u32x4*)(GV + (r0 + s) * 512 + h * 128 + 16 * c + 8);
            LAS bf16_t* vd = sVt + (16 * c) * 72 + s;
            vd[0 * 72] = (bf16_t)(v0.x & 0xffff); vd[1 * 72] = (bf16_t)(v0.x >> 16); vd[2 * 72] = (bf16_t)(v0.y & 0xffff); vd[3 * 72] = (bf16_t)(v0.y >> 16);
            vd[4 * 72] = (bf16_t)(v0.z & 0xffff); vd[5 * 72] = (bf16_t)(v0.z >> 16); vd[6 * 72] = (bf16_t)(v0.w & 0xffff); vd[7 * 72] = (bf16_t)(v0.w >> 16);
            vd[8 * 72] = (bf16_t)(v1.x & 0xffff); vd[9 * 72] = (bf16_t)(v1.x >> 16); vd[10 * 72] = (bf16_t)(v1.y & 0xffff); vd[11 * 72] = (bf16_t)(v1.y >> 16);
            vd[12 * 72] = (bf16_t)(v1.z & 0xffff); vd[13 * 72] = (bf16_t)(v1.z >> 16); vd[14 * 72] = (bf16_t)(v1.w & 0xffff); vd[15 * 72] = (bf16_t)(v1.w >> 16);
        }
        __syncthreads();
        if (!PASS_C) {
#pragma unroll
            for (int kb = 0; kb < 4; ++kb) { f32x4 acc = (f32x4){0.f, 0.f, 0.f, 0.f};
#pragma unroll
                for (int ks = 0; ks < 2; ++ks) { const bf16x8 a = *(const LAS bf16x8*)(sKEt + (16 * kb + r) * 72 + 32 * ks + 8 * gq); const bf16x8 bb = *(const LAS bf16x8*)(sVt + (16 * wave + r) * 72 + 32 * ks + 8 * gq); acc = mfma16(a, bb, acc); }
                *(f32x4*)(UPD + ((size_t)u * 128 + 16 * wave + r) * 64 + 16 * kb + 4 * gq) = acc; }
        } else {
            {
                const int tb = wave >> 1;
#pragma unroll
                for (int i = 0; i < 2; ++i) { const int sb = 2 * (wave & 1) + i;
                    f32x4 acc = (f32x4){0.f, 0.f, 0.f, 0.f};
                    if (sb <= tb) {
#pragma unroll
                        for (int ks = 0; ks < 2; ++ks) { const bf16x8 a = *(const LAS bf16x8*)(sQD + (16 * tb + r) * 72 + 32 * ks + 8 * gq); const bf16x8 bb = *(const LAS bf16x8*)(sKI + (16 * sb + r) * 72 + 32 * ks + 8 * gq); acc = mfma16(a, bb, acc); }
                    }
#pragma unroll
                    for (int j = 0; j < 4; ++j) { const int tt = 16 * tb + 4 * gq + j, ss = 16 * sb + r; sAT[tt * 72 + ss] = f2bf((sb <= tb && ss <= tt) ? acc[j] : 0.f); } }
            }
            __syncthreads();
            const int tb = wave & 3, hv = wave >> 2;
            f32x4 acc[4];
#pragma unroll
            for (int i = 0; i < 4; ++i) { acc[i] = (f32x4){0.f, 0.f, 0.f, 0.f}; const int dvb = 4 * hv + i;
#pragma unroll
                for (int ks = 0; ks < 2; ++ks) {
                    const bf16x8 a1 = *(const LAS bf16x8*)(sAT + (16 * tb + r) * 72 + 32 * ks + 8 * gq); const bf16x8 b1 = *(const LAS bf16x8*)(sVt + (16 * dvb + r) * 72 + 32 * ks + 8 * gq); acc[i] = mfma16(a1, b1, acc[i]);
                    const bf16x8 a2 = *(const LAS bf16x8*)(sQD + (16 * tb + r) * 72 + 32 * ks + 8 * gq); const bf16x8 b2 = *(const LAS bf16x8*)(sSt + (16 * dvb + r) * 72 + 32 * ks + 8 * gq); acc[i] = mfma16(a2, b2, acc[i]);
                } }
            float ss[4];
#pragma unroll
            for (int j = 0; j < 4; ++j) { float q = 0.f;
#pragma unroll
                for (int i = 0; i < 4; ++i) q += acc[i][j] * acc[i][j];
                q += __shfl_xor(q, 1); q += __shfl_xor(q, 2); q += __shfl_xor(q, 4); q += __shfl_xor(q, 8); ss[j] = q; }
            if (r == 0) {
#pragma unroll
                for (int j = 0; j < 4; ++j) sSS[hv * 64 + 16 * tb + 4 * gq + j] = ss[j];
            }
            __syncthreads();
#pragma unroll
            for (int j = 0; j < 4; ++j) { const int tt = 16 * tb + 4 * gq + j; const float rs = 1.0f / sqrtf((sSS[tt] + sSS[64 + tt]) * (1.f / 128.f) + EPS);
#pragma unroll
                for (int i = 0; i < 4; ++i) { const int dv = 16 * (4 * hv + i) + r; bf16_t* gp = GR + (r0 + tt) * 512 + h * 128 + dv; *gp = f2bf(acc[i][j] * rs * ng[dv] * bf2f(*gp)); } }
        }
        __syncthreads();
    }
}
__device__ __forceinline__ void gla_scan(unsigned char* ws, int gtid, int ngt) {
    ws = launder(ws); gtid = blockIdx.x * 512 + vlaunder((int)threadIdx.x);
    float* UPD = (float*)(ws + WS_UPD); const float* DEC = (const float*)(ws + WS_DEC);
    for (int e = gtid; e < 32 * 8192; e += ngt) {
        const int bh = e >> 13, rem = e & 8191, dk = rem & 63; float S = 0.f;
#pragma unroll 8
        for (int n = 0; n < 64; ++n) { const size_t idx = ((size_t)(bh * 64 + n)) * 8192 + rem; const float uv = UPD[idx]; UPD[idx] = S; S = DEC[(bh * 64 + n) * 64 + dk] * S + uv; }
    }
}
__device__ __forceinline__ void conv_fix(const Params& p, int l, int gtid, int ngt) {
    unsigned char* ws = launder(p.ws); gtid = blockIdx.x * 512 + vlaunder((int)threadIdx.x);
    const float* head = (const float*)(ws + WS_HEAD); const float* tail = (const float*)(ws + WS_TAIL); bf16_t* act = (bf16_t*)(ws + WS_ACT);
    const float* cw = launder(p.ffn_conv_w) + (size_t)l * 3 * DFF2; const float* cb = launder(p.ffn_conv_b) + (size_t)l * DFF2;
    for (int e = gtid; e < 128 * DFF; e += ngt) {
        const int pm = e / DFF, c = e % DFF, j = c >> 7, cc = c & 127; const int pa = 256 * j + cc, pu = pa + 128;
        const bool first = (pm & 15) == 0;
        const float ta0 = first ? 0.f : tail[((size_t)(pm - 1) * 2 + 0) * DFF2 + pa], ta1 = first ? 0.f : tail[((size_t)(pm - 1) * 2 + 1) * DFF2 + pa];
        const float tu0 = first ? 0.f : tail[((size_t)(pm - 1) * 2 + 0) * DFF2 + pu], tu1 = first ? 0.f : tail[((size_t)(pm - 1) * 2 + 1) * DFF2 + pu];
        const float ha0 = head[((size_t)pm * 2 + 0) * DFF2 + pa], ha1 = head[((size_t)pm * 2 + 1) * DFF2 + pa];
        const float hu0 = head[((size_t)pm * 2 + 0) * DFF2 + pu], hu1 = head[((size_t)pm * 2 + 1) * DFF2 + pu];
        const float wa0 = cw[c], wa1 = cw[DFF2 + c], wa2 = cw[2 * DFF2 + c], ba = cb[c];
        const float wu0 = cw[DFF + c], wu1 = cw[DFF2 + DFF + c], wu2 = cw[2 * DFF2 + DFF + c], bu = cb[DFF + c];
        const float ca0 = ba + wa0 * ta0 + wa1 * ta1 + wa2 * ha0, cu0 = bu + wu0 * tu0 + wu1 * tu1 + wu2 * hu0;
        const float ca1 = ba + wa0 * ta1 + wa1 * ha0 + wa2 * ha1, cu1 = bu + wu0 * tu1 + wu1 * hu0 + wu2 * hu1;
        act[((size_t)pm * 256 + 0) * DFF + c] = f2bf(gelu_tanh_f(ca0) * cu0);
        act[((size_t)pm * 256 + 1) * DFF + c] = f2bf(gelu_tanh_f(ca1) * cu1);
    }
}

#define GRID_SYNC() do { asm volatile("s_waitcnt vmcnt(0) lgkmcnt(0)" ::: "memory"); grid.sync(); } while (0)
#ifndef DBG_STOP
#define DBG_STOP 0
#endif
__device__ __forceinline__ void dbg_dump(float* out, const bf16_t* a, const bf16_t* b, const bf16_t* c, int lda) {
    for (size_t e = (size_t)blockIdx.x * 512 + threadIdx.x; e < (size_t)MTOK * DM; e += (size_t)gridDim.x * 512) {
        const size_t m = e >> 10; const int col = (lda == 3072) ? (int)(e & 1023) + 1024 * (int)(m % 3) : (int)(e & 1023) % lda; float v = bf2f(a[m * lda + col]); if (b) v += bf2f(b[m * lda + col]); if (c) v += bf2f(c[m * lda + col]); out[e] = v; }
}
__global__ void __launch_bounds__(512, 2) mega_fwd(Params p) {
    extern __shared__ __attribute__((aligned(16))) unsigned char lds_raw[];
    LAS unsigned char* lds = (LAS unsigned char*)lds_raw;
    cg::grid_group grid = cg::this_grid();
    const int tid = threadIdx.x, lane = tid & 63, wave = __builtin_amdgcn_readfirstlane(tid >> 6);
    const int G = gridDim.x, gw = blockIdx.x * 8 + wave, ngw = G * 8, ngt = G * 512;
    unsigned char* ws = p.ws;
    bf16_t* XN = (bf16_t*)(ws + WS_XN);

    convert_weights(p, 0, lds, gw, ngw, wave, lane);
    row_phase(p.x, nullptr, nullptr, p.out, p.mix_pre_g, XN, gw, ngw, lane);
    GRID_SYNC();
    if (DBG_STOP == 8) {
        {
            unsigned char* ws = launder(p.ws); bf16_t* XN = (bf16_t*)(ws + WS_XN);
            pg8::Gemm g{XN, (const bf16_t*)(ws + WS_WIN) + (size_t)4352 * 1024, 1024, 1024, 1024, 0, 0}; pg8::StaticOrder S; S.init(MTOK, 3072, G, (int)blockIdx.x);
            pg8::EpiGates E{(bf16_t*)(ws + WS_GATES)}; pg8::gemm_phase(lds, g, S, E);
        }
        GRID_SYNC();
        dbg_dump(p.out, (const bf16_t*)(ws + WS_GATES), nullptr, nullptr, 3072); return;
    }
#pragma unroll 1
    for (int l = 0; l < 2; ++l) {
        {
            unsigned char* ws = launder(p.ws); bf16_t* XN = (bf16_t*)(ws + WS_XN);
            pg8::Gemm g{XN, (const bf16_t*)(ws + WS_WIN), 1024, 1024, 1024, 0, 0}; pg8::StaticOrder S; S.init(MTOK, 4352, G, (int)blockIdx.x);
            pg8::EpiG1 E{ws}; pg8::gemm_phase(lds, g, S, E);
        }
        GRID_SYNC();
        if (DBG_STOP == 1) { dbg_dump(p.out, (const bf16_t*)(ws + WS_KA), (const bf16_t*)(ws + WS_SV), (const bf16_t*)(ws + WS_GV), 512); return; }
        sb_phase(lds, ws, tid, wave, lane);
        sg_phase(lds, p, l, tid, wave, lane);
        gla_phase<false>(lds, p, l, tid, wave, lane);
        GRID_SYNC();
        gla_scan(ws, 0, ngt);
        GRID_SYNC();
        gla_phase<true>(lds, p, l, tid, wave, lane);
        GRID_SYNC();
        if (DBG_STOP == 2) { dbg_dump(p.out, (const bf16_t*)(ws + WS_QA), (const bf16_t*)(ws + WS_U), (const bf16_t*)(ws + WS_GR), 512); return; }
        {
            unsigned char* ws = launder(p.ws); bf16_t* XN = (bf16_t*)(ws + WS_XN);
            pg8::Gemm g{XN, (const bf16_t*)(ws + WS_WIN) + (size_t)4352 * 1024, 1024, 1024, 1024, 0, 0}; pg8::StaticOrder S; S.init(MTOK, 3072, G, (int)blockIdx.x);
            pg8::EpiGates E{(bf16_t*)(ws + WS_GATES)}; pg8::gemm_phase(lds, g, S, E);
        }
        GRID_SYNC();
        if (DBG_STOP == 7) { dbg_dump(p.out, (const bf16_t*)(ws + WS_GATES), nullptr, nullptr, 3072); return; }
        {
            unsigned char* ws = launder(p.ws); bf16_t* XN = (bf16_t*)(ws + WS_XN);
            pg8::Gemm g{(const bf16_t*)(ws + WS_QA), (const bf16_t*)(ws + WS_WP), 512, 512, 512, 4, (size_t)(32 * MiB)}; pg8::MergeOrder S; S.base.init(MTOK, 1024, G, (int)blockIdx.x);
            pg8::EpiMerge E{(const bf16_t*)(ws + WS_GATES), XN}; pg8::gemm_phase(lds, g, S, E);
        }
        GRID_SYNC();
        if (DBG_STOP == 3) { dbg_dump(p.out, (const bf16_t*)(ws + WS_XN), nullptr, nullptr, 1024); return; }
        {
            unsigned char* ws = launder(p.ws); bf16_t* XN = (bf16_t*)(ws + WS_XN);
            pg8::Gemm g{XN, (const bf16_t*)(ws + WS_WOUT), 1024, 1024, 1024, 0, 0}; pg8::StaticOrder S; S.init(MTOK, 1024, G, (int)blockIdx.x);
            pg8::EpiF32 E{(float*)(ws + WS_Y32)}; pg8::gemm_phase(lds, g, S, E);
        }
        GRID_SYNC();
        row_phase(p.out, (const float*)(ws + WS_Y32), p.mix_post_g + l * DM, p.out, p.ffn_pre_g + l * DM, XN, gw, ngw, lane);
        GRID_SYNC();
        if (DBG_STOP == 4) return;
        {
            unsigned char* ws = launder(p.ws); bf16_t* XN = (bf16_t*)(ws + WS_XN);
            pg8::Gemm g{XN, (const bf16_t*)(ws + WS_WUP), 1024, 1024, 1024, 0, 0}; pg8::StaticOrder S; S.init(MTOK, DFF2, G, (int)blockIdx.x);
            pg8::EpiConv E{launder(p.ffn_conv_w) + (size_t)l * 3 * DFF2, launder(p.ffn_conv_b) + (size_t)l * DFF2, (bf16_t*)(ws + WS_ACT), (float*)(ws + WS_HEAD), (float*)(ws + WS_TAIL)};
            pg8::gemm_phase(lds, g, S, E);
        }
        GRID_SYNC();
        conv_fix(p, l, 0, ngt);
        GRID_SYNC();
        if (DBG_STOP == 5) { dbg_dump(p.out, (const bf16_t*)(ws + WS_ACT), nullptr, nullptr, 1024); return; }
        {
            unsigned char* ws = launder(p.ws);
            pg8::Gemm g{(const bf16_t*)(ws + WS_ACT), (const bf16_t*)(ws + WS_WDN), DFF, DFF, DFF, 0, 0}; pg8::StaticOrder S; S.init(MTOK, 1024, G, (int)blockIdx.x);
            pg8::EpiF32 E{(float*)(ws + WS_Y32B)}; pg8::gemm_phase(lds, g, S, E);
        }
        GRID_SYNC();
        if (l == 0) {
            row_phase(p.out, (const float*)(ws + WS_Y32B), p.ffn_post_g, p.out, p.mix_pre_g + DM, XN, gw, ngw, lane);
            convert_weights(p, 1, lds, gw, ngw, wave, lane);
            GRID_SYNC();
            if (DBG_STOP == 6) return;
        } else {
            row_phase(p.out, (const float*)(ws + WS_Y32B), p.ffn_post_g + DM, p.out, nullptr, nullptr, gw, ngw, lane);
        }
    }
}

extern "C" void kernel_launch(void* const* d_in, const int* in_sizes, int n_in, void* d_out, int out_size, void* d_ws, size_t ws_size, hipStream_t stream) {
    static int grid = 0;
    if (grid == 0) {
        if (n_in != 21 || out_size != MTOK * DM || ws_size < WS_END) { fprintf(stderr, "kernel_launch: unexpected shapes (n_in %d, out %d, ws %zu)\n", n_in, out_size, ws_size); grid = -1; return; }
        int dev = 0, cus = 0, per_cu = 0;
        hipGetDevice(&dev); hipDeviceGetAttribute(&cus, hipDeviceAttributeMultiprocessorCount, dev);
        if (hipFuncSetAttribute((const void*)mega_fwd, hipFuncAttributeMaxDynamicSharedMemorySize, LDS_BYTES) != hipSuccess) { fprintf(stderr, "kernel_launch: hipFuncSetAttribute failed\n"); grid = -1; return; }
        if (hipOccupancyMaxActiveBlocksPerMultiprocessor(&per_cu, (const void*)mega_fwd, 512, LDS_BYTES) != hipSuccess || per_cu < 1) { fprintf(stderr, "kernel_launch: occupancy query says %d blocks/CU\n", per_cu); per_cu = 1; }
        (void)hipGetLastError();
        grid = cus;
    }
    if (grid < 0) return;
    Params p{};
    const float** f = (const float**)&p;
    for (int i = 0; i < 21; ++i) f[i] = (const float*)d_in[i];
    p.out = (float*)d_out; p.ws = (unsigned char*)d_ws;
    void* args[] = {&p};
    hipError_t e = hipLaunchCooperativeKernel((const void*)mega_fwd, dim3(grid), dim3(512), args, LDS_BYTES, stream);
    if (e != hipSuccess) fprintf(stderr, "cooperative launch failed: %s (grid %d)\n", hipGetErrorString(e), grid);
}
```

```cpp
#include <hip/hip_runtime.h>
#include <hip/hip_cooperative_groups.h>
#include <cstdio>
#include <cstdint>
namespace cg = cooperative_groups;

#define LAS __attribute__((address_space(3)))
typedef unsigned short bf16_t;
typedef short bf16x8 __attribute__((ext_vector_type(8)));
typedef float f32x4 __attribute__((ext_vector_type(4)));
typedef unsigned u32x4 __attribute__((ext_vector_type(4)));
typedef unsigned u32x2 __attribute__((ext_vector_type(2)));

constexpr int BATCH = 8, SEQ = 4096, DM = 1024, MTOK = BATCH * SEQ;
constexpr int INW = 7184, DFF = 2816, DFF2 = 5632;
constexpr float EPS = 1e-6f;
constexpr float SB_THR = -106.0f;

constexpr size_t MiB = 1u << 20;
constexpr size_t WS_GDOWN = 1 * MiB;
constexpr size_t WS_DEC = 3 * MiB;
constexpr size_t WS_WIN = 4 * MiB;
constexpr size_t WS_WP = 19 * MiB;
constexpr size_t WS_WOUT = 22 * MiB;
constexpr size_t WS_WUP = 24 * MiB;
constexpr size_t WS_WDN = 35 * MiB;
constexpr size_t WS_XN = 41 * MiB;
constexpr size_t WS_QA = 105 * MiB, WS_U = 137 * MiB, WS_GR = 169 * MiB;
constexpr size_t WS_KA = 201 * MiB, WS_VA = 233 * MiB, WS_SV = 265 * MiB, WS_GV = 297 * MiB;
constexpr size_t WS_GQ = 329 * MiB, WS_GK = 345 * MiB;
constexpr size_t WS_UPD = 361 * MiB;
constexpr size_t WS_GATES = 201 * MiB;
constexpr size_t WS_Y32 = 105 * MiB;
constexpr size_t WS_ACT = 105 * MiB;
constexpr size_t WS_HEAD = 282 * MiB;
constexpr size_t WS_TAIL = 288 * MiB;
constexpr size_t WS_Y32B = 300 * MiB;
constexpr size_t WS_END = 428 * MiB;

constexpr int LDS_BYTES = 147456;
constexpr int MISC_OFF = 147456 - 64;
constexpr size_t WS_BAR = 0;
constexpr int XT_OFF = 131072;

typedef float f32x2_t __attribute__((ext_vector_type(2)));
typedef __bf16 bf16x2_t __attribute__((ext_vector_type(2)));
__device__ __forceinline__ unsigned cvt_pk_bf16(float lo, float hi) { const f32x2_t v = {lo, hi}; const bf16x2_t b = __builtin_convertvector(v, bf16x2_t); return __builtin_bit_cast(unsigned, b); }
__device__ __forceinline__ float bf2f(unsigned short h) { return __uint_as_float(((unsigned)h) << 16); }
__device__ __forceinline__ float bflo(unsigned w) { return __uint_as_float(w << 16); }
__device__ __forceinline__ float bfhi(unsigned w) { return __uint_as_float(w & 0xffff0000u); }
__device__ __forceinline__ unsigned short f2bf(float f) { return (unsigned short)(cvt_pk_bf16(f, 0.f) & 0xffffu); }
__device__ __forceinline__ bf16x8 pack8(f32x4 a, f32x4 b) {
    u32x4 w; w.x = cvt_pk_bf16(a[0], a[1]); w.y = cvt_pk_bf16(a[2], a[3]); w.z = cvt_pk_bf16(b[0], b[1]); w.w = cvt_pk_bf16(b[2], b[3]);
    return __builtin_bit_cast(bf16x8, w);
}
__device__ __forceinline__ float rcpf_(float x) { return __builtin_amdgcn_rcpf(x); }
__device__ __forceinline__ float gelu_tanh_f(float x) { const float u = 0.7978845608f * (x + 0.044715f * x * x * x); return x * rcpf_(1.f + __expf(-2.f * u)); }
__device__ __forceinline__ float sigmoid_f(float x) { return rcpf_(1.f + __expf(-x)); }
__device__ __forceinline__ float logsig_f(float x) { return fminf(x, 0.f) - __logf(1.f + __expf(-fabsf(x))); }
__device__ __forceinline__ f32x4 mfma16(bf16x8 a, bf16x8 b, f32x4 c) { return __builtin_amdgcn_mfma_f32_16x16x32_bf16(a, b, c, 0, 0, 0); }
__device__ __forceinline__ float wave_sum(float v) {
#pragma unroll
    for (int o = 1; o < 64; o <<= 1) v += __shfl_xor(v, o);
    return v;
}
#define LDS_WAIT() asm volatile("s_waitcnt lgkmcnt(0)" ::: "memory")
template <class T> __device__ __forceinline__ T* launder(T* p) {
    const unsigned long long v = (unsigned long long)p; unsigned lo = __builtin_amdgcn_readfirstlane((unsigned)v), hi = __builtin_amdgcn_readfirstlane((unsigned)(v >> 32));
    asm volatile("" : "+s"(lo), "+s"(hi)); return (T*)(((unsigned long long)hi << 32) | lo); }
__device__ __forceinline__ int vlaunder(int x) { asm volatile("" : "+v"(x)); return x; }
__device__ __forceinline__ float dpp_shr1(float v) { return __builtin_bit_cast(float, __builtin_amdgcn_update_dpp(0, __builtin_bit_cast(int, v), 0x111, 0xf, 0xf, true)); }
__device__ __forceinline__ float dpp_shr2(float v) { return __builtin_bit_cast(float, __builtin_amdgcn_update_dpp(0, __builtin_bit_cast(int, v), 0x112, 0xf, 0xf, true)); }
__device__ __forceinline__ float dpp_shl14(float v) { return __builtin_bit_cast(float, __builtin_amdgcn_update_dpp(0, __builtin_bit_cast(int, v), 0x10E, 0xf, 0xf, true)); }
__device__ __forceinline__ float dpp_shl15(float v) { return __builtin_bit_cast(float, __builtin_amdgcn_update_dpp(0, __builtin_bit_cast(int, v), 0x10F, 0xf, 0xf, true)); }

struct Params {
    const float* x; const float* mix_pre_g; const float* mix_post_g; const float* w_in; const float* sg_ln_g; const float* sg_ln_b; const float* sg_w; const float* sg_b;
    const float* gla_w_gup; const float* gla_b_gate; const float* gla_norm_g; const float* p_a; const float* p_b; const float* p_c; const float* w_out;
    const float* ffn_pre_g; const float* ffn_post_g; const float* ffn_w_up; const float* ffn_conv_w; const float* ffn_conv_b; const float* ffn_w_down;
    float* out; unsigned char* ws;
};
#include <cstddef>
__device__ __forceinline__ const void* karg_(int byte_off) { const char __attribute__((address_space(4)))* ka = (const char __attribute__((address_space(4)))*)__builtin_amdgcn_kernarg_segment_ptr(); return *(const void* const volatile __attribute__((address_space(4)))*)(ka + byte_off); }
#define PP(field) ((decltype(Params::field))karg_((int)offsetof(Params, field)))

namespace pg8 {
constexpr int BM = 256, BK = 64, HALF = 128, HTB = HALF * BK * 2, NXCD = 8, WGM = 8;
__device__ __forceinline__ int lds_byte(int r, int c) { const int st = (r >> 4) * 2 + (c >> 5), rr = r & 15, cc = c & 31, ob = rr * 64 + cc * 2; return st * 1024 + (ob ^ (((ob >> 9) & 1) << 5)); }
__device__ __forceinline__ void stage_rc(int b, int& R, int& C) { const int st = b / 1024, sb = b % 1024, swz = sb ^ (((sb >> 9) & 1) << 5); R = (st >> 1) * 16 + swz / 64; C = (st & 1) * 32 + (swz % 64) / 2; }
__device__ __forceinline__ int perm32(int rho) { const int n = rho >> 4, i = rho & 15; return 8 * (i >> 2) + 4 * n + (i & 3); }

struct Unit { int pm, pn; };
struct Gemm { const bf16_t* A; const bf16_t* Bt; int K, lda, ldb, adiv; size_t astride; };

struct StaticOrder {
    int nM, nN, nwg, G, c;
    __device__ __forceinline__ void init(int M, int N, int G_, int c_) { nM = M / BM; nN = N / BM; nwg = nM * nN; G = G_; c = c_; }
    __device__ __forceinline__ bool next(int i, Unit& u) const {
        const long L = (long)i * G + c; if (L >= nwg) return false;
        int wgid = (int)L; { const int q = nwg / NXCD, r = nwg % NXCD, xcd = wgid % NXCD, off = wgid / NXCD; wgid = (xcd < r ? xcd * (q + 1) : r * (q + 1) + (xcd - r) * q) + off; }
        const int nig = WGM * nN, gid = wgid / nig, fm = gid * WGM, gsz = (nM - fm) < WGM ? (nM - fm) : WGM;
        u.pm = fm + ((wgid % nig) % gsz); u.pn = (wgid % nig) / gsz; return true;
    }
};
struct MergeOrder {
    StaticOrder base;
    __device__ __forceinline__ bool next(int i, Unit& u) const { const int br = i % 3; Unit t; if (!base.next(i / 3, t)) return false; u.pm = t.pm; u.pn = t.pn + 4 * br; return true; }
};

template <class Epi, class Sched>
__device__ __forceinline__ void gemm_phase(LAS unsigned char* lds, const Gemm g, const Sched& S, const Epi& E) {
    const int tid = vlaunder((int)threadIdx.x), wid = __builtin_amdgcn_readfirstlane(tid >> 6), lane = tid & 63, wr = wid >> 2, wc = wid & 3, fr = lane & 15, fq = lane >> 4;
    const int K = g.K, nt = K / BK;
    unsigned voffA[2], voffB[2];
#pragma unroll
    for (int i = 0; i < 2; ++i) { int R, C; stage_rc(tid * 16 + i * 8192, R, C); const int Rb = Epi::PERM ? ((R & ~31) + perm32(R & 31)) : R;
        voffA[i] = (unsigned)(R * g.lda + C) * 2u; voffB[i] = (unsigned)(Rb * g.ldb + C) * 2u; }
    const size_t kstep = (size_t)(BK * 2);
    const size_t hstepA = (size_t)HALF * g.lda * 2, hstepB = (size_t)HALF * g.ldb * 2;
    const size_t tstepA = 2 * hstepA, tstepB = 2 * hstepB;
    const unsigned ldsw = (unsigned)wid * 1024u;
    const int aoff = lds_byte(wr * 64 + fr, fq * 8), boff = lds_byte(wc * 32 + fr, fq * 8);
#define PG8_SA(b, h) (((b) * 2 + (h)) * HTB)
#define PG8_SB(b, h) ((4 + (b) * 2 + (h)) * HTB)
#define PG8_STAGE(bufoff, gbase, voff) do { _Pragma("unroll") for (int _i = 0; _i < 2; ++_i) \
        __builtin_amdgcn_global_load_lds((const unsigned*)((const char*)(gbase) + (voff)[_i]), (LAS unsigned*)(lds + (bufoff) + ldsw + _i * 8192), 16, 0, 0); } while (0)
#define PG8_LDA(dst, b, h) do { _Pragma("unroll") for (int m = 0; m < 4; ++m) _Pragma("unroll") for (int k = 0; k < 2; ++k) dst[m][k] = *(const LAS bf16x8*)(lds + PG8_SA(b, h) + aoff + m * 2048 + k * 1024); } while (0)
#define PG8_LDB(dst, b, h) do { _Pragma("unroll") for (int n = 0; n < 2; ++n) _Pragma("unroll") for (int k = 0; k < 2; ++k) dst[n][k] = *(const LAS bf16x8*)(lds + PG8_SB(b, h) + boff + n * 2048 + k * 1024); } while (0)
#define PG8_MMA(ai, bj, At, Bt) do { __builtin_amdgcn_s_setprio(1); _Pragma("unroll") for (int m = 0; m < 4; ++m) _Pragma("unroll") for (int n = 0; n < 2; ++n) _Pragma("unroll") for (int k = 0; k < 2; ++k) \
        acc[ai][bj][m][n] = __builtin_amdgcn_mfma_f32_16x16x32_bf16(Bt[n][k], At[m][k], acc[ai][bj][m][n], 0, 0, 0); __builtin_amdgcn_s_setprio(0); } while (0)
#define PG8_WAIT_V(n) asm volatile("s_waitcnt vmcnt(" #n ")" ::: "memory")
#define PG8_WAIT_L(n) asm volatile("s_waitcnt lgkmcnt(" #n ")" ::: "memory")
#define PG8_BAR __builtin_amdgcn_s_barrier()
#define PG8_SCHED __builtin_amdgcn_sched_barrier(0)
    Unit cur, nxt; int ui = 0;
    if (!S.next(0, cur)) return;
    f32x4 acc[2][2][4][2];
#pragma unroll
    for (int a = 0; a < 2; ++a)
#pragma unroll
        for (int b = 0; b < 2; ++b)
#pragma unroll
            for (int m = 0; m < 4; ++m)
#pragma unroll
                for (int n = 0; n < 2; ++n) acc[a][b][m][n] = (f32x4){0.f, 0.f, 0.f, 0.f};
    bf16x8 At[4][2], B0[2][2], B1[2][2];
    const char* cA = (const char*)g.A + (size_t)cur.pm * tstepA + (g.adiv ? (size_t)(cur.pn / g.adiv) * g.astride : 0);
    const char* cB = (const char*)g.Bt + (size_t)cur.pn * tstepB;
    PG8_STAGE(PG8_SB(0, 0), cB, voffB); PG8_STAGE(PG8_SB(0, 1), cB + hstepB, voffB); PG8_STAGE(PG8_SA(0, 0), cA, voffA); PG8_STAGE(PG8_SA(0, 1), cA + hstepA, voffA);
    if (wr == 1) PG8_BAR;
    PG8_WAIT_V(2); PG8_BAR;
    PG8_STAGE(PG8_SB(1, 0), cB + kstep, voffB); PG8_STAGE(PG8_SA(1, 0), cA + kstep, voffA); PG8_STAGE(PG8_SB(1, 1), cB + hstepB + kstep, voffB);
    PG8_WAIT_V(6); PG8_BAR;
    for (;;) {
        const bool has_next = S.next(ui + 1, nxt);
        const char* nA = has_next ? (const char*)g.A + (size_t)nxt.pm * tstepA + (g.adiv ? (size_t)(nxt.pn / g.adiv) * g.astride : 0) : cA;
        const char* nB = has_next ? (const char*)g.Bt + (size_t)nxt.pn * tstepB : cB;
        for (int t = 0; t < nt; t += 2) {
            const bool last = (t == nt - 2);
            const char* a1 = cA + (size_t)(t + 1) * kstep;
            const char* a2 = last ? nA : cA + (size_t)(t + 2) * kstep; const char* b2 = last ? nB : cB + (size_t)(t + 2) * kstep;
            const char* a3 = a2 + kstep; const char* b3 = b2 + kstep;
            PG8_LDB(B0, 0, 0); PG8_LDB(B1, 0, 1); PG8_SCHED; PG8_LDA(At, 0, 0); PG8_STAGE(PG8_SA(1, 1), a1 + hstepA, voffA);
            PG8_WAIT_V(8); PG8_WAIT_L(0); PG8_BAR; PG8_MMA(0, 0, At, B0); PG8_MMA(0, 1, At, B1); PG8_BAR; PG8_SCHED;
            PG8_LDA(At, 0, 1); PG8_STAGE(PG8_SB(0, 0), b2, voffB); PG8_STAGE(PG8_SB(0, 1), b2 + hstepB, voffB); PG8_STAGE(PG8_SA(0, 0), a2, voffA);
            PG8_WAIT_V(8); PG8_WAIT_L(0); PG8_BAR; PG8_MMA(1, 0, At, B0); PG8_MMA(1, 1, At, B1); PG8_BAR; PG8_SCHED;
            PG8_LDB(B0, 1, 0); PG8_LDB(B1, 1, 1); PG8_SCHED; PG8_LDA(At, 1, 0); PG8_STAGE(PG8_SA(0, 1), a2 + hstepA, voffA);
            PG8_WAIT_V(8); PG8_WAIT_L(0); PG8_BAR; PG8_MMA(0, 0, At, B0); PG8_MMA(0, 1, At, B1); PG8_BAR; PG8_SCHED;
            PG8_LDA(At, 1, 1); PG8_STAGE(PG8_SB(1, 0), b3, voffB); PG8_STAGE(PG8_SB(1, 1), b3 + hstepB, voffB); PG8_STAGE(PG8_SA(1, 0), a3, voffA);
            PG8_WAIT_V(8); PG8_WAIT_L(0); PG8_BAR; PG8_MMA(1, 0, At, B0); PG8_MMA(1, 1, At, B1); PG8_BAR; PG8_SCHED;
        }
        if (wr == 0) PG8_BAR;
        E(acc, cur, wr, wc, fr, fq, lds);
        if (!has_next) break;
#pragma unroll
        for (int a = 0; a < 2; ++a)
#pragma unroll
            for (int b = 0; b < 2; ++b)
#pragma unroll
                for (int m = 0; m < 4; ++m)
#pragma unroll
                    for (int n = 0; n < 2; ++n) acc[a][b][m][n] = (f32x4){0.f, 0.f, 0.f, 0.f};
        cur = nxt; cA = nA; cB = nB; ++ui;
        if (wr == 1) PG8_BAR;
    }
    PG8_WAIT_V(0);
    PG8_BAR;
#undef PG8_SA
#undef PG8_SB
#undef PG8_STAGE
#undef PG8_LDA
#undef PG8_LDB
#undef PG8_MMA
#undef PG8_WAIT_V
#undef PG8_WAIT_L
#undef PG8_BAR
#undef PG8_SCHED
}

typedef const f32x4 (&AccRef)[2][2][4][2];

struct EpiG1 {
    static constexpr bool PERM = true;
    unsigned char* ws;
    __device__ __forceinline__ void operator()(f32x4 (&acc)[2][2][4][2], const Unit& u, int wr, int wc, int fr, int fq, LAS unsigned char*) const {
        const int pn = u.pn;
        const int row0 = u.pm * BM + wr * 64 + fr;
        if (pn == 16) {
            if (wc == 0 && fq < 2) { float* G = (float*)(ws + WS_GDOWN);
#pragma unroll
                for (int ai = 0; ai < 2; ++ai)
#pragma unroll
                    for (int m = 0; m < 4; ++m)
#pragma unroll
                        for (int n = 0; n < 2; ++n) *(f32x4*)(G + (size_t)(row0 + ai * HALF + m * 16) * 16 + 8 * fq + 4 * n) = acc[ai][0][m][n]; }
            return;
        }
        size_t off; int ldc = 512, colt, act = 0;
        if (pn < 2) { off = WS_QA; colt = pn * 256; }
        else if (pn < 4) { off = WS_KA; colt = (pn - 2) * 256; }
        else if (pn < 6) { off = WS_VA; colt = (pn - 4) * 256; }
        else if (pn < 8) { off = WS_U; colt = (pn - 6) * 256; act = 1; }
        else if (pn < 10) { off = WS_SV; colt = (pn - 8) * 256; act = 1; }
        else if (pn == 10) { off = WS_GQ; colt = 0; ldc = 256; }
        else if (pn == 11) { off = WS_GK; colt = 0; ldc = 256; }
        else if (pn < 14) { off = WS_GV; colt = (pn - 12) * 256; }
        else { off = WS_GR; colt = (pn - 14) * 256; act = 2; }
        bf16_t* base = (bf16_t*)(ws + off);
        const int col0 = colt + wc * 32 + 8 * fq;
#pragma unroll
        for (int ai = 0; ai < 2; ++ai)
#pragma unroll
            for (int m = 0; m < 4; ++m) { bf16_t* rowp = base + (size_t)(row0 + ai * HALF + m * 16) * ldc + col0;
#pragma unroll
                for (int bj = 0; bj < 2; ++bj) { f32x4 v0 = acc[ai][bj][m][0], v1 = acc[ai][bj][m][1];
                    if (act == 1) {
#pragma unroll
                        for (int e = 0; e < 4; ++e) { v0[e] = gelu_tanh_f(v0[e]); v1[e] = gelu_tanh_f(v1[e]); }
                    } else if (act == 2) {
#pragma unroll
                        for (int e = 0; e < 4; ++e) { v0[e] = v0[e] * sigmoid_f(v0[e]); v1[e] = v1[e] * sigmoid_f(v1[e]); }
                    }
                    u32x4 w; w.x = cvt_pk_bf16(v0[0], v0[1]); w.y = cvt_pk_bf16(v0[2], v0[3]); w.z = cvt_pk_bf16(v1[0], v1[1]); w.w = cvt_pk_bf16(v1[2], v1[3]);
                    *(u32x4*)(rowp + bj * HALF) = w; } }
    }
};
struct EpiGates {
    static constexpr bool PERM = true;
    bf16_t* O;
    __device__ __forceinline__ void operator()(f32x4 (&acc)[2][2][4][2], const Unit& u, int wr, int wc, int fr, int fq, LAS unsigned char*) const {
        const int row0 = u.pm * BM + wr * 64 + fr, col0 = u.pn * BM + wc * 32 + 8 * fq;
#pragma unroll
        for (int ai = 0; ai < 2; ++ai)
#pragma unroll
            for (int m = 0; m < 4; ++m) { bf16_t* rowp = O + (size_t)(row0 + ai * HALF + m * 16) * 3072 + col0;
#pragma unroll
                for (int bj = 0; bj < 2; ++bj) { f32x4 v0 = acc[ai][bj][m][0], v1 = acc[ai][bj][m][1];
#pragma unroll
                    for (int e = 0; e < 4; ++e) { v0[e] = sigmoid_f(v0[e]); v1[e] = sigmoid_f(v1[e]); }
                    u32x4 w; w.x = cvt_pk_bf16(v0[0], v0[1]); w.y = cvt_pk_bf16(v0[2], v0[3]); w.z = cvt_pk_bf16(v1[0], v1[1]); w.w = cvt_pk_bf16(v1[2], v1[3]);
                    *(u32x4*)(rowp + bj * HALF) = w; } }
    }
};
struct EpiMerge {
    static constexpr bool PERM = true;
    const bf16_t* gates; bf16_t* O;
    __device__ __forceinline__ void operator()(f32x4 (&acc)[2][2][4][2], const Unit& u, int wr, int wc, int fr, int fq, LAS unsigned char*) const {
        const int br = u.pn >> 2, ct = u.pn & 3;
        const int row0 = u.pm * BM + wr * 64 + fr, col0 = ct * BM + wc * 32 + 8 * fq;
#pragma unroll
        for (int ai = 0; ai < 2; ++ai)
#pragma unroll
            for (int m = 0; m < 4; ++m) { const size_t row = (size_t)(row0 + ai * HALF + m * 16);
#pragma unroll
                for (int bj = 0; bj < 2; ++bj) { f32x4 v0 = acc[ai][bj][m][0], v1 = acc[ai][bj][m][1];
                    const u32x4 gw = *(const u32x4*)(gates + row * 3072 + br * 1024 + col0 + bj * HALF);
                    v0[0] *= bflo(gw.x); v0[1] *= bfhi(gw.x); v0[2] *= bflo(gw.y); v0[3] *= bfhi(gw.y);
                    v1[0] *= bflo(gw.z); v1[1] *= bfhi(gw.z); v1[2] *= bflo(gw.w); v1[3] *= bfhi(gw.w);
                    bf16_t* op = O + row * 1024 + col0 + bj * HALF;
                    if (br > 0) { const u32x4 pw = *(const u32x4*)op;
                        v0[0] += bflo(pw.x); v0[1] += bfhi(pw.x); v0[2] += bflo(pw.y); v0[3] += bfhi(pw.y);
                        v1[0] += bflo(pw.z); v1[1] += bfhi(pw.z); v1[2] += bflo(pw.w); v1[3] += bfhi(pw.w); }
                    u32x4 w; w.x = cvt_pk_bf16(v0[0], v0[1]); w.y = cvt_pk_bf16(v0[2], v0[3]); w.z = cvt_pk_bf16(v1[0], v1[1]); w.w = cvt_pk_bf16(v1[2], v1[3]);
                    *(u32x4*)op = w; } }
    }
};
struct EpiF32 {
    static constexpr bool PERM = false;
    float* O;
    __device__ __forceinline__ void operator()(f32x4 (&acc)[2][2][4][2], const Unit& u, int wr, int wc, int fr, int fq, LAS unsigned char*) const {
        const int row0 = u.pm * BM + wr * 64 + fr, col0 = u.pn * BM + wc * 32 + 4 * fq;
#pragma unroll
        for (int ai = 0; ai < 2; ++ai)
#pragma unroll
            for (int m = 0; m < 4; ++m) { float* rowp = O + (size_t)(row0 + ai * HALF + m * 16) * 1024 + col0;
#pragma unroll
                for (int bj = 0; bj < 2; ++bj)
#pragma unroll
                    for (int n = 0; n < 2; ++n) *(f32x4*)(rowp + bj * HALF + n * 16) = acc[ai][bj][m][n]; }
    }
};
struct EpiConv {
    static constexpr bool PERM = true;
    const float* cw; const float* cb; bf16_t* act; float* head; float* tail;
    __device__ __forceinline__ void operator()(f32x4 (&acc)[2][2][4][2], const Unit& u, int wr, int wc, int fr, int fq, LAS unsigned char* lds) const {
        LAS float* XT = (LAS float*)(lds + XT_OFF);
        const int ccol = wc * 32 + 8 * fq;
        if (fr >= 14) {
#pragma unroll
            for (int ai = 0; ai < 2; ++ai)
#pragma unroll
                for (int bj = 0; bj < 2; ++bj)
#pragma unroll
                    for (int n = 0; n < 2; ++n) *(LAS f32x4*)(XT + ((ai * 2 + wr) * 2 + (fr - 14)) * 256 + bj * HALF + ccol + 4 * n) = acc[ai][bj][3][n];
            if (wr == 1) {
#pragma unroll
                for (int bj = 0; bj < 2; ++bj)
#pragma unroll
                    for (int n = 0; n < 2; ++n) *(f32x4*)(tail + ((size_t)u.pm * 2 + (fr - 14)) * DFF2 + u.pn * BM + bj * HALF + ccol + 4 * n) = acc[1][bj][3][n];
            }
        }
        if (fr < 2 && wr == 0) {
#pragma unroll
            for (int bj = 0; bj < 2; ++bj)
#pragma unroll
                for (int n = 0; n < 2; ++n) *(f32x4*)(head + ((size_t)u.pm * 2 + fr) * DFF2 + u.pn * BM + bj * HALF + ccol + 4 * n) = acc[0][bj][0][n];
        }
        asm volatile("s_waitcnt lgkmcnt(0)" ::: "memory"); __builtin_amdgcn_s_barrier(); asm volatile("" ::: "memory");
#pragma unroll
        for (int n = 0; n < 2; ++n) {
            const int ch = u.pn * HALF + ccol + 4 * n;
            const f32x4 wa0 = *(const f32x4*)(cw + ch), wa1 = *(const f32x4*)(cw + DFF2 + ch), wa2 = *(const f32x4*)(cw + 2 * DFF2 + ch), ba = *(const f32x4*)(cb + ch);
            const f32x4 wu0 = *(const f32x4*)(cw + DFF + ch), wu1 = *(const f32x4*)(cw + DFF2 + DFF + ch), wu2 = *(const f32x4*)(cw + 2 * DFF2 + DFF + ch), bu = *(const f32x4*)(cb + DFF + ch);
#pragma unroll
            for (int ai = 1; ai >= 0; --ai)
#pragma unroll
                for (int m = 3; m >= 0; --m) {
                    f32x4 pa, pu;
                    if (m > 0) { pa = acc[ai][0][m - 1][n]; pu = acc[ai][1][m - 1][n]; }
                    else {
                        const int slot = ai * 2 + wr - 1;
                        if (slot >= 0) { pa = *(const LAS f32x4*)(XT + (slot * 2 + (fr & 1)) * 256 + ccol + 4 * n); pu = *(const LAS f32x4*)(XT + (slot * 2 + (fr & 1)) * 256 + HALF + ccol + 4 * n); }
                        else { pa = (f32x4){0.f, 0.f, 0.f, 0.f}; pu = pa; }
                    }
                    f32x4 xa = acc[ai][0][m][n], xu = acc[ai][1][m][n];
                    asm volatile("" : "+v"(xa), "+v"(xu), "+v"(pa), "+v"(pu));
                    f32x4 res;
#pragma unroll
                    for (int e = 0; e < 4; ++e) {
                        const float a1 = dpp_shr1(xa[e]) + dpp_shl15(pa[e]), a2 = dpp_shr2(xa[e]) + dpp_shl14(pa[e]);
                        const float u1 = dpp_shr1(xu[e]) + dpp_shl15(pu[e]), u2 = dpp_shr2(xu[e]) + dpp_shl14(pu[e]);
                        const float ca = ba[e] + wa0[e] * a2 + wa1[e] * a1 + wa2[e] * xa[e];
                        const float cu = bu[e] + wu0[e] * u2 + wu1[e] * u1 + wu2[e] * xu[e];
                        res[e] = gelu_tanh_f(ca) * cu;
                    }
                    asm volatile("" : "+v"(res));
                    acc[ai][0][m][n] = res;
                }
        }
        const int row0 = u.pm * BM + wr * 64 + fr;
#pragma unroll
        for (int ai = 0; ai < 2; ++ai)
#pragma unroll
            for (int m = 0; m < 4; ++m) { const f32x4 v0 = acc[ai][0][m][0], v1 = acc[ai][0][m][1];
                u32x4 w; w.x = cvt_pk_bf16(v0[0], v0[1]); w.y = cvt_pk_bf16(v0[2], v0[3]); w.z = cvt_pk_bf16(v1[0], v1[1]); w.w = cvt_pk_bf16(v1[2], v1[3]);
                *(u32x4*)(act + (size_t)(row0 + ai * HALF + m * 16) * DFF + u.pn * HALF + ccol) = w; }
    }
};
}

__device__ __forceinline__ void transpose_item(const float* W, int ldsrc, int k0, int nsrc0, bf16_t* WT, int K, int ndst0, LAS float* scr, int lane) {
#pragma unroll 8
    for (int i = 0; i < 32; ++i) { const int kk = 2 * i + (lane >> 5); scr[kk * 33 + (lane & 31)] = W[(size_t)(k0 + kk) * ldsrc + nsrc0 + (lane & 31)]; }
    LDS_WAIT(); asm volatile("" ::: "memory");
    const int c = lane & 7;
#pragma unroll
    for (int j = 0; j < 4; ++j) { const int n = (lane >> 3) + 8 * j; const LAS float* s = scr + (8 * c) * 33 + n;
        u32x4 o; o.x = cvt_pk_bf16(s[0 * 33], s[1 * 33]); o.y = cvt_pk_bf16(s[2 * 33], s[3 * 33]); o.z = cvt_pk_bf16(s[4 * 33], s[5 * 33]); o.w = cvt_pk_bf16(s[6 * 33], s[7 * 33]);
        *(u32x4*)(WT + (size_t)(ndst0 + n) * K + k0 + 8 * c) = o; }
    LDS_WAIT(); asm volatile("" ::: "memory");
}
__device__ __forceinline__ void convert_weights(const Params& p, int l, LAS unsigned char* lds, int gw, int ngw, int wave, int lane) {
    lane = vlaunder(lane);
    LAS float* scr = (LAS float*)(lds + wave * 16384);
    unsigned char* ws = launder(PP(ws));
    bf16_t* Win = (bf16_t*)(ws + WS_WIN); bf16_t* WP = (bf16_t*)(ws + WS_WP); bf16_t* WO = (bf16_t*)(ws + WS_WOUT); bf16_t* WU = (bf16_t*)(ws + WS_WUP); bf16_t* WD = (bf16_t*)(ws + WS_WDN);
    const float* w_in = launder(PP(w_in)) + (size_t)l * DM * INW;
    constexpr int I0 = 16 * 128, I1 = 16 * 96, I2 = 8 * 32, I5 = 16 * 32, I6 = 16 * 176, I7 = 44 * 32;
    constexpr int NITEMS = I0 + I1 + 3 * I2 + I5 + I6 + I7;
    for (int it = gw; it < NITEMS; it += ngw) {
        int r = it;
        if (r < I0) { const int kb = r / 128, nb = r % 128; transpose_item(w_in, INW, 64 * kb, 32 * nb, Win, 1024, 32 * nb, scr, lane); continue; } r -= I0;
        if (r < I1) { const int kb = r / 96, nb = r % 96; transpose_item(w_in, INW, 64 * kb, 4112 + 32 * nb, Win, 1024, 4352 + 32 * nb, scr, lane); continue; } r -= I1;
        if (r < 3 * I2) { const int br = r / I2, q = r % I2, kb = q / 32, nb = q % 32;
            const float* src = launder(br == 0 ? PP(p_a) : (br == 1 ? PP(p_b) : PP(p_c))) + (size_t)l * 512 * 1024;
            transpose_item(src, 1024, 64 * kb, 32 * nb, WP, 512, 1024 * br + 32 * nb, scr, lane); continue; } r -= 3 * I2;
        if (r < I5) { const int kb = r / 32, nb = r % 32; transpose_item(launder(PP(w_out)) + (size_t)l * 1024 * 1024, 1024, 64 * kb, 32 * nb, WO, 1024, 32 * nb, scr, lane); continue; } r -= I5;
        if (r < I6) { const int kb = r / 176, nb = r % 176, j = nb >> 3, half = (nb >> 2) & 1, q = nb & 3;
            transpose_item(launder(PP(ffn_w_up)) + (size_t)l * 1024 * DFF2, DFF2, 64 * kb, DFF * half + 128 * j + 32 * q, WU, 1024, 256 * j + 128 * half + 32 * q, scr, lane); continue; } r -= I6;
        { const int kb = r / 32, nb = r % 32; transpose_item(launder(PP(ffn_w_down)) + (size_t)l * DFF * 1024, 1024, 64 * kb, 32 * nb, WD, DFF, 32 * nb, scr, lane); }
    }
    for (int idx = gw * 64 + lane; idx < 256 * 1024; idx += ngw * 64) { const int n = idx >> 10, k = idx & 1023;
        const float v = (n < 16) ? w_in[(size_t)k * INW + 4096 + n] : 0.f; Win[(size_t)(4096 + n) * 1024 + k] = f2bf(v); }
}

__device__ __forceinline__ void row_phase(const float* hin, const float* y, const float* gpost, float* hout, const float* gpre, bf16_t* xn, int gw, int ngw, int lane) {
    hin = launder(hin); y = launder(y); hout = launder(hout); xn = launder(xn); gpost = launder(gpost); gpre = launder(gpre); lane = vlaunder(lane);
    for (int m = gw; m < MTOK; m += ngw) {
        const f32x4* hr = (const f32x4*)(hin + (size_t)m * DM) + lane;
        f32x4 v[4];
#pragma unroll
        for (int j = 0; j < 4; ++j) v[j] = hr[64 * j];
        if (y) {
            const f32x4* yr = (const f32x4*)(y + (size_t)m * DM) + lane; f32x4 yv[4]; float s = 0.f;
#pragma unroll
            for (int j = 0; j < 4; ++j) { yv[j] = yr[64 * j]; s += (yv[j].x * yv[j].x + yv[j].y * yv[j].y) + (yv[j].z * yv[j].z + yv[j].w * yv[j].w); }
            const float r = 1.0f / sqrtf(wave_sum(s) * (1.f / DM) + EPS);
#pragma unroll
            for (int j = 0; j < 4; ++j) { const f32x4 gp = *((const f32x4*)gpost + lane + 64 * j); v[j] += yv[j] * r * gp; }
        }
        f32x4* ho = (f32x4*)(hout + (size_t)m * DM) + lane;
#pragma unroll
        for (int j = 0; j < 4; ++j) ho[64 * j] = v[j];
        if (xn) {
            float s = 0.f;
#pragma unroll
            for (int j = 0; j < 4; ++j) s += (v[j].x * v[j].x + v[j].y * v[j].y) + (v[j].z * v[j].z + v[j].w * v[j].w);
            const float r = 1.0f / sqrtf(wave_sum(s) * (1.f / DM) + EPS);
            u32x2* xo = (u32x2*)(xn + (size_t)m * DM) + lane;
#pragma unroll
            for (int j = 0; j < 4; ++j) { const f32x4 g = *((const f32x4*)gpre + lane + 64 * j); const f32x4 o = v[j] * r * g; u32x2 w; w.x = cvt_pk_bf16(o.x, o.y); w.y = cvt_pk_bf16(o.z, o.w); xo[64 * j] = w; }
        }
    }
}

__device__ __forceinline__ void sb_phase(LAS unsigned char* lds, unsigned char* ws, int tid, int wave, int lane) {
    ws = launder(ws); tid = vlaunder(tid); lane = tid & 63;
    bf16_t* QA = (bf16_t*)(ws + WS_QA); const bf16_t* KA = (const bf16_t*)(ws + WS_KA); const bf16_t* VA = (const bf16_t*)(ws + WS_VA);
    LAS bf16_t* sK = (LAS bf16_t*)lds;
    LAS bf16_t* sVt = (LAS bf16_t*)(lds + 9216);
    const int r = lane & 15, g = lane >> 4;
    for (int u = blockIdx.x; u < BATCH * 8 * 32; u += gridDim.x) {
        const int b = u >> 8, h = (u >> 5) & 7, qb = u & 31;
        const int tq0 = qb * 128 + wave * 16, t = tq0 + r;
        const size_t rowbase = (size_t)b * SEQ;
        bf16x8 qf[2];
#pragma unroll
        for (int ks = 0; ks < 2; ++ks) qf[ks] = *(const bf16x8*)(QA + (rowbase + t) * 512 + h * 64 + 32 * ks + 8 * g);
        f32x4 o[4];
#pragma unroll
        for (int i = 0; i < 4; ++i) o[i] = (f32x4){0.f, 0.f, 0.f, 0.f};
        float carry = 0.f;
        for (int kt = qb * 2 + 1; kt >= 0; --kt) {
            {
                const int key = tid >> 3, ch = tid & 7;
                const size_t goff = (rowbase + kt * 64 + key) * 512 + h * 64 + 8 * ch;
                const u32x4 kv = *(const u32x4*)(KA + goff); const u32x4 vv = *(const u32x4*)(VA + goff);
                *(LAS u32x4*)(sK + key * 72 + 8 * ch) = kv;
                LAS bf16_t* vd = sVt + (8 * ch) * 68 + key;
                vd[0 * 68] = (bf16_t)(vv.x & 0xffff); vd[1 * 68] = (bf16_t)(vv.x >> 16); vd[2 * 68] = (bf16_t)(vv.y & 0xffff); vd[3 * 68] = (bf16_t)(vv.y >> 16);
                vd[4 * 68] = (bf16_t)(vv.z & 0xffff); vd[5 * 68] = (bf16_t)(vv.z >> 16); vd[6 * 68] = (bf16_t)(vv.w & 0xffff); vd[7 * 68] = (bf16_t)(vv.w >> 16);
            }
            __syncthreads();
            const bool active = (kt * 64) < (tq0 + 15);
            if (active) {
                f32x4 s[4];
#pragma unroll
                for (int kb = 0; kb < 4; ++kb) { s[kb] = (f32x4){0.f, 0.f, 0.f, 0.f};
#pragma unroll
                    for (int ks = 0; ks < 2; ++ks) { const bf16x8 a = *(const LAS bf16x8*)(sK + (16 * kb + r) * 72 + 32 * ks + 8 * g); s[kb] = mfma16(a, qf[ks], s[kb]); } }
                f32x4 w[4];
#pragma unroll
                for (int kb = 3; kb >= 0; --kb) {
                    float l[4], ls[4]; bool mk[4];
#pragma unroll
                    for (int j = 0; j < 4; ++j) { const int key = kt * 64 + 16 * kb + 4 * g + j; const float z = s[kb][j] * 0.125f; mk[j] = key < t;
                        const float lsz = logsig_f(z); ls[j] = lsz; l[j] = mk[j] ? (lsz - z) : 0.f; }
                    const float sg = (l[0] + l[1]) + (l[2] + l[3]);
                    const float a_ = __shfl_xor(sg, 16); const float b_ = sg + a_; const float c_ = __shfl_xor(b_, 32);
                    const float suf = ((g & 1) == 0 ? a_ : 0.f) + ((g & 2) == 0 ? c_ : 0.f);
                    const float t3 = carry + suf, t2 = t3 + l[3], t1 = t2 + l[2], t0 = t1 + l[1];
                    w[kb][0] = mk[0] ? __expf(ls[0] + t0) : 0.f; w[kb][1] = mk[1] ? __expf(ls[1] + t1) : 0.f;
                    w[kb][2] = mk[2] ? __expf(ls[2] + t2) : 0.f; w[kb][3] = mk[3] ? __expf(ls[3] + t3) : 0.f;
                    carry += b_ + c_;
                }
#pragma unroll
                for (int sI = 0; sI < 2; ++sI) {
                    const bf16x8 pb = pack8(w[2 * sI], w[2 * sI + 1]);
#pragma unroll
                    for (int dvb = 0; dvb < 4; ++dvb) {
                        const LAS bf16_t* vp = sVt + (16 * dvb + r) * 68 + 32 * sI + 4 * g;
                        const u32x2 lo = *(const LAS u32x2*)vp, hi = *(const LAS u32x2*)(vp + 16);
                        u32x4 av; av.x = lo.x; av.y = lo.y; av.z = hi.x; av.w = hi.y;
                        o[dvb] = mfma16(__builtin_bit_cast(bf16x8, av), pb, o[dvb]);
                    }
                }
            }
            const int done = __all(carry < SB_THR) ? 1 : 0;
            if (__syncthreads_and(done)) break;
        }
#pragma unroll
        for (int dvb = 0; dvb < 4; ++dvb) { u32x2 w2; w2.x = cvt_pk_bf16(o[dvb][0], o[dvb][1]); w2.y = cvt_pk_bf16(o[dvb][2], o[dvb][3]);
            *(u32x2*)(QA + (rowbase + t) * 512 + h * 64 + 16 * dvb + 4 * g) = w2; }
        __syncthreads();
    }
}

__device__ __forceinline__ void sg_phase(LAS unsigned char* lds, const Params& p, int l, int tid, int wave, int lane) {
    unsigned char* ws = launder(PP(ws)); tid = vlaunder(tid); lane = tid & 63;
    bf16_t* U = (bf16_t*)(ws + WS_U); const bf16_t* SV = (const bf16_t*)(ws + WS_SV);
    LAS bf16_t* sVn = (LAS bf16_t*)(lds + wave * (64 * 136 * 2));
    LAS float* sSt = (LAS float*)(lds + 8 * 64 * 136 * 2);
    const int r = lane & 15, gq = lane >> 4;
    const float* lng = launder(PP(sg_ln_g)) + l * 512; const float* lnb = launder(PP(sg_ln_b)) + l * 512;
    const float* W = launder(PP(sg_w)) + ((size_t)(l * 8 + wave)) * 128 * 128;
    const float* Bs = launder(PP(sg_b)) + (l * 8 + wave) * 128;
    for (int u = blockIdx.x; u < BATCH * 32; u += gridDim.x) {
        const size_t row0 = (size_t)u * 128;
        for (int i = 0; i < 16; ++i) {
            const int tok = wave * 16 + i;
            const u32x4 vv = *(const u32x4*)(SV + (row0 + tok) * 512 + 8 * lane);
            float x[8] = {bflo(vv.x), bfhi(vv.x), bflo(vv.y), bfhi(vv.y), bflo(vv.z), bfhi(vv.z), bflo(vv.w), bfhi(vv.w)};
            float s = 0.f;
#pragma unroll
            for (int e = 0; e < 8; ++e) s += x[e];
            const float mu = wave_sum(s) * (1.f / 512.f);
            float q = 0.f;
#pragma unroll
            for (int e = 0; e < 8; ++e) { const float d = x[e] - mu; q += d * d; }
            const float rs = 1.0f / sqrtf(wave_sum(q) * (1.f / 512.f) + EPS);
            if (lane == 0) { sSt[tok * 2] = mu; sSt[tok * 2 + 1] = rs; }
        }
        __syncthreads();
#pragma unroll
        for (int i = 0; i < 2; ++i) {
            const int s = lane + 64 * i; const float mu = sSt[s * 2], rs = sSt[s * 2 + 1];
#pragma unroll
            for (int c = 0; c < 8; ++c) {
                const u32x4 vv = *(const u32x4*)(SV + (row0 + s) * 512 + wave * 64 + 8 * c);
                const float x[8] = {bflo(vv.x), bfhi(vv.x), bflo(vv.y), bfhi(vv.y), bflo(vv.z), bfhi(vv.z), bflo(vv.w), bfhi(vv.w)};
                const f32x4 g0 = *(const f32x4*)(lng + wave * 64 + 8 * c), g1 = *(const f32x4*)(lng + wave * 64 + 8 * c + 4);
                const f32x4 b0 = *(const f32x4*)(lnb + wave * 64 + 8 * c), b1 = *(const f32x4*)(lnb + wave * 64 + 8 * c + 4);
#pragma unroll
                for (int e = 0; e < 8; ++e) { const float gg = e < 4 ? g0[e & 3] : g1[e & 3], bb = e < 4 ? b0[e & 3] : b1[e & 3];
                    sVn[(8 * c + e) * 136 + s] = f2bf((x[e] - mu) * rs * gg + bb); }
            }
        }
        __syncthreads();
        for (int tb = 0; tb < 8; ++tb) {
            f32x4 acc[4];
#pragma unroll
            for (int i = 0; i < 4; ++i) acc[i] = (f32x4){0.f, 0.f, 0.f, 0.f};
            const int t = 16 * tb + r;
            for (int ks = 0; ks <= (tb >> 1); ++ks) {
                const int s0 = 32 * ks + 8 * gq;
                f32x4 w0 = *(const f32x4*)(W + t * 128 + s0), w1 = *(const f32x4*)(W + t * 128 + s0 + 4);
#pragma unroll
                for (int e = 0; e < 4; ++e) { if (s0 + e > t) w0[e] = 0.f; if (s0 + 4 + e > t) w1[e] = 0.f; }
                const bf16x8 a = pack8(w0, w1);
#pragma unroll
                for (int db = 0; db < 4; ++db) { const bf16x8 bb = *(const LAS bf16x8*)(sVn + (16 * db + r) * 136 + s0); acc[db] = mfma16(a, bb, acc[db]); }
            }
#pragma unroll
            for (int j = 0; j < 4; ++j) { const int tt = 16 * tb + 4 * gq + j; const float bsv = Bs[tt];
#pragma unroll
                for (int db = 0; db < 4; ++db) { bf16_t* up = U + (row0 + tt) * 512 + wave * 64 + 16 * db + r; *up = f2bf(bf2f(*up) * (acc[db][j] + bsv)); } }
        }
        __syncthreads();
    }
}

template <bool PASS_C>
__device__ __forceinline__ void gla_phase(LAS unsigned char* lds, const Params& p, int l, int tid, int wave, int lane) {
    unsigned char* ws = launder(PP(ws)); tid = vlaunder(tid); lane = tid & 63;
    const bf16_t* GQ = (const bf16_t*)(ws + WS_GQ); const bf16_t* GK = (const bf16_t*)(ws + WS_GK); const bf16_t* GV = (const bf16_t*)(ws + WS_GV);
    bf16_t* GR = (bf16_t*)(ws + WS_GR); const float* GD = (const float*)(ws + WS_GDOWN); float* UPD = (float*)(ws + WS_UPD); float* DEC = (float*)(ws + WS_DEC);
    LAS float* sCum = (LAS float*)lds;
    LAS float* sTot = (LAS float*)(lds + 16384);
    LAS bf16_t* sQD = (LAS bf16_t*)(lds + 18432);
    LAS bf16_t* sKI = (LAS bf16_t*)(lds + 27648);
    LAS bf16_t* sKEt = (LAS bf16_t*)(lds + 36864);
    LAS bf16_t* sVt = (LAS bf16_t*)(lds + 46080);
    LAS bf16_t* sAT = (LAS bf16_t*)(lds + 64512);
    LAS bf16_t* sSt = (LAS bf16_t*)(lds + 73728);
    LAS float* sSS = (LAS float*)(lds + 92160);
    const int r = lane & 15, gq = lane >> 4;
    const float* wgup = launder(PP(gla_w_gup)) + l * 16 * 256; const float* bgate = launder(PP(gla_b_gate)) + l * 256; const float* ng = launder(PP(gla_norm_g)) + l * 128;
    for (int u = blockIdx.x; u < BATCH * 4 * 64; u += gridDim.x) {
        const int b = u >> 8, h = (u >> 6) & 3, n = u & 63;
        const size_t r0 = (size_t)b * SEQ + n * 64;
        const int t_ = tid >> 3, k8 = (tid & 7) * 8;
        {
            const f32x4* gdp = (const f32x4*)(GD + (r0 + t_) * 16);
            const f32x4 g0 = gdp[0], g1 = gdp[1], g2 = gdp[2], g3 = gdp[3];
            const float gd[16] = {g0[0], g0[1], g0[2], g0[3], g1[0], g1[1], g1[2], g1[3], g2[0], g2[1], g2[2], g2[3], g3[0], g3[1], g3[2], g3[3]};
            f32x4 a0 = *(const f32x4*)(bgate + h * 64 + k8), a1 = *(const f32x4*)(bgate + h * 64 + k8 + 4);
#pragma unroll
            for (int rr = 0; rr < 16; ++rr) { const f32x4 w0 = *(const f32x4*)(wgup + rr * 256 + h * 64 + k8), w1 = *(const f32x4*)(wgup + rr * 256 + h * 64 + k8 + 4); a0 += w0 * gd[rr]; a1 += w1 * gd[rr]; }
            f32x4 o0, o1;
#pragma unroll
            for (int e = 0; e < 4; ++e) { o0[e] = logsig_f(a0[e]) * 0.0625f; o1[e] = logsig_f(a1[e]) * 0.0625f; }
            *(LAS f32x4*)(sCum + t_ * 64 + k8) = o0; *(LAS f32x4*)(sCum + t_ * 64 + k8 + 4) = o1;
        }
        __syncthreads();
        {
            const int k = tid & 63, seg = tid >> 6; float run = 0.f;
#pragma unroll
            for (int i = 0; i < 8; ++i) { run += sCum[(8 * seg + i) * 64 + k]; sCum[(8 * seg + i) * 64 + k] = run; }
            sTot[seg * 64 + k] = run;
            __syncthreads();
            float pre = 0.f;
#pragma unroll
            for (int s = 0; s < 7; ++s) pre += (s < seg) ? sTot[s * 64 + k] : 0.f;
#pragma unroll
            for (int i = 0; i < 8; ++i) sCum[(8 * seg + i) * 64 + k] += pre;
        }
        __syncthreads();
        {
            const f32x4 c0 = *(const LAS f32x4*)(sCum + t_ * 64 + k8), c1 = *(const LAS f32x4*)(sCum + t_ * 64 + k8 + 4);
            const f32x4 e0 = *(const LAS f32x4*)(sCum + 63 * 64 + k8), e1 = *(const LAS f32x4*)(sCum + 63 * 64 + k8 + 4);
            const u32x4 kw = *(const u32x4*)(GK + (r0 + t_) * 256 + h * 64 + k8);
            const float kk[8] = {bflo(kw.x), bfhi(kw.x), bflo(kw.y), bfhi(kw.y), bflo(kw.z), bfhi(kw.z), bflo(kw.w), bfhi(kw.w)};
            const float cm[8] = {c0[0], c0[1], c0[2], c0[3], c1[0], c1[1], c1[2], c1[3]};
            const float ce[8] = {e0[0], e0[1], e0[2], e0[3], e1[0], e1[1], e1[2], e1[3]};
            if (PASS_C) {
                const u32x4 qw = *(const u32x4*)(GQ + (r0 + t_) * 256 + h * 64 + k8);
                const float qq[8] = {bflo(qw.x), bfhi(qw.x), bflo(qw.y), bfhi(qw.y), bflo(qw.z), bfhi(qw.z), bflo(qw.w), bfhi(qw.w)};
                f32x4 qa, qb, ka, kb;
#pragma unroll
                for (int e = 0; e < 4; ++e) { qa[e] = qq[e] * 0.125f * __expf(cm[e]); qb[e] = qq[e + 4] * 0.125f * __expf(cm[e + 4]); ka[e] = kk[e] * __expf(-cm[e]); kb[e] = kk[e + 4] * __expf(-cm[e + 4]); }
                *(LAS bf16x8*)(sQD + t_ * 72 + k8) = pack8(qa, qb); *(LAS bf16x8*)(sKI + t_ * 72 + k8) = pack8(ka, kb);
                const int dv = tid >> 2, kq = (tid & 3) * 16; const f32x4* sp = (const f32x4*)(UPD + ((size_t)u * 128 + dv) * 64 + kq);
                const f32x4 s0 = sp[0], s1 = sp[1], s2 = sp[2], s3 = sp[3];
                *(LAS bf16x8*)(sSt + dv * 72 + kq) = pack8(s0, s1); *(LAS bf16x8*)(sSt + dv * 72 + kq + 8) = pack8(s2, s3);
            } else {
#pragma unroll
                for (int e = 0; e < 8; ++e) sKEt[(k8 + e) * 72 + t_] = f2bf(kk[e] * __expf(ce[e] - cm[e]));
                if (t_ == 63) {
#pragma unroll
                    for (int e = 0; e < 8; ++e) DEC[(size_t)u * 64 + k8 + e] = __expf(ce[e]);
                }
            }
            const int s = tid >> 3, c = tid & 7;
            const u32x4 v0 = *(const u32x4*)(GV + (r0 + s) * 512 + h * 128 + 16 * c), v1 = *(const u32x4*)(GV + (r0 + s) * 512 + h * 128 + 16 * c + 8);
            LAS bf16_t* vd = sVt + (16 * c) * 72 + s;
            vd[0 * 72] = (bf16_t)(v0.x & 0xffff); vd[1 * 72] = (bf16_t)(v0.x >> 16); vd[2 * 72] = (bf16_t)(v0.y & 0xffff); vd[3 * 72] = (bf16_t)(v0.y >> 16);
            vd[4 * 72] = (bf16_t)(v0.z & 0xffff); vd[5 * 72] = (bf16_t)(v0.z >> 16); vd[6 * 72] = (bf16_t)(v0.w & 0xffff); vd[7 * 72] = (bf16_t)(v0.w >> 16);
            vd[8 * 72] = (bf16_t)(v1.x & 0xffff); vd[9 * 72] = (bf16_t)(v1.x >> 16); vd[10 * 72] = (bf16_t)(v1.y & 0xffff); vd[11 * 72] = (bf16_t)(v1.y >> 16);
            vd[12 * 72] = (bf16_t)(v1.z & 0xffff); vd[13 * 72] = (bf16_t)(v1.z >> 16); vd[14 * 72] = (bf16_t)(v1.w & 0xffff); vd[15 * 72] = (bf16_t)(v1.w >> 16);
        }
        __syncthreads();
        if (!PASS_C) {
#pragma unroll
            for (int kb = 0; kb < 4; ++kb) { f32x4 acc = (f32x4){0.f, 0.f, 0.f, 0.f};
#pragma unroll
                for (int ks = 0; ks < 2; ++ks) { const bf16x8 a = *(const LAS bf16x8*)(sKEt + (16 * kb + r) * 72 + 32 * ks + 8 * gq); const bf16x8 bb = *(const LAS bf16x8*)(sVt + (16 * wave + r) * 72 + 32 * ks + 8 * gq); acc = mfma16(a, bb, acc); }
                *(f32x4*)(UPD + ((size_t)u * 128 + 16 * wave + r) * 64 + 16 * kb + 4 * gq) = acc; }
        } else {
            {
                const int tb = wave >> 1;
#pragma unroll
                for (int i = 0; i < 2; ++i) { const int sb = 2 * (wave & 1) + i;
                    f32x4 acc = (f32x4){0.f, 0.f, 0.f, 0.f};
                    if (sb <= tb) {
#pragma unroll
                        for (int ks = 0; ks < 2; ++ks) { const bf16x8 a = *(const LAS bf16x8*)(sQD + (16 * tb + r) * 72 + 32 * ks + 8 * gq); const bf16x8 bb = *(const LAS bf16x8*)(sKI + (16 * sb + r) * 72 + 32 * ks + 8 * gq); acc = mfma16(a, bb, acc); }
                    }
#pragma unroll
                    for (int j = 0; j < 4; ++j) { const int tt = 16 * tb + 4 * gq + j, ss = 16 * sb + r; sAT[tt * 72 + ss] = f2bf((sb <= tb && ss <= tt) ? acc[j] : 0.f); } }
            }
            __syncthreads();
            const int tb = wave & 3, hv = wave >> 2;
            f32x4 acc[4];
#pragma unroll
            for (int i = 0; i < 4; ++i) { acc[i] = (f32x4){0.f, 0.f, 0.f, 0.f}; const int dvb = 4 * hv + i;
#pragma unroll
                for (int ks = 0; ks < 2; ++ks) {
                    const bf16x8 a1 = *(const LAS bf16x8*)(sAT + (16 * tb + r) * 72 + 32 * ks + 8 * gq); const bf16x8 b1 = *(const LAS bf16x8*)(sVt + (16 * dvb + r) * 72 + 32 * ks + 8 * gq); acc[i] = mfma16(a1, b1, acc[i]);
                    const bf16x8 a2 = *(const LAS bf16x8*)(sQD + (16 * tb + r) * 72 + 32 * ks + 8 * gq); const bf16x8 b2 = *(const LAS bf16x8*)(sSt + (16 * dvb + r) * 72 + 32 * ks + 8 * gq); acc[i] = mfma16(a2, b2, acc[i]);
                } }
            float ss[4];
#pragma unroll
            for (int j = 0; j < 4; ++j) { float q = 0.f;
#pragma unroll
                for (int i = 0; i < 4; ++i) q += acc[i][j] * acc[i][j];
                q += __shfl_xor(q, 1); q += __shfl_xor(q, 2); q += __shfl_xor(q, 4); q += __shfl_xor(q, 8); ss[j] = q; }
            if (r == 0) {
#pragma unroll
                for (int j = 0; j < 4; ++j) sSS[hv * 64 + 16 * tb + 4 * gq + j] = ss[j];
            }
            __syncthreads();
#pragma unroll
            for (int j = 0; j < 4; ++j) { const int tt = 16 * tb + 4 * gq + j; const float rs = 1.0f / sqrtf((sSS[tt] + sSS[64 + tt]) * (1.f / 128.f) + EPS);
#pragma unroll
                for (int i = 0; i < 4; ++i) { const int dv = 16 * (4 * hv + i) + r; bf16_t* gp = GR + (r0 + tt) * 512 + h * 128 + dv; *gp = f2bf(acc[i][j] * rs * ng[dv] * bf2f(*gp)); } }
        }
        __syncthreads();
    }
}
__device__ __forceinline__ void gla_scan(unsigned char* ws, int gtid, int ngt) {
    ws = launder(ws); gtid = blockIdx.x * 512 + vlaunder((int)threadIdx.x);
    float* UPD = (float*)(ws + WS_UPD); const float* DEC = (const float*)(ws + WS_DEC);
    for (int e = gtid; e < 32 * 8192; e += ngt) {
        const int bh = e >> 13, rem = e & 8191, dk = rem & 63; float S = 0.f;
#pragma unroll 8
        for (int n = 0; n < 64; ++n) { const size_t idx = ((size_t)(bh * 64 + n)) * 8192 + rem; const float uv = UPD[idx]; UPD[idx] = S; S = DEC[(bh * 64 + n) * 64 + dk] * S + uv; }
    }
}
__device__ __forceinline__ void conv_fix(const Params& p, int l, int gtid, int ngt) {
    unsigned char* ws = launder(PP(ws)); gtid = blockIdx.x * 512 + vlaunder((int)threadIdx.x);
    const float* head = (const float*)(ws + WS_HEAD); const float* tail = (const float*)(ws + WS_TAIL); bf16_t* act = (bf16_t*)(ws + WS_ACT);
    const float* cw = launder(PP(ffn_conv_w)) + (size_t)l * 3 * DFF2; const float* cb = launder(PP(ffn_conv_b)) + (size_t)l * DFF2;
    for (int e = gtid; e < 128 * DFF; e += ngt) {
        const int pm = e / DFF, c = e % DFF, j = c >> 7, cc = c & 127; const int pa = 256 * j + cc, pu = pa + 128;
        const bool first = (pm & 15) == 0;
        const float ta0 = first ? 0.f : tail[((size_t)(pm - 1) * 2 + 0) * DFF2 + pa], ta1 = first ? 0.f : tail[((size_t)(pm - 1) * 2 + 1) * DFF2 + pa];
        const float tu0 = first ? 0.f : tail[((size_t)(pm - 1) * 2 + 0) * DFF2 + pu], tu1 = first ? 0.f : tail[((size_t)(pm - 1) * 2 + 1) * DFF2 + pu];
        const float ha0 = head[((size_t)pm * 2 + 0) * DFF2 + pa], ha1 = head[((size_t)pm * 2 + 1) * DFF2 + pa];
        const float hu0 = head[((size_t)pm * 2 + 0) * DFF2 + pu], hu1 = head[((size_t)pm * 2 + 1) * DFF2 + pu];
        const float wa0 = cw[c], wa1 = cw[DFF2 + c], wa2 = cw[2 * DFF2 + c], ba = cb[c];
        const float wu0 = cw[DFF + c], wu1 = cw[DFF2 + DFF + c], wu2 = cw[2 * DFF2 + DFF + c], bu = cb[DFF + c];
        const float ca0 = ba + wa0 * ta0 + wa1 * ta1 + wa2 * ha0, cu0 = bu + wu0 * tu0 + wu1 * tu1 + wu2 * hu0;
        const float ca1 = ba + wa0 * ta1 + wa1 * ha0 + wa2 * ha1, cu1 = bu + wu0 * tu1 + wu1 * hu0 + wu2 * hu1;
        act[((size_t)pm * 256 + 0) * DFF + c] = f2bf(gelu_tanh_f(ca0) * cu0);
        act[((size_t)pm * 256 + 1) * DFF + c] = f2bf(gelu_tanh_f(ca1) * cu1);
    }
}

#define XB_TMO      128
#define XB_XCNT(j)  (256  + 64 * (j))
#define XB_XSUB(j)  (1280 + 64 * (j))
#define XB_XGEN(j)  (2304 + 64 * (j))
#define XB_TOP      3328
#define XB_TOPGEN   3392
#define XCD_BAR_WORDS 3456
#define XB_SPIN_CAP (1u << 18)

__device__ __forceinline__ unsigned xb_ld(unsigned* p)              { return __hip_atomic_load(p, __ATOMIC_RELAXED, __HIP_MEMORY_SCOPE_AGENT); }
__device__ __forceinline__ unsigned xb_add(unsigned* p, unsigned v) { return __hip_atomic_fetch_add(p, v, __ATOMIC_RELAXED, __HIP_MEMORY_SCOPE_AGENT); }
__device__ __forceinline__ unsigned xb_xcc_id() { return (unsigned)__builtin_amdgcn_s_getreg((3 << 11) | 20) & 0xFu; }
#define XB_SPIN(cond, bar) do { unsigned _sp = 0; while (cond) { __builtin_amdgcn_s_sleep(1); \
    if ((++_sp & 255u) == 0u) { if (xb_ld(&(bar)[XB_TMO])) break; if (_sp > XB_SPIN_CAP) { atomicAdd(&(bar)[XB_TMO], 1u); break; } } } } while (0)

struct XcdBarrier {
    unsigned* bar; unsigned x;
    volatile LAS unsigned* st;
};

__device__ __forceinline__ XcdBarrier xcd_barrier_post(unsigned* bar, volatile LAS unsigned* st) {
    XcdBarrier b; b.bar = bar; b.x = xb_xcc_id(); b.st = st;
    if (threadIdx.x == 0) (void)xb_add(&bar[XB_XCNT(b.x)], 1u);
    return b;
}
__device__ __forceinline__ void xcd_barrier_complete(unsigned* bar, unsigned x, unsigned& nloc, unsigned& nx) {
    const unsigned G = gridDim.x * gridDim.y * gridDim.z;
    unsigned sum, cnt, mine, sp = 0u;
    for (;;) {
        sum = 0u; cnt = 0u; mine = 0u;
#pragma unroll
        for (unsigned j = 0; j < 16; ++j) { const unsigned c = xb_ld(&bar[XB_XCNT(j)]); sum += c; cnt += (c > 0u) ? 1u : 0u; mine = (j == x) ? c : mine; }
        if (sum == G) break;
        __builtin_amdgcn_s_sleep(1);
        if ((++sp & 255u) == 0u) { if (xb_ld(&bar[XB_TMO])) break; if (sp > XB_SPIN_CAP) { atomicAdd(&bar[XB_TMO], 1u); break; } }
    }
    nloc = mine > 0u ? mine : 1u; nx = cnt > 0u ? cnt : 1u;
}

__device__ __forceinline__ void xcd_barrier(const XcdBarrier& b) {
    asm volatile("s_waitcnt vmcnt(0)" ::: "memory");
    __syncthreads();
    if (threadIdx.x == 0) {
        unsigned* bar = b.bar;
        __builtin_amdgcn_s_waitcnt(0);
        unsigned nloc = b.st[0], nx = b.st[1];
        if (nloc == 0u) { xcd_barrier_complete(bar, b.x, nloc, nx); b.st[0] = nloc; b.st[1] = nx; }
        const unsigned old = xb_add(&bar[XB_XSUB(b.x)], 1u);
        const unsigned gen = old / nloc;
        if (old + 1u == (gen + 1u) * nloc) {
            __builtin_amdgcn_fence(__ATOMIC_RELEASE, "agent");
            asm volatile("s_waitcnt vmcnt(0)" ::: "memory");
            const unsigned og = xb_add(&bar[XB_TOP], 1u);
            const unsigned tg = og / nx;
            if (og + 1u == (tg + 1u) * nx) xb_add(&bar[XB_TOPGEN], 1u);
            else XB_SPIN(xb_ld(&bar[XB_TOPGEN]) == tg, bar);
            __builtin_amdgcn_fence(__ATOMIC_ACQUIRE, "agent");
            xb_add(&bar[XB_XGEN(b.x)], 1u);
            asm volatile("s_waitcnt vmcnt(0)" ::: "memory");
        } else {
            XB_SPIN(xb_ld(&bar[XB_XGEN(b.x)]) == gen, bar);
            __builtin_amdgcn_fence(__ATOMIC_ACQUIRE, "agent");
            asm volatile("s_waitcnt vmcnt(0)" ::: "memory");
        }
    }
    __syncthreads();
}
#define CG_SYNC() do { asm volatile("s_waitcnt vmcnt(0) lgkmcnt(0)" ::: "memory"); grid.sync(); } while (0)
#define GRID_SYNC() do { for (int rs_ = 0; rs_ < REP_SYNC; ++rs_) { xcd_barrier(xbar); } } while (0)
#ifndef DBG_STOP
#define DBG_STOP 0
#endif
#ifndef REP_GEMM
#define REP_GEMM 1
#endif
#ifndef REP_SYNC
#define REP_SYNC 1
#endif
#ifndef REP_MISC
#define REP_MISC 1
#endif
__device__ __forceinline__ void dbg_dump(float* out, const bf16_t* a, const bf16_t* b, const bf16_t* c, int lda) {
    for (size_t e = (size_t)blockIdx.x * 512 + threadIdx.x; e < (size_t)MTOK * DM; e += (size_t)gridDim.x * 512) {
        const size_t m = e >> 10; const int col = (lda == 3072) ? (int)(e & 1023) + 1024 * (int)(m % 3) : (int)(e & 1023) % lda; float v = bf2f(a[m * lda + col]); if (b) v += bf2f(b[m * lda + col]); if (c) v += bf2f(c[m * lda + col]); out[e] = v; }
}
__global__ void __launch_bounds__(512, 2) mega_fwd(Params p) {
    extern __shared__ __attribute__((aligned(16))) unsigned char lds_raw[];
    LAS unsigned char* lds = (LAS unsigned char*)lds_raw;
    cg::grid_group grid = cg::this_grid();
    const int tid = threadIdx.x, lane = tid & 63, wave = __builtin_amdgcn_readfirstlane(tid >> 6);
    const int G = gridDim.x, gw = blockIdx.x * 8 + wave, ngw = G * 8, ngt = G * 512;
    unsigned char* ws = PP(ws);
    bf16_t* XN = (bf16_t*)(ws + WS_XN);
    volatile LAS unsigned* misc = (volatile LAS unsigned*)(lds + MISC_OFF);
    if (tid < 4) misc[tid] = 0u;
    __syncthreads();
    const XcdBarrier xbar = xcd_barrier_post((unsigned*)(ws + WS_BAR), misc);

    convert_weights(p, 0, lds, gw, ngw, wave, lane);
    row_phase(PP(x), nullptr, nullptr, PP(out), PP(mix_pre_g), XN, gw, ngw, lane);
    CG_SYNC();
    if (DBG_STOP == 8) {
        {
            unsigned char* ws = launder(PP(ws)); bf16_t* XN = (bf16_t*)(ws + WS_XN);
            pg8::Gemm g{XN, (const bf16_t*)(ws + WS_WIN) + (size_t)4352 * 1024, 1024, 1024, 1024, 0, 0}; pg8::StaticOrder S; S.init(MTOK, 3072, G, (int)blockIdx.x);
            pg8::EpiGates E{(bf16_t*)(ws + WS_GATES)}; pg8::gemm_phase(lds, g, S, E);
        }
        GRID_SYNC();
        dbg_dump(PP(out), (const bf16_t*)(ws + WS_GATES), nullptr, nullptr, 3072); return;
    }
#pragma unroll 1
    for (int l = 0; l < 2; ++l) {
        {
            unsigned char* ws = launder(PP(ws)); bf16_t* XN = (bf16_t*)(ws + WS_XN);
            pg8::Gemm g{XN, (const bf16_t*)(ws + WS_WIN), 1024, 1024, 1024, 0, 0}; pg8::StaticOrder S; S.init(MTOK, 4352, G, (int)blockIdx.x);
            pg8::EpiG1 E{ws}; for (int rep_ = 0; rep_ < REP_GEMM; ++rep_) pg8::gemm_phase(lds, g, S, E);
        }
        GRID_SYNC();
        if (DBG_STOP == 1) { dbg_dump(PP(out), (const bf16_t*)(ws + WS_KA), (const bf16_t*)(ws + WS_SV), (const bf16_t*)(ws + WS_GV), 512); return; }
        sb_phase(lds, ws, tid, wave, lane);
        sg_phase(lds, p, l, tid, wave, lane);
        gla_phase<false>(lds, p, l, tid, wave, lane);
        GRID_SYNC();
        gla_scan(ws, 0, ngt);
        GRID_SYNC();
        gla_phase<true>(lds, p, l, tid, wave, lane);
        GRID_SYNC();
        if (DBG_STOP == 2) { dbg_dump(PP(out), (const bf16_t*)(ws + WS_QA), (const bf16_t*)(ws + WS_U), (const bf16_t*)(ws + WS_GR), 512); return; }
        {
            unsigned char* ws = launder(PP(ws)); bf16_t* XN = (bf16_t*)(ws + WS_XN);
            pg8::Gemm g{XN, (const bf16_t*)(ws + WS_WIN) + (size_t)4352 * 1024, 1024, 1024, 1024, 0, 0}; pg8::StaticOrder S; S.init(MTOK, 3072, G, (int)blockIdx.x);
            pg8::EpiGates E{(bf16_t*)(ws + WS_GATES)}; for (int rep_ = 0; rep_ < REP_GEMM; ++rep_) pg8::gemm_phase(lds, g, S, E);
        }
        GRID_SYNC();
        if (DBG_STOP == 7) { dbg_dump(PP(out), (const bf16_t*)(ws + WS_GATES), nullptr, nullptr, 3072); return; }
        {
            unsigned char* ws = launder(PP(ws)); bf16_t* XN = (bf16_t*)(ws + WS_XN);
            pg8::Gemm g{(const bf16_t*)(ws + WS_QA), (const bf16_t*)(ws + WS_WP), 512, 512, 512, 4, (size_t)(32 * MiB)}; pg8::MergeOrder S; S.base.init(MTOK, 1024, G, (int)blockIdx.x);
            pg8::EpiMerge E{(const bf16_t*)(ws + WS_GATES), XN}; for (int rep_ = 0; rep_ < REP_GEMM; ++rep_) pg8::gemm_phase(lds, g, S, E);
        }
        GRID_SYNC();
        if (DBG_STOP == 3) { dbg_dump(PP(out), (const bf16_t*)(ws + WS_XN), nullptr, nullptr, 1024); return; }
        {
            unsigned char* ws = launder(PP(ws)); bf16_t* XN = (bf16_t*)(ws + WS_XN);
            pg8::Gemm g{XN, (const bf16_t*)(ws + WS_WOUT), 1024, 1024, 1024, 0, 0}; pg8::StaticOrder S; S.init(MTOK, 1024, G, (int)blockIdx.x);
            pg8::EpiF32 E{(float*)(ws + WS_Y32)}; for (int rep_ = 0; rep_ < REP_GEMM; ++rep_) pg8::gemm_phase(lds, g, S, E);
        }
        GRID_SYNC();
        row_phase(PP(out), (const float*)(ws + WS_Y32), PP(mix_post_g) + l * DM, PP(out), PP(ffn_pre_g) + l * DM, XN, gw, ngw, lane);
        GRID_SYNC();
        if (DBG_STOP == 4) return;
        {
            unsigned char* ws = launder(PP(ws)); bf16_t* XN = (bf16_t*)(ws + WS_XN);
            pg8::Gemm g{XN, (const bf16_t*)(ws + WS_WUP), 1024, 1024, 1024, 0, 0}; pg8::StaticOrder S; S.init(MTOK, DFF2, G, (int)blockIdx.x);
            pg8::EpiConv E{launder(PP(ffn_conv_w)) + (size_t)l * 3 * DFF2, launder(PP(ffn_conv_b)) + (size_t)l * DFF2, (bf16_t*)(ws + WS_ACT), (float*)(ws + WS_HEAD), (float*)(ws + WS_TAIL)};
            for (int rep_ = 0; rep_ < REP_GEMM; ++rep_) pg8::gemm_phase(lds, g, S, E);
        }
        GRID_SYNC();
        conv_fix(p, l, 0, ngt);
        GRID_SYNC();
        if (DBG_STOP == 5) { dbg_dump(PP(out), (const bf16_t*)(ws + WS_ACT), nullptr, nullptr, 1024); return; }
        {
            unsigned char* ws = launder(PP(ws));
            pg8::Gemm g{(const bf16_t*)(ws + WS_ACT), (const bf16_t*)(ws + WS_WDN), DFF, DFF, DFF, 0, 0}; pg8::StaticOrder S; S.init(MTOK, 1024, G, (int)blockIdx.x);
            pg8::EpiF32 E{(float*)(ws + WS_Y32B)}; for (int rep_ = 0; rep_ < REP_GEMM; ++rep_) pg8::gemm_phase(lds, g, S, E);
        }
        GRID_SYNC();
        if (l == 0) {
            row_phase(PP(out), (const float*)(ws + WS_Y32B), PP(ffn_post_g), PP(out), PP(mix_pre_g) + DM, XN, gw, ngw, lane);
            convert_weights(p, 1, lds, gw, ngw, wave, lane);
            GRID_SYNC();
            if (DBG_STOP == 6) return;
        } else {
            row_phase(PP(out), (const float*)(ws + WS_Y32B), PP(ffn_post_g) + DM, PP(out), nullptr, nullptr, gw, ngw, lane);
        }
    }
}

extern "C" void kernel_launch(void* const* d_in, const int* in_sizes, int n_in, void* d_out, int out_size, void* d_ws, size_t ws_size, hipStream_t stream) {
    static int grid = 0;
    if (grid == 0) {
        if (n_in != 21 || out_size != MTOK * DM || ws_size < WS_END) { fprintf(stderr, "kernel_launch: unexpected shapes (n_in %d, out %d, ws %zu)\n", n_in, out_size, ws_size); grid = -1; return; }
        int dev = 0, cus = 0, per_cu = 0;
        hipGetDevice(&dev); hipDeviceGetAttribute(&cus, hipDeviceAttributeMultiprocessorCount, dev);
        if (hipFuncSetAttribute((const void*)mega_fwd, hipFuncAttributeMaxDynamicSharedMemorySize, LDS_BYTES) != hipSuccess) { fprintf(stderr, "kernel_launch: hipFuncSetAttribute failed\n"); grid = -1; return; }
        if (hipOccupancyMaxActiveBlocksPerMultiprocessor(&per_cu, (const void*)mega_fwd, 512, LDS_BYTES) != hipSuccess || per_cu < 1) { fprintf(stderr, "kernel_launch: occupancy query says %d blocks/CU\n", per_cu); per_cu = 1; }
        (void)hipGetLastError();
        grid = cus;
    }
    if (grid < 0) return;
    Params p{};
    const float** f = (const float**)&p;
    for (int i = 0; i < 21; ++i) f[i] = (const float*)d_in[i];
    p.out = (float*)d_out; p.ws = (unsigned char*)d_ws;
    (void)hipMemsetAsync(d_ws, 0, 65536, stream);
    void* args[] = {&p};
    hipError_t e = hipLaunchCooperativeKernel((const void*)mega_fwd, dim3(grid), dim3(512), args, LDS_BYTES, stream);
    if (e != hipSuccess) fprintf(stderr, "cooperative launch failed: %s (grid %d)\n", hipGetErrorString(e), grid);
}
```

```cpp
#include <hip/hip_runtime.h>
#include <hip/hip_cooperative_groups.h>
#include <cstdio>
#include <cstdint>
namespace cg = cooperative_groups;

#define LAS __attribute__((address_space(3)))
typedef unsigned short bf16_t;
typedef short bf16x8 __attribute__((ext_vector_type(8)));
typedef float f32x4 __attribute__((ext_vector_type(4)));
typedef unsigned u32x4 __attribute__((ext_vector_type(4)));
typedef unsigned u32x2 __attribute__((ext_vector_type(2)));

constexpr int BATCH = 8, SEQ = 4096, DM = 1024, MTOK = BATCH * SEQ;
constexpr int INW = 7184, DFF = 2816, DFF2 = 5632;
constexpr float EPS = 1e-6f;
constexpr float SB_THR = -106.0f;

constexpr size_t MiB = 1u << 20;
constexpr size_t WS_GDOWN = 1 * MiB;
constexpr size_t WS_DEC = 3 * MiB;
constexpr size_t WS_WIN = 4 * MiB;
constexpr size_t WS_WP = 19 * MiB;
constexpr size_t WS_WOUT = 22 * MiB;
constexpr size_t WS_WUP = 24 * MiB;
constexpr size_t WS_WDN = 35 * MiB;
constexpr size_t WS_XN = 41 * MiB;
constexpr size_t WS_QA = 105 * MiB, WS_U = 137 * MiB, WS_GR = 169 * MiB;
constexpr size_t WS_KA = 201 * MiB, WS_VA = 233 * MiB, WS_SV = 265 * MiB, WS_GV = 297 * MiB;
constexpr size_t WS_GQ = 329 * MiB, WS_GK = 345 * MiB;
constexpr size_t WS_UPD = 361 * MiB;
constexpr size_t WS_GATES = 201 * MiB;
constexpr size_t WS_Y32 = 105 * MiB;
constexpr size_t WS_ACT = 105 * MiB;
constexpr size_t WS_HEAD = 282 * MiB;
constexpr size_t WS_TAIL = 288 * MiB;
constexpr size_t WS_Y32B = 300 * MiB;
constexpr size_t WS_END = 428 * MiB;

constexpr int LDS_BYTES = 147456;
constexpr int MISC_OFF = 147456 - 64;
constexpr size_t WS_BAR = 0;
constexpr int XT_OFF = 131072;

typedef float f32x2_t __attribute__((ext_vector_type(2)));
typedef __bf16 bf16x2_t __attribute__((ext_vector_type(2)));
__device__ __forceinline__ unsigned cvt_pk_bf16(float lo, float hi) { const f32x2_t v = {lo, hi}; const bf16x2_t b = __builtin_convertvector(v, bf16x2_t); return __builtin_bit_cast(unsigned, b); }
__device__ __forceinline__ float bf2f(unsigned short h) { return __uint_as_float(((unsigned)h) << 16); }
__device__ __forceinline__ float bflo(unsigned w) { return __uint_as_float(w << 16); }
__device__ __forceinline__ float bfhi(unsigned w) { return __uint_as_float(w & 0xffff0000u); }
__device__ __forceinline__ unsigned short f2bf(float f) { return (unsigned short)(cvt_pk_bf16(f, 0.f) & 0xffffu); }
__device__ __forceinline__ bf16x8 pack8(f32x4 a, f32x4 b) {
    u32x4 w; w.x = cvt_pk_bf16(a[0], a[1]); w.y = cvt_pk_bf16(a[2], a[3]); w.z = cvt_pk_bf16(b[0], b[1]); w.w = cvt_pk_bf16(b[2], b[3]);
    return __builtin_bit_cast(bf16x8, w);
}
__device__ __forceinline__ float rcpf_(float x) { return __builtin_amdgcn_rcpf(x); }
__device__ __forceinline__ float gelu_tanh_f(float x) { const float u = 0.7978845608f * (x + 0.044715f * x * x * x); return x * rcpf_(1.f + __expf(-2.f * u)); }
__device__ __forceinline__ float sigmoid_f(float x) { return rcpf_(1.f + __expf(-x)); }
__device__ __forceinline__ float logsig_f(float x) { return fminf(x, 0.f) - __logf(1.f + __expf(-fabsf(x))); }
__device__ __forceinline__ f32x4 mfma16(bf16x8 a, bf16x8 b, f32x4 c) { return __builtin_amdgcn_mfma_f32_16x16x32_bf16(a, b, c, 0, 0, 0); }
__device__ __forceinline__ float wave_sum(float v) {
#pragma unroll
    for (int o = 1; o < 64; o <<= 1) v += __shfl_xor(v, o);
    return v;
}
#define LDS_WAIT() asm volatile("s_waitcnt lgkmcnt(0)" ::: "memory")
template <class T> __device__ __forceinline__ T* launder(T* p) {
    const unsigned long long v = (unsigned long long)p; unsigned lo = __builtin_amdgcn_readfirstlane((unsigned)v), hi = __builtin_amdgcn_readfirstlane((unsigned)(v >> 32));
    asm volatile("" : "+s"(lo), "+s"(hi)); return (T*)(((unsigned long long)hi << 32) | lo); }
__device__ __forceinline__ int vlaunder(int x) { asm volatile("" : "+v"(x)); return x; }
__device__ __forceinline__ float dpp_shr1(float v) { return __builtin_bit_cast(float, __builtin_amdgcn_update_dpp(0, __builtin_bit_cast(int, v), 0x111, 0xf, 0xf, true)); }
__device__ __forceinline__ float dpp_shr2(float v) { return __builtin_bit_cast(float, __builtin_amdgcn_update_dpp(0, __builtin_bit_cast(int, v), 0x112, 0xf, 0xf, true)); }
__device__ __forceinline__ float dpp_shl14(float v) { return __builtin_bit_cast(float, __builtin_amdgcn_update_dpp(0, __builtin_bit_cast(int, v), 0x10E, 0xf, 0xf, true)); }
__device__ __forceinline__ float dpp_shl15(float v) { return __builtin_bit_cast(float, __builtin_amdgcn_update_dpp(0, __builtin_bit_cast(int, v), 0x10F, 0xf, 0xf, true)); }

struct Params {
    const float* x; const float* mix_pre_g; const float* mix_post_g; const float* w_in; const float* sg_ln_g; const float* sg_ln_b; const float* sg_w; const float* sg_b;
    const float* gla_w_gup; const float* gla_b_gate; const float* gla_norm_g; const float* p_a; const float* p_b; const float* p_c; const float* w_out;
    const float* ffn_pre_g; const float* ffn_post_g; const float* ffn_w_up; const float* ffn_conv_w; const float* ffn_conv_b; const float* ffn_w_down;
    float* out; unsigned char* ws;
};
#include <cstddef>
__device__ __forceinline__ const void* karg_(int byte_off) { const char __attribute__((address_space(4)))* ka = (const char __attribute__((address_space(4)))*)__builtin_amdgcn_kernarg_segment_ptr(); return *(const void* const volatile __attribute__((address_space(4)))*)(ka + byte_off); }
#define PP(field) ((decltype(Params::field))karg_((int)offsetof(Params, field)))

namespace pg8 {
constexpr int BM = 256, BK = 64, HALF = 128, HTB = HALF * BK * 2, NXCD = 8, WGM = 8;
__device__ __forceinline__ int lds_byte(int r, int c) { const int st = (r >> 4) * 2 + (c >> 5), rr = r & 15, cc = c & 31, ob = rr * 64 + cc * 2; return st * 1024 + (ob ^ (((ob >> 9) & 1) << 5)); }
__device__ __forceinline__ void stage_rc(int b, int& R, int& C) { const int st = b / 1024, sb = b % 1024, swz = sb ^ (((sb >> 9) & 1) << 5); R = (st >> 1) * 16 + swz / 64; C = (st & 1) * 32 + (swz % 64) / 2; }
__device__ __forceinline__ int perm32(int rho) { const int n = rho >> 4, i = rho & 15; return 8 * (i >> 2) + 4 * n + (i & 3); }

struct Unit { int pm, pn; };
struct Gemm { const bf16_t* A; const bf16_t* Bt; int K, lda, ldb, adiv; size_t astride; };

struct StaticOrder {
    int nM, nN, nwg, G, c;
    __device__ __forceinline__ void init(int M, int N, int G_, int c_) { nM = M / BM; nN = N / BM; nwg = nM * nN; G = G_; c = c_; }
    __device__ __forceinline__ bool next(int i, Unit& u) const {
        const long L = (long)i * G + c; if (L >= nwg) return false;
        int wgid = (int)L; { const int q = nwg / NXCD, r = nwg % NXCD, xcd = wgid % NXCD, off = wgid / NXCD; wgid = (xcd < r ? xcd * (q + 1) : r * (q + 1) + (xcd - r) * q) + off; }
        const int nig = WGM * nN, gid = wgid / nig, fm = gid * WGM, gsz = (nM - fm) < WGM ? (nM - fm) : WGM;
        u.pm = fm + ((wgid % nig) % gsz); u.pn = (wgid % nig) / gsz; return true;
    }
};
struct MergeOrder {
    StaticOrder base;
    __device__ __forceinline__ bool next(int i, Unit& u) const { const int br = i % 3; Unit t; if (!base.next(i / 3, t)) return false; u.pm = t.pm; u.pn = t.pn + 4 * br; return true; }
};

template <class Epi, class Sched>
__device__ __forceinline__ void gemm_phase(LAS unsigned char* lds, const Gemm g, const Sched& S, const Epi& E) {
    const int tid = vlaunder((int)threadIdx.x), wid = __builtin_amdgcn_readfirstlane(tid >> 6), lane = tid & 63, wr = wid >> 2, wc = wid & 3, fr = lane & 15, fq = lane >> 4;
    const int K = g.K, nt = K / BK;
    unsigned voffA[2], voffB[2];
#pragma unroll
    for (int i = 0; i < 2; ++i) { int R, C; stage_rc(tid * 16 + i * 8192, R, C); const int Rb = Epi::PERM ? ((R & ~31) + perm32(R & 31)) : R;
        voffA[i] = (unsigned)(R * g.lda + C) * 2u; voffB[i] = (unsigned)(Rb * g.ldb + C) * 2u; }
    const size_t kstep = (size_t)(BK * 2);
    const size_t hstepA = (size_t)HALF * g.lda * 2, hstepB = (size_t)HALF * g.ldb * 2;
    const size_t tstepA = 2 * hstepA, tstepB = 2 * hstepB;
    const unsigned ldsw = (unsigned)wid * 1024u;
    const int aoff = lds_byte(wr * 64 + fr, fq * 8), boff = lds_byte(wc * 32 + fr, fq * 8);
#define PG8_SA(b, h) (((b) * 2 + (h)) * HTB)
#define PG8_SB(b, h) ((4 + (b) * 2 + (h)) * HTB)
#define PG8_STAGE(bufoff, gbase, voff) do { _Pragma("unroll") for (int _i = 0; _i < 2; ++_i) \
        __builtin_amdgcn_global_load_lds((const unsigned*)((const char*)(gbase) + (voff)[_i]), (LAS unsigned*)(lds + (bufoff) + ldsw + _i * 8192), 16, 0, 0); } while (0)
#define PG8_LDA(dst, b, h) do { _Pragma("unroll") for (int m = 0; m < 4; ++m) _Pragma("unroll") for (int k = 0; k < 2; ++k) dst[m][k] = *(const LAS bf16x8*)(lds + PG8_SA(b, h) + aoff + m * 2048 + k * 1024); } while (0)
#define PG8_LDB(dst, b, h) do { _Pragma("unroll") for (int n = 0; n < 2; ++n) _Pragma("unroll") for (int k = 0; k < 2; ++k) dst[n][k] = *(const LAS bf16x8*)(lds + PG8_SB(b, h) + boff + n * 2048 + k * 1024); } while (0)
#define PG8_MMA(ai, bj, At, Bt) do { __builtin_amdgcn_s_setprio(1); _Pragma("unroll") for (int m = 0; m < 4; ++m) _Pragma("unroll") for (int n = 0; n < 2; ++n) _Pragma("unroll") for (int k = 0; k < 2; ++k) \
        acc[ai][bj][m][n] = __builtin_amdgcn_mfma_f32_16x16x32_bf16(Bt[n][k], At[m][k], acc[ai][bj][m][n], 0, 0, 0); __builtin_amdgcn_s_setprio(0); } while (0)
#define PG8_WAIT_V(n) asm volatile("s_waitcnt vmcnt(" #n ")" ::: "memory")
#define PG8_WAIT_L(n) asm volatile("s_waitcnt lgkmcnt(" #n ")" ::: "memory")
#define PG8_BAR __builtin_amdgcn_s_barrier()
#define PG8_SCHED __builtin_amdgcn_sched_barrier(0)
    Unit cur, nxt; int ui = 0;
    if (!S.next(0, cur)) return;
    f32x4 acc[2][2][4][2];
#pragma unroll
    for (int a = 0; a < 2; ++a)
#pragma unroll
        for (int b = 0; b < 2; ++b)
#pragma unroll
            for (int m = 0; m < 4; ++m)
#pragma unroll
                for (int n = 0; n < 2; ++n) acc[a][b][m][n] = (f32x4){0.f, 0.f, 0.f, 0.f};
    bf16x8 At[4][2], B0[2][2], B1[2][2];
    const char* cA = (const char*)g.A + (size_t)cur.pm * tstepA + (g.adiv ? (size_t)(cur.pn / g.adiv) * g.astride : 0);
    const char* cB = (const char*)g.Bt + (size_t)cur.pn * tstepB;
    PG8_STAGE(PG8_SB(0, 0), cB, voffB); PG8_STAGE(PG8_SB(0, 1), cB + hstepB, voffB); PG8_STAGE(PG8_SA(0, 0), cA, voffA); PG8_STAGE(PG8_SA(0, 1), cA + hstepA, voffA);
    if (wr == 1) PG8_BAR;
    PG8_WAIT_V(2); PG8_BAR;
    PG8_STAGE(PG8_SB(1, 0), cB + kstep, voffB); PG8_STAGE(PG8_SA(1, 0), cA + kstep, voffA); PG8_STAGE(PG8_SB(1, 1), cB + hstepB + kstep, voffB);
    PG8_WAIT_V(6); PG8_BAR;
    for (;;) {
        const bool has_next = S.next(ui + 1, nxt);
        const char* nA = has_next ? (const char*)g.A + (size_t)nxt.pm * tstepA + (g.adiv ? (size_t)(nxt.pn / g.adiv) * g.astride : 0) : cA;
        const char* nB = has_next ? (const char*)g.Bt + (size_t)nxt.pn * tstepB : cB;
        for (int t = 0; t < nt; t += 2) {
            const bool last = (t == nt - 2);
            const char* a1 = cA + (size_t)(t + 1) * kstep;
            const char* a2 = last ? nA : cA + (size_t)(t + 2) * kstep; const char* b2 = last ? nB : cB + (size_t)(t + 2) * kstep;
            const char* a3 = a2 + kstep; const char* b3 = b2 + kstep;
            PG8_LDB(B0, 0, 0); PG8_LDB(B1, 0, 1); PG8_SCHED; PG8_LDA(At, 0, 0); PG8_STAGE(PG8_SA(1, 1), a1 + hstepA, voffA);
            PG8_WAIT_V(8); PG8_WAIT_L(0); PG8_BAR; PG8_MMA(0, 0, At, B0); PG8_MMA(0, 1, At, B1); PG8_BAR; PG8_SCHED;
            PG8_LDA(At, 0, 1); PG8_STAGE(PG8_SB(0, 0), b2, voffB); PG8_STAGE(PG8_SB(0, 1), b2 + hstepB, voffB); PG8_STAGE(PG8_SA(0, 0), a2, voffA);
            PG8_WAIT_V(8); PG8_WAIT_L(0); PG8_BAR; PG8_MMA(1, 0, At, B0); PG8_MMA(1, 1, At, B1); PG8_BAR; PG8_SCHED;
            PG8_LDB(B0, 1, 0); PG8_LDB(B1, 1, 1); PG8_SCHED; PG8_LDA(At, 1, 0); PG8_STAGE(PG8_SA(0, 1), a2 + hstepA, voffA);
            PG8_WAIT_V(8); PG8_WAIT_L(0); PG8_BAR; PG8_MMA(0, 0, At, B0); PG8_MMA(0, 1, At, B1); PG8_BAR; PG8_SCHED;
            PG8_LDA(At, 1, 1); PG8_STAGE(PG8_SB(1, 0), b3, voffB); PG8_STAGE(PG8_SB(1, 1), b3 + hstepB, voffB); PG8_STAGE(PG8_SA(1, 0), a3, voffA);
            PG8_WAIT_V(8); PG8_WAIT_L(0); PG8_BAR; PG8_MMA(1, 0, At, B0); PG8_MMA(1, 1, At, B1); PG8_BAR; PG8_SCHED;
        }
        if (wr == 0) PG8_BAR;
        E(acc, cur, wr, wc, fr, fq, lds);
        if (!has_next) break;
#pragma unroll
        for (int a = 0; a < 2; ++a)
#pragma unroll
            for (int b = 0; b < 2; ++b)
#pragma unroll
                for (int m = 0; m < 4; ++m)
#pragma unroll
                    for (int n = 0; n < 2; ++n) acc[a][b][m][n] = (f32x4){0.f, 0.f, 0.f, 0.f};
        cur = nxt; cA = nA; cB = nB; ++ui;
        if (wr == 1) PG8_BAR;
    }
    PG8_WAIT_V(0);
    PG8_BAR;
#undef PG8_SA
#undef PG8_SB
#undef PG8_STAGE
#undef PG8_LDA
#undef PG8_LDB
#undef PG8_MMA
#undef PG8_WAIT_V
#undef PG8_WAIT_L
#undef PG8_BAR
#undef PG8_SCHED
}

typedef const f32x4 (&AccRef)[2][2][4][2];

struct EpiG1 {
    static constexpr bool PERM = true;
    unsigned char* ws;
    __device__ __forceinline__ void operator()(f32x4 (&acc)[2][2][4][2], const Unit& u, int wr, int wc, int fr, int fq, LAS unsigned char*) const {
        const int pn = u.pn;
        const int row0 = u.pm * BM + wr * 64 + fr;
        if (pn == 16) {
            if (wc == 0 && fq < 2) { float* G = (float*)(ws + WS_GDOWN);
#pragma unroll
                for (int ai = 0; ai < 2; ++ai)
#pragma unroll
                    for (int m = 0; m < 4; ++m)
#pragma unroll
                        for (int n = 0; n < 2; ++n) *(f32x4*)(G + (size_t)(row0 + ai * HALF + m * 16) * 16 + 8 * fq + 4 * n) = acc[ai][0][m][n]; }
            return;
        }
        size_t off; int ldc = 512, colt, act = 0;
        if (pn < 2) { off = WS_QA; colt = pn * 256; }
        else if (pn < 4) { off = WS_KA; colt = (pn - 2) * 256; }
        else if (pn < 6) { off = WS_VA; colt = (pn - 4) * 256; }
        else if (pn < 8) { off = WS_U; colt = (pn - 6) * 256; act = 1; }
        else if (pn < 10) { off = WS_SV; colt = (pn - 8) * 256; act = 1; }
        else if (pn == 10) { off = WS_GQ; colt = 0; ldc = 256; }
        else if (pn == 11) { off = WS_GK; colt = 0; ldc = 256; }
        else if (pn < 14) { off = WS_GV; colt = (pn - 12) * 256; }
        else { off = WS_GR; colt = (pn - 14) * 256; act = 2; }
        bf16_t* base = (bf16_t*)(ws + off);
        const int col0 = colt + wc * 32 + 8 * fq;
#pragma unroll
        for (int ai = 0; ai < 2; ++ai)
#pragma unroll
            for (int m = 0; m < 4; ++m) { bf16_t* rowp = base + (size_t)(row0 + ai * HALF + m * 16) * ldc + col0;
#pragma unroll
                for (int bj = 0; bj < 2; ++bj) { f32x4 v0 = acc[ai][bj][m][0], v1 = acc[ai][bj][m][1];
                    if (act == 1) {
#pragma unroll
                        for (int e = 0; e < 4; ++e) { v0[e] = gelu_tanh_f(v0[e]); v1[e] = gelu_tanh_f(v1[e]); }
                    } else if (act == 2) {
#pragma unroll
                        for (int e = 0; e < 4; ++e) { v0[e] = v0[e] * sigmoid_f(v0[e]); v1[e] = v1[e] * sigmoid_f(v1[e]); }
                    }
                    u32x4 w; w.x = cvt_pk_bf16(v0[0], v0[1]); w.y = cvt_pk_bf16(v0[2], v0[3]); w.z = cvt_pk_bf16(v1[0], v1[1]); w.w = cvt_pk_bf16(v1[2], v1[3]);
                    *(u32x4*)(rowp + bj * HALF) = w; } }
    }
};
struct EpiGates {
    static constexpr bool PERM = true;
    bf16_t* O;
    __device__ __forceinline__ void operator()(f32x4 (&acc)[2][2][4][2], const Unit& u, int wr, int wc, int fr, int fq, LAS unsigned char*) const {
        const int row0 = u.pm * BM + wr * 64 + fr, col0 = u.pn * BM + wc * 32 + 8 * fq;
#pragma unroll
        for (int ai = 0; ai < 2; ++ai)
#pragma unroll
            for (int m = 0; m < 4; ++m) { bf16_t* rowp = O + (size_t)(row0 + ai * HALF + m * 16) * 3072 + col0;
#pragma unroll
                for (int bj = 0; bj < 2; ++bj) { f32x4 v0 = acc[ai][bj][m][0], v1 = acc[ai][bj][m][1];
#pragma unroll
                    for (int e = 0; e < 4; ++e) { v0[e] = sigmoid_f(v0[e]); v1[e] = sigmoid_f(v1[e]); }
                    u32x4 w; w.x = cvt_pk_bf16(v0[0], v0[1]); w.y = cvt_pk_bf16(v0[2], v0[3]); w.z = cvt_pk_bf16(v1[0], v1[1]); w.w = cvt_pk_bf16(v1[2], v1[3]);
                    *(u32x4*)(rowp + bj * HALF) = w; } }
    }
};
struct EpiMerge {
    static constexpr bool PERM = true;
    const bf16_t* gates; bf16_t* O;
    __device__ __forceinline__ void operator()(f32x4 (&acc)[2][2][4][2], const Unit& u, int wr, int wc, int fr, int fq, LAS unsigned char*) const {
        const int br = u.pn >> 2, ct = u.pn & 3;
        const int row0 = u.pm * BM + wr * 64 + fr, col0 = ct * BM + wc * 32 + 8 * fq;
#pragma unroll
        for (int ai = 0; ai < 2; ++ai)
#pragma unroll
            for (int m = 0; m < 4; ++m) { const size_t row = (size_t)(row0 + ai * HALF + m * 16);
#pragma unroll
                for (int bj = 0; bj < 2; ++bj) { f32x4 v0 = acc[ai][bj][m][0], v1 = acc[ai][bj][m][1];
                    const u32x4 gw = *(const u32x4*)(gates + row * 3072 + br * 1024 + col0 + bj * HALF);
                    v0[0] *= bflo(gw.x); v0[1] *= bfhi(gw.x); v0[2] *= bflo(gw.y); v0[3] *= bfhi(gw.y);
                    v1[0] *= bflo(gw.z); v1[1] *= bfhi(gw.z); v1[2] *= bflo(gw.w); v1[3] *= bfhi(gw.w);
                    bf16_t* op = O + row * 1024 + col0 + bj * HALF;
                    if (br > 0) { const u32x4 pw = *(const u32x4*)op;
                        v0[0] += bflo(pw.x); v0[1] += bfhi(pw.x); v0[2] += bflo(pw.y); v0[3] += bfhi(pw.y);
                        v1[0] += bflo(pw.z); v1[1] += bfhi(pw.z); v1[2] += bflo(pw.w); v1[3] += bfhi(pw.w); }
                    u32x4 w; w.x = cvt_pk_bf16(v0[0], v0[1]); w.y = cvt_pk_bf16(v0[2], v0[3]); w.z = cvt_pk_bf16(v1[0], v1[1]); w.w = cvt_pk_bf16(v1[2], v1[3]);
                    *(u32x4*)op = w; } }
    }
};
struct EpiF32 {
    static constexpr bool PERM = true;
    bf16_t* O;
    __device__ __forceinline__ void operator()(f32x4 (&acc)[2][2][4][2], const Unit& u, int wr, int wc, int fr, int fq, LAS unsigned char*) const {
        const int row0 = u.pm * BM + wr * 64 + fr, col0 = u.pn * BM + wc * 32 + 8 * fq;
#pragma unroll
        for (int ai = 0; ai < 2; ++ai)
#pragma unroll
            for (int m = 0; m < 4; ++m) { bf16_t* rowp = O + (size_t)(row0 + ai * HALF + m * 16) * 1024 + col0;
#pragma unroll
                for (int bj = 0; bj < 2; ++bj) { const f32x4 v0 = acc[ai][bj][m][0], v1 = acc[ai][bj][m][1];
                    u32x4 w; w.x = cvt_pk_bf16(v0[0], v0[1]); w.y = cvt_pk_bf16(v0[2], v0[3]); w.z = cvt_pk_bf16(v1[0], v1[1]); w.w = cvt_pk_bf16(v1[2], v1[3]);
                    *(u32x4*)(rowp + bj * HALF) = w; } }
    }
};
struct EpiConv {
    static constexpr bool PERM = true;
    const float* cw; const float* cb; bf16_t* act; float* head; float* tail;
    __device__ __forceinline__ void operator()(f32x4 (&acc)[2][2][4][2], const Unit& u, int wr, int wc, int fr, int fq, LAS unsigned char* lds) const {
        LAS float* XT = (LAS float*)(lds + XT_OFF);
        const int ccol = wc * 32 + 8 * fq;
        if (fr >= 14) {
#pragma unroll
            for (int ai = 0; ai < 2; ++ai)
#pragma unroll
                for (int bj = 0; bj < 2; ++bj)
#pragma unroll
                    for (int n = 0; n < 2; ++n) *(LAS f32x4*)(XT + ((ai * 2 + wr) * 2 + (fr - 14)) * 256 + bj * HALF + ccol + 4 * n) = acc[ai][bj][3][n];
            if (wr == 1) {
#pragma unroll
                for (int bj = 0; bj < 2; ++bj)
#pragma unroll
                    for (int n = 0; n < 2; ++n) *(f32x4*)(tail + ((size_t)u.pm * 2 + (fr - 14)) * DFF2 + u.pn * BM + bj * HALF + ccol + 4 * n) = acc[1][bj][3][n];
            }
        }
        if (fr < 2 && wr == 0) {
#pragma unroll
            for (int bj = 0; bj < 2; ++bj)
#pragma unroll
                for (int n = 0; n < 2; ++n) *(f32x4*)(head + ((size_t)u.pm * 2 + fr) * DFF2 + u.pn * BM + bj * HALF + ccol + 4 * n) = acc[0][bj][0][n];
        }
        asm volatile("s_waitcnt lgkmcnt(0)" ::: "memory"); __builtin_amdgcn_s_barrier(); asm volatile("" ::: "memory");
#pragma unroll
        for (int n = 0; n < 2; ++n) {
            const int ch = u.pn * HALF + ccol + 4 * n;
            const f32x4 wa0 = *(const f32x4*)(cw + ch), wa1 = *(const f32x4*)(cw + DFF2 + ch), wa2 = *(const f32x4*)(cw + 2 * DFF2 + ch), ba = *(const f32x4*)(cb + ch);
            const f32x4 wu0 = *(const f32x4*)(cw + DFF + ch), wu1 = *(const f32x4*)(cw + DFF2 + DFF + ch), wu2 = *(const f32x4*)(cw + 2 * DFF2 + DFF + ch), bu = *(const f32x4*)(cb + DFF + ch);
#pragma unroll
            for (int ai = 1; ai >= 0; --ai)
#pragma unroll
                for (int m = 3; m >= 0; --m) {
                    f32x4 pa, pu;
                    if (m > 0) { pa = acc[ai][0][m - 1][n]; pu = acc[ai][1][m - 1][n]; }
                    else {
                        const int slot = ai * 2 + wr - 1;
                        if (slot >= 0) { pa = *(const LAS f32x4*)(XT + (slot * 2 + (fr & 1)) * 256 + ccol + 4 * n); pu = *(const LAS f32x4*)(XT + (slot * 2 + (fr & 1)) * 256 + HALF + ccol + 4 * n); }
                        else { pa = (f32x4){0.f, 0.f, 0.f, 0.f}; pu = pa; }
                    }
                    f32x4 xa = acc[ai][0][m][n], xu = acc[ai][1][m][n];
                    asm volatile("" : "+v"(xa), "+v"(xu), "+v"(pa), "+v"(pu));
                    f32x4 res;
#pragma unroll
                    for (int e = 0; e < 4; ++e) {
                        const float a1 = dpp_shr1(xa[e]) + dpp_shl15(pa[e]), a2 = dpp_shr2(xa[e]) + dpp_shl14(pa[e]);
                        const float u1 = dpp_shr1(xu[e]) + dpp_shl15(pu[e]), u2 = dpp_shr2(xu[e]) + dpp_shl14(pu[e]);
                        const float ca = ba[e] + wa0[e] * a2 + wa1[e] * a1 + wa2[e] * xa[e];
                        const float cu = bu[e] + wu0[e] * u2 + wu1[e] * u1 + wu2[e] * xu[e];
                        res[e] = gelu_tanh_f(ca) * cu;
                    }
                    asm volatile("" : "+v"(res));
                    acc[ai][0][m][n] = res;
                }
        }
        const int row0 = u.pm * BM + wr * 64 + fr;
#pragma unroll
        for (int ai = 0; ai < 2; ++ai)
#pragma unroll
            for (int m = 0; m < 4; ++m) { const f32x4 v0 = acc[ai][0][m][0], v1 = acc[ai][0][m][1];
                u32x4 w; w.x = cvt_pk_bf16(v0[0], v0[1]); w.y = cvt_pk_bf16(v0[2], v0[3]); w.z = cvt_pk_bf16(v1[0], v1[1]); w.w = cvt_pk_bf16(v1[2], v1[3]);
                *(u32x4*)(act + (size_t)(row0 + ai * HALF + m * 16) * DFF + u.pn * HALF + ccol) = w; }
    }
};
}

__device__ __forceinline__ void transpose_item(const float* W, int ldsrc, int k0, int nsrc0, bf16_t* WT, int K, int ndst0, LAS float* scr, int lane) {
#pragma unroll 8
    for (int i = 0; i < 32; ++i) { const int kk = 2 * i + (lane >> 5); scr[kk * 33 + (lane & 31)] = W[(size_t)(k0 + kk) * ldsrc + nsrc0 + (lane & 31)]; }
    LDS_WAIT(); asm volatile("" ::: "memory");
    const int c = lane & 7;
#pragma unroll
    for (int j = 0; j < 4; ++j) { const int n = (lane >> 3) + 8 * j; const LAS float* s = scr + (8 * c) * 33 + n;
        u32x4 o; o.x = cvt_pk_bf16(s[0 * 33], s[1 * 33]); o.y = cvt_pk_bf16(s[2 * 33], s[3 * 33]); o.z = cvt_pk_bf16(s[4 * 33], s[5 * 33]); o.w = cvt_pk_bf16(s[6 * 33], s[7 * 33]);
        *(u32x4*)(WT + (size_t)(ndst0 + n) * K + k0 + 8 * c) = o; }
    LDS_WAIT(); asm volatile("" ::: "memory");
}
__device__ __forceinline__ void convert_weights(const Params& p, int l, LAS unsigned char* lds, int gw, int ngw, int wave, int lane) {
    lane = vlaunder((int)threadIdx.x) & 63;
    LAS float* scr = (LAS float*)(lds + wave * 16384);
    unsigned char* ws = launder(PP(ws));
    bf16_t* Win = (bf16_t*)(ws + WS_WIN); bf16_t* WP = (bf16_t*)(ws + WS_WP); bf16_t* WO = (bf16_t*)(ws + WS_WOUT); bf16_t* WU = (bf16_t*)(ws + WS_WUP); bf16_t* WD = (bf16_t*)(ws + WS_WDN);
    const float* w_in = launder(PP(w_in)) + (size_t)l * DM * INW;
    constexpr int I0 = 16 * 128, I1 = 16 * 96, I2 = 8 * 32, I5 = 16 * 32, I6 = 16 * 176, I7 = 44 * 32;
    constexpr int NITEMS = I0 + I1 + 3 * I2 + I5 + I6 + I7;
    for (int it = gw; it < NITEMS; it += ngw) {
        int r = it;
        if (r < I0) { const int kb = r / 128, nb = r % 128; transpose_item(w_in, INW, 64 * kb, 32 * nb, Win, 1024, 32 * nb, scr, lane); continue; } r -= I0;
        if (r < I1) { const int kb = r / 96, nb = r % 96; transpose_item(w_in, INW, 64 * kb, 4112 + 32 * nb, Win, 1024, 4352 + 32 * nb, scr, lane); continue; } r -= I1;
        if (r < 3 * I2) { const int br = r / I2, q = r % I2, kb = q / 32, nb = q % 32;
            const float* src = launder(br == 0 ? PP(p_a) : (br == 1 ? PP(p_b) : PP(p_c))) + (size_t)l * 512 * 1024;
            transpose_item(src, 1024, 64 * kb, 32 * nb, WP, 512, 1024 * br + 32 * nb, scr, lane); continue; } r -= 3 * I2;
        if (r < I5) { const int kb = r / 32, nb = r % 32; transpose_item(launder(PP(w_out)) + (size_t)l * 1024 * 1024, 1024, 64 * kb, 32 * nb, WO, 1024, 32 * nb, scr, lane); continue; } r -= I5;
        if (r < I6) { const int kb = r / 176, nb = r % 176, j = nb >> 3, half = (nb >> 2) & 1, q = nb & 3;
            transpose_item(launder(PP(ffn_w_up)) + (size_t)l * 1024 * DFF2, DFF2, 64 * kb, DFF * half + 128 * j + 32 * q, WU, 1024, 256 * j + 128 * half + 32 * q, scr, lane); continue; } r -= I6;
        { const int kb = r / 32, nb = r % 32; transpose_item(launder(PP(ffn_w_down)) + (size_t)l * DFF * 1024, 1024, 64 * kb, 32 * nb, WD, DFF, 32 * nb, scr, lane); }
    }
    for (int idx = gw * 64 + lane; idx < 256 * 1024; idx += ngw * 64) { const int n = idx >> 10, k = idx & 1023;
        const float v = (n < 16) ? w_in[(size_t)k * INW + 4096 + n] : 0.f; Win[(size_t)(4096 + n) * 1024 + k] = f2bf(v); }
}

__device__ __forceinline__ void row_phase(const float* hin, const bf16_t* y, const float* gpost, float* hout, const float* gpre, bf16_t* xn, int gw, int ngw, int lane) {
    hin = launder(hin); y = launder(y); hout = launder(hout); xn = launder(xn); gpost = launder(gpost); gpre = launder(gpre); lane = vlaunder((int)threadIdx.x) & 63;
    for (int m = gw; m < MTOK; m += ngw) {
        const f32x4* hr = (const f32x4*)(hin + (size_t)m * DM) + lane;
        f32x4 v[4];
#pragma unroll
        for (int j = 0; j < 4; ++j) v[j] = hr[64 * j];
        if (y) {
            const u32x2* yr = (const u32x2*)(y + (size_t)m * DM) + lane; f32x4 yv[4]; float s = 0.f;
#pragma unroll
            for (int j = 0; j < 4; ++j) { const u32x2 yw = yr[64 * j]; yv[j] = (f32x4){bflo(yw.x), bfhi(yw.x), bflo(yw.y), bfhi(yw.y)}; s += (yv[j].x * yv[j].x + yv[j].y * yv[j].y) + (yv[j].z * yv[j].z + yv[j].w * yv[j].w); }
            const float r = __builtin_amdgcn_rsqf(wave_sum(s) * (1.f / DM) + EPS);
#pragma unroll
            for (int j = 0; j < 4; ++j) { const f32x4 gp = *((const f32x4*)gpost + lane + 64 * j); v[j] += yv[j] * r * gp; }
        }
        if (hout) { f32x4* ho = (f32x4*)(hout + (size_t)m * DM) + lane;
#pragma unroll
            for (int j = 0; j < 4; ++j) ho[64 * j] = v[j]; }
        if (xn) {
            float s = 0.f;
#pragma unroll
            for (int j = 0; j < 4; ++j) s += (v[j].x * v[j].x + v[j].y * v[j].y) + (v[j].z * v[j].z + v[j].w * v[j].w);
            const float r = __builtin_amdgcn_rsqf(wave_sum(s) * (1.f / DM) + EPS);
            u32x2* xo = (u32x2*)(xn + (size_t)m * DM) + lane;
#pragma unroll
            for (int j = 0; j < 4; ++j) { const f32x4 g = *((const f32x4*)gpre + lane + 64 * j); const f32x4 o = v[j] * r * g; u32x2 w; w.x = cvt_pk_bf16(o.x, o.y); w.y = cvt_pk_bf16(o.z, o.w); xo[64 * j] = w; }
        }
    }
}

__device__ __forceinline__ void sb_phase(LAS unsigned char* lds, unsigned char* ws, int tid, int wave, int lane, size_t dst_off = WS_QA) {
    ws = launder(ws); tid = vlaunder((int)threadIdx.x); lane = tid & 63;
    bf16_t* QA = (bf16_t*)(ws + WS_QA); bf16_t* YA = (bf16_t*)(ws + dst_off); const bf16_t* KA = (const bf16_t*)(ws + WS_KA); const bf16_t* VA = (const bf16_t*)(ws + WS_VA);
    LAS bf16_t* sK = (LAS bf16_t*)lds;
    LAS bf16_t* sVt = (LAS bf16_t*)(lds + 9216);
    const int r = lane & 15, g = lane >> 4;
    for (int u = blockIdx.x; u < BATCH * 8 * 32; u += gridDim.x) {
        const int b = u >> 8, h = (u >> 5) & 7, qb = u & 31;
        const int tq0 = qb * 128 + wave * 16, t = tq0 + r;
        const size_t rowbase = (size_t)b * SEQ;
        bf16x8 qf[2];
#pragma unroll
        for (int ks = 0; ks < 2; ++ks) qf[ks] = *(const bf16x8*)(QA + (rowbase + t) * 512 + h * 64 + 32 * ks + 8 * g);
        f32x4 o[4];
#pragma unroll
        for (int i = 0; i < 4; ++i) o[i] = (f32x4){0.f, 0.f, 0.f, 0.f};
        float carry = 0.f;
        for (int kt = qb * 2 + 1; kt >= 0; --kt) {
            {
                const int key = tid >> 3, ch = tid & 7;
                const size_t goff = (rowbase + kt * 64 + key) * 512 + h * 64 + 8 * ch;
                const u32x4 kv = *(const u32x4*)(KA + goff); const u32x4 vv = *(const u32x4*)(VA + goff);
                *(LAS u32x4*)(sK + key * 72 + 8 * ch) = kv;
                LAS bf16_t* vd = sVt + (8 * ch) * 68 + key;
                vd[0 * 68] = (bf16_t)(vv.x & 0xffff); vd[1 * 68] = (bf16_t)(vv.x >> 16); vd[2 * 68] = (bf16_t)(vv.y & 0xffff); vd[3 * 68] = (bf16_t)(vv.y >> 16);
                vd[4 * 68] = (bf16_t)(vv.z & 0xffff); vd[5 * 68] = (bf16_t)(vv.z >> 16); vd[6 * 68] = (bf16_t)(vv.w & 0xffff); vd[7 * 68] = (bf16_t)(vv.w >> 16);
            }
            __syncthreads();
            const bool active = (kt * 64) < (tq0 + 15);
            if (active) {
                f32x4 s[4];
#pragma unroll
                for (int kb = 0; kb < 4; ++kb) { s[kb] = (f32x4){0.f, 0.f, 0.f, 0.f};
#pragma unroll
                    for (int ks = 0; ks < 2; ++ks) { const bf16x8 a = *(const LAS bf16x8*)(sK + (16 * kb + r) * 72 + 32 * ks + 8 * g); s[kb] = mfma16(a, qf[ks], s[kb]); } }
                f32x4 w[4];
#pragma unroll
                for (int kb = 3; kb >= 0; --kb) {
                    float l[4], ls[4]; bool mk[4];
#pragma unroll
                    for (int j = 0; j < 4; ++j) { const int key = kt * 64 + 16 * kb + 4 * g + j; const float z = s[kb][j] * 0.125f; mk[j] = key < t;
                        const float lsz = logsig_f(z); ls[j] = lsz; l[j] = mk[j] ? (lsz - z) : 0.f; }
                    const float sg = (l[0] + l[1]) + (l[2] + l[3]);
                    const float a_ = __shfl_xor(sg, 16); const float b_ = sg + a_; const float c_ = __shfl_xor(b_, 32);
                    const float suf = ((g & 1) == 0 ? a_ : 0.f) + ((g & 2) == 0 ? c_ : 0.f);
                    const float t3 = carry + suf, t2 = t3 + l[3], t1 = t2 + l[2], t0 = t1 + l[1];
                    w[kb][0] = mk[0] ? __expf(ls[0] + t0) : 0.f; w[kb][1] = mk[1] ? __expf(ls[1] + t1) : 0.f;
                    w[kb][2] = mk[2] ? __expf(ls[2] + t2) : 0.f; w[kb][3] = mk[3] ? __expf(ls[3] + t3) : 0.f;
                    carry += b_ + c_;
                }
#pragma unroll
                for (int sI = 0; sI < 2; ++sI) {
                    const bf16x8 pb = pack8(w[2 * sI], w[2 * sI + 1]);
#pragma unroll
                    for (int dvb = 0; dvb < 4; ++dvb) {
                        const LAS bf16_t* vp = sVt + (16 * dvb + r) * 68 + 32 * sI + 4 * g;
                        const u32x2 lo = *(const LAS u32x2*)vp, hi = *(const LAS u32x2*)(vp + 16);
                        u32x4 av; av.x = lo.x; av.y = lo.y; av.z = hi.x; av.w = hi.y;
                        o[dvb] = mfma16(__builtin_bit_cast(bf16x8, av), pb, o[dvb]);
                    }
                }
            }
            const int done = __all(carry < SB_THR) ? 1 : 0;
            if (__syncthreads_and(done)) break;
        }
#pragma unroll
        for (int dvb = 0; dvb < 4; ++dvb) { u32x2 w2; w2.x = cvt_pk_bf16(o[dvb][0], o[dvb][1]); w2.y = cvt_pk_bf16(o[dvb][2], o[dvb][3]);
            *(u32x2*)(YA + (rowbase + t) * 512 + h * 64 + 16 * dvb + 4 * g) = w2; }
        __syncthreads();
    }
}

__device__ __forceinline__ void sg_phase(LAS unsigned char* lds, const Params& p, int l, int tid, int wave, int lane) {
    unsigned char* ws = launder(PP(ws)); tid = vlaunder((int)threadIdx.x); lane = tid & 63;
    bf16_t* U = (bf16_t*)(ws + WS_U); const bf16_t* SV = (const bf16_t*)(ws + WS_SV);
    LAS bf16_t* sVn = (LAS bf16_t*)(lds + wave * (64 * 136 * 2));
    LAS float* sSt = (LAS float*)(lds + 8 * 64 * 136 * 2);
    const int r = lane & 15, gq = lane >> 4;
    const float* lng = launder(PP(sg_ln_g)) + l * 512; const float* lnb = launder(PP(sg_ln_b)) + l * 512;
    const float* W = launder(PP(sg_w)) + ((size_t)(l * 8 + wave)) * 128 * 128;
    const float* Bs = launder(PP(sg_b)) + (l * 8 + wave) * 128;
    for (int u = blockIdx.x; u < BATCH * 32; u += gridDim.x) {
        const size_t row0 = (size_t)u * 128;
        for (int i = 0; i < 16; ++i) {
            const int tok = wave * 16 + i;
            const u32x4 vv = *(const u32x4*)(SV + (row0 + tok) * 512 + 8 * lane);
            float x[8] = {bflo(vv.x), bfhi(vv.x), bflo(vv.y), bfhi(vv.y), bflo(vv.z), bfhi(vv.z), bflo(vv.w), bfhi(vv.w)};
            float s = 0.f;
#pragma unroll
            for (int e = 0; e < 8; ++e) s += x[e];
            const float mu = wave_sum(s) * (1.f / 512.f);
            float q = 0.f;
#pragma unroll
            for (int e = 0; e < 8; ++e) { const float d = x[e] - mu; q += d * d; }
            const float rs = __builtin_amdgcn_rsqf(wave_sum(q) * (1.f / 512.f) + EPS);
            if (lane == 0) { sSt[tok * 2] = mu; sSt[tok * 2 + 1] = rs; }
        }
        __syncthreads();
#pragma unroll
        for (int i = 0; i < 2; ++i) {
            const int s = lane + 64 * i; const float mu = sSt[s * 2], rs = sSt[s * 2 + 1];
#pragma unroll
            for (int c = 0; c < 8; ++c) {
                const u32x4 vv = *(const u32x4*)(SV + (row0 + s) * 512 + wave * 64 + 8 * c);
                const float x[8] = {bflo(vv.x), bfhi(vv.x), bflo(vv.y), bfhi(vv.y), bflo(vv.z), bfhi(vv.z), bflo(vv.w), bfhi(vv.w)};
                const f32x4 g0 = *(const f32x4*)(lng + wave * 64 + 8 * c), g1 = *(const f32x4*)(lng + wave * 64 + 8 * c + 4);
                const f32x4 b0 = *(const f32x4*)(lnb + wave * 64 + 8 * c), b1 = *(const f32x4*)(lnb + wave * 64 + 8 * c + 4);
#pragma unroll
                for (int e = 0; e < 8; ++e) { const float gg = e < 4 ? g0[e & 3] : g1[e & 3], bb = e < 4 ? b0[e & 3] : b1[e & 3];
                    sVn[(8 * c + e) * 136 + s] = f2bf((x[e] - mu) * rs * gg + bb); }
            }
        }
        __syncthreads();
        {
            f32x4 acc[8][4];
#pragma unroll
            for (int tb = 0; tb < 8; ++tb)
#pragma unroll
                for (int i = 0; i < 4; ++i) acc[tb][i] = (f32x4){0.f, 0.f, 0.f, 0.f};
#pragma unroll
            for (int ks = 0; ks < 4; ++ks) {
                const int s0 = 32 * ks + 8 * gq;
                bf16x8 bb[4];
#pragma unroll
                for (int db = 0; db < 4; ++db) bb[db] = *(const LAS bf16x8*)(sVn + (16 * db + r) * 136 + s0);
#pragma unroll
                for (int tb = 2 * ks; tb < 8; ++tb) {
                    const int t = 16 * tb + r;
                    f32x4 w0 = *(const f32x4*)(W + t * 128 + s0), w1 = *(const f32x4*)(W + t * 128 + s0 + 4);
#pragma unroll
                    for (int e = 0; e < 4; ++e) { if (s0 + e > t) w0[e] = 0.f; if (s0 + 4 + e > t) w1[e] = 0.f; }
                    const bf16x8 a = pack8(w0, w1);
#pragma unroll
                    for (int db = 0; db < 4; ++db) acc[tb][db] = mfma16(a, bb[db], acc[tb][db]);
                }
            }
#pragma unroll
            for (int tb = 0; tb < 8; ++tb)
#pragma unroll
                for (int j = 0; j < 4; ++j) { const int tt = 16 * tb + 4 * gq + j; const float bsv = Bs[tt];
#pragma unroll
                    for (int db = 0; db < 4; ++db) { bf16_t* up = U + (row0 + tt) * 512 + wave * 64 + 16 * db + r; *up = f2bf(bf2f(*up) * (acc[tb][db][j] + bsv)); } }
        }
        __syncthreads();
    }
}

template <bool PASS_C>
__device__ __forceinline__ void gla_phase(LAS unsigned char* lds, const Params& p, int l, int tid, int wave, int lane) {
    unsigned char* ws = launder(PP(ws)); tid = vlaunder((int)threadIdx.x); lane = tid & 63;
    const bf16_t* GQ = (const bf16_t*)(ws + WS_GQ); const bf16_t* GK = (const bf16_t*)(ws + WS_GK); const bf16_t* GV = (const bf16_t*)(ws + WS_GV);
    bf16_t* GR = (bf16_t*)(ws + WS_GR); const float* GD = (const float*)(ws + WS_GDOWN); float* UPD = (float*)(ws + WS_UPD); float* DEC = (float*)(ws + WS_DEC);
    LAS float* sCum = (LAS float*)lds;
    LAS float* sTot = (LAS float*)(lds + 16384);
    LAS bf16_t* sQD = (LAS bf16_t*)(lds + 18432);
    LAS bf16_t* sKI = (LAS bf16_t*)(lds + 27648);
    LAS bf16_t* sKEt = (LAS bf16_t*)(lds + 36864);
    LAS bf16_t* sVt = (LAS bf16_t*)(lds + 46080);
    LAS bf16_t* sAT = (LAS bf16_t*)(lds + 64512);
    LAS bf16_t* sSt = (LAS bf16_t*)(lds + 73728);
    LAS float* sSS = (LAS float*)(lds + 92160);
    const int r = lane & 15, gq = lane >> 4;
    const float* wgup = launder(PP(gla_w_gup)) + l * 16 * 256; const float* bgate = launder(PP(gla_b_gate)) + l * 256; const float* ng = launder(PP(gla_norm_g)) + l * 128;
    for (int u = blockIdx.x; u < BATCH * 4 * 64; u += gridDim.x) {
        const int b = u >> 8, h = (u >> 6) & 3, n = u & 63;
        const size_t r0 = (size_t)b * SEQ + n * 64;
        const int t_ = tid >> 3, k8 = (tid & 7) * 8;
        {
            const f32x4* gdp = (const f32x4*)(GD + (r0 + t_) * 16);
            const f32x4 g0 = gdp[0], g1 = gdp[1], g2 = gdp[2], g3 = gdp[3];
            const float gd[16] = {g0[0], g0[1], g0[2], g0[3], g1[0], g1[1], g1[2], g1[3], g2[0], g2[1], g2[2], g2[3], g3[0], g3[1], g3[2], g3[3]};
            f32x4 a0 = *(const f32x4*)(bgate + h * 64 + k8), a1 = *(const f32x4*)(bgate + h * 64 + k8 + 4);
#pragma unroll
            for (int rr = 0; rr < 16; ++rr) { const f32x4 w0 = *(const f32x4*)(wgup + rr * 256 + h * 64 + k8), w1 = *(const f32x4*)(wgup + rr * 256 + h * 64 + k8 + 4); a0 += w0 * gd[rr]; a1 += w1 * gd[rr]; }
            f32x4 o0, o1;
#pragma unroll
            for (int e = 0; e < 4; ++e) { o0[e] = logsig_f(a0[e]) * 0.0625f; o1[e] = logsig_f(a1[e]) * 0.0625f; }
            *(LAS f32x4*)(sCum + t_ * 64 + k8) = o0; *(LAS f32x4*)(sCum + t_ * 64 + k8 + 4) = o1;
        }
        __syncthreads();
        {
            const int k = tid & 63, seg = tid >> 6; float run = 0.f;
#pragma unroll
            for (int i = 0; i < 8; ++i) { run += sCum[(8 * seg + i) * 64 + k]; sCum[(8 * seg + i) * 64 + k] = run; }
            sTot[seg * 64 + k] = run;
            __syncthreads();
            float pre = 0.f;
#pragma unroll
            for (int s = 0; s < 7; ++s) pre += (s < seg) ? sTot[s * 64 + k] : 0.f;
#pragma unroll
            for (int i = 0; i < 8; ++i) sCum[(8 * seg + i) * 64 + k] += pre;
        }
        __syncthreads();
        {
            const f32x4 c0 = *(const LAS f32x4*)(sCum + t_ * 64 + k8), c1 = *(const LAS f32x4*)(sCum + t_ * 64 + k8 + 4);
            const f32x4 e0 = *(const LAS f32x4*)(sCum + 63 * 64 + k8), e1 = *(const LAS f32x4*)(sCum + 63 * 64 + k8 + 4);
            const u32x4 kw = *(const u32x4*)(GK + (r0 + t_) * 256 + h * 64 + k8);
            const float kk[8] = {bflo(kw.x), bfhi(kw.x), bflo(kw.y), bfhi(kw.y), bflo(kw.z), bfhi(kw.z), bflo(kw.w), bfhi(kw.w)};
            const float cm[8] = {c0[0], c0[1], c0[2], c0[3], c1[0], c1[1], c1[2], c1[3]};
            const float ce[8] = {e0[0], e0[1], e0[2], e0[3], e1[0], e1[1], e1[2], e1[3]};
            if (PASS_C) {
                const u32x4 qw = *(const u32x4*)(GQ + (r0 + t_) * 256 + h * 64 + k8);
                const float qq[8] = {bflo(qw.x), bfhi(qw.x), bflo(qw.y), bfhi(qw.y), bflo(qw.z), bfhi(qw.z), bflo(qw.w), bfhi(qw.w)};
                f32x4 qa, qb, ka, kb;
#pragma unroll
                for (int e = 0; e < 4; ++e) { qa[e] = qq[e] * 0.125f * __expf(cm[e]); qb[e] = qq[e + 4] * 0.125f * __expf(cm[e + 4]); ka[e] = kk[e] * __expf(-cm[e]); kb[e] = kk[e + 4] * __expf(-cm[e + 4]); }
                *(LAS bf16x8*)(sQD + t_ * 72 + k8) = pack8(qa, qb); *(LAS bf16x8*)(sKI + t_ * 72 + k8) = pack8(ka, kb);
                const int dv = tid >> 2, kq = (tid & 3) * 16; const f32x4* sp = (const f32x4*)(UPD + ((size_t)u * 128 + dv) * 64 + kq);
                const f32x4 s0 = sp[0], s1 = sp[1], s2 = sp[2], s3 = sp[3];
                *(LAS bf16x8*)(sSt + dv * 72 + kq) = pack8(s0, s1); *(LAS bf16x8*)(sSt + dv * 72 + kq + 8) = pack8(s2, s3);
            } else {
#pragma unroll
                for (int e = 0; e < 8; ++e) sKEt[(k8 + e) * 72 + t_] = f2bf(kk[e] * __expf(ce[e] - cm[e]));
                if (t_ == 63) {
#pragma unroll
                    for (int e = 0; e < 8; ++e) DEC[(size_t)u * 64 + k8 + e] = __expf(ce[e]);
                }
            }
            const int s = tid >> 3, c = tid & 7;
            const u32x4 v0 = *(const u32x4*)(GV + (r0 + s) * 512 + h * 128 + 16 * c), v1 = *(const u32x4*)(GV + (r0 + s) * 512 + h * 128 + 16 * c + 8);
            LAS bf16_t* vd = sVt + (16 * c) * 72 + s;
            vd[0 * 72] = (bf16_t)(v0.x & 0xffff); vd[1 * 72] = (bf16_t)(v0.x >> 16); vd[2 * 72] = (bf16_t)(v0.y & 0xffff); vd[3 * 72] = (bf16_t)(v0.y >> 16);
            vd[4 * 72] = (bf16_t)(v0.z & 0xffff); vd[5 * 72] = (bf16_t)(v0.z >> 16); vd[6 * 72] = (bf16_t)(v0.w & 0xffff); vd[7 * 72] = (bf16_t)(v0.w >> 16);
            vd[8 * 72] = (bf16_t)(v1.x & 0xffff); vd[9 * 72] = (bf16_t)(v1.x >> 16); vd[10 * 72] = (bf16_t)(v1.y & 0xffff); vd[11 * 72] = (bf16_t)(v1.y >> 16);
            vd[12 * 72] = (bf16_t)(v1.z & 0xffff); vd[13 * 72] = (bf16_t)(v1.z >> 16); vd[14 * 72] = (bf16_t)(v1.w & 0xffff); vd[15 * 72] = (bf16_t)(v1.w >> 16);
        }
        __syncthreads();
        if (!PASS_C) {
#pragma unroll
            for (int kb = 0; kb < 4; ++kb) { f32x4 acc = (f32x4){0.f, 0.f, 0.f, 0.f};
#pragma unroll
                for (int ks = 0; ks < 2; ++ks) { const bf16x8 a = *(const LAS bf16x8*)(sKEt + (16 * kb + r) * 72 + 32 * ks + 8 * gq); const bf16x8 bb = *(const LAS bf16x8*)(sVt + (16 * wave + r) * 72 + 32 * ks + 8 * gq); acc = mfma16(a, bb, acc); }
                *(f32x4*)(UPD + ((size_t)u * 128 + 16 * wave + r) * 64 + 16 * kb + 4 * gq) = acc; }
        } else {
            {
                const int tb = wave >> 1;
#pragma unroll
                for (int i = 0; i < 2; ++i) { const int sb = 2 * (wave & 1) + i;
                    f32x4 acc = (f32x4){0.f, 0.f, 0.f, 0.f};
                    if (sb <= tb) {
#pragma unroll
                        for (int ks = 0; ks < 2; ++ks) { const bf16x8 a = *(const LAS bf16x8*)(sQD + (16 * tb + r) * 72 + 32 * ks + 8 * gq); const bf16x8 bb = *(const LAS bf16x8*)(sKI + (16 * sb + r) * 72 + 32 * ks + 8 * gq); acc = mfma16(a, bb, acc); }
                    }
#pragma unroll
                    for (int j = 0; j < 4; ++j) { const int tt = 16 * tb + 4 * gq + j, ss = 16 * sb + r; sAT[tt * 72 + ss] = f2bf((sb <= tb && ss <= tt) ? acc[j] : 0.f); } }
            }
            __syncthreads();
            const int tb = wave & 3, hv = wave >> 2;
            f32x4 acc[4];
#pragma unroll
            for (int i = 0; i < 4; ++i) { acc[i] = (f32x4){0.f, 0.f, 0.f, 0.f}; const int dvb = 4 * hv + i;
#pragma unroll
                for (int ks = 0; ks < 2; ++ks) {
                    const bf16x8 a1 = *(const LAS bf16x8*)(sAT + (16 * tb + r) * 72 + 32 * ks + 8 * gq); const bf16x8 b1 = *(const LAS bf16x8*)(sVt + (16 * dvb + r) * 72 + 32 * ks + 8 * gq); acc[i] = mfma16(a1, b1, acc[i]);
                    const bf16x8 a2 = *(const LAS bf16x8*)(sQD + (16 * tb + r) * 72 + 32 * ks + 8 * gq); const bf16x8 b2 = *(const LAS bf16x8*)(sSt + (16 * dvb + r) * 72 + 32 * ks + 8 * gq); acc[i] = mfma16(a2, b2, acc[i]);
                } }
            float ss[4];
#pragma unroll
            for (int j = 0; j < 4; ++j) { float q = 0.f;
#pragma unroll
                for (int i = 0; i < 4; ++i) q += acc[i][j] * acc[i][j];
                q += __shfl_xor(q, 1); q += __shfl_xor(q, 2); q += __shfl_xor(q, 4); q += __shfl_xor(q, 8); ss[j] = q; }
            if (r == 0) {
#pragma unroll
                for (int j = 0; j < 4; ++j) sSS[hv * 64 + 16 * tb + 4 * gq + j] = ss[j];
            }
            __syncthreads();
#pragma unroll
            for (int j = 0; j < 4; ++j) { const int tt = 16 * tb + 4 * gq + j; const float rs = __builtin_amdgcn_rsqf((sSS[tt] + sSS[64 + tt]) * (1.f / 128.f) + EPS);
#pragma unroll
                for (int i = 0; i < 4; ++i) { const int dv = 16 * (4 * hv + i) + r; bf16_t* gp = GR + (r0 + tt) * 512 + h * 128 + dv; *gp = f2bf(acc[i][j] * rs * ng[dv] * bf2f(*gp)); } }
        }
        __syncthreads();
    }
}
__device__ __forceinline__ void gla_scan(unsigned char* ws, int gtid, int ngt) {
    ws = launder(ws); gtid = blockIdx.x * 512 + vlaunder((int)threadIdx.x);
    float* UPD = (float*)(ws + WS_UPD); const float* DEC = (const float*)(ws + WS_DEC);
    for (int e = gtid; e < 32 * 8192; e += ngt) {
        const int bh = e >> 13, rem = e & 8191, dk = rem & 63; float S = 0.f;
#pragma unroll 1
        for (int n0 = 0; n0 < 64; n0 += 16) {
            float uv[16], dv[16];
#pragma unroll
            for (int i = 0; i < 16; ++i) { uv[i] = UPD[((size_t)(bh * 64 + n0 + i)) * 8192 + rem]; dv[i] = DEC[(bh * 64 + n0 + i) * 64 + dk]; }
#pragma unroll
            for (int i = 0; i < 16; ++i) { UPD[((size_t)(bh * 64 + n0 + i)) * 8192 + rem] = S; S = dv[i] * S + uv[i]; }
        }
    }
}
__device__ __forceinline__ void conv_fix(const Params& p, int l, int gtid, int ngt) {
    unsigned char* ws = launder(PP(ws)); gtid = blockIdx.x * 512 + vlaunder((int)threadIdx.x);
    const float* head = (const float*)(ws + WS_HEAD); const float* tail = (const float*)(ws + WS_TAIL); bf16_t* act = (bf16_t*)(ws + WS_ACT);
    const float* cw = launder(PP(ffn_conv_w)) + (size_t)l * 3 * DFF2; const float* cb = launder(PP(ffn_conv_b)) + (size_t)l * DFF2;
    for (int e = gtid; e < 128 * DFF; e += ngt) {
        const int pm = e / DFF, c = e % DFF, j = c >> 7, cc = c & 127; const int pa = 256 * j + cc, pu = pa + 128;
        const bool first = (pm & 15) == 0;
        const float ta0 = first ? 0.f : tail[((size_t)(pm - 1) * 2 + 0) * DFF2 + pa], ta1 = first ? 0.f : tail[((size_t)(pm - 1) * 2 + 1) * DFF2 + pa];
        const float tu0 = first ? 0.f : tail[((size_t)(pm - 1) * 2 + 0) * DFF2 + pu], tu1 = first ? 0.f : tail[((size_t)(pm - 1) * 2 + 1) * DFF2 + pu];
        const float ha0 = head[((size_t)pm * 2 + 0) * DFF2 + pa], ha1 = head[((size_t)pm * 2 + 1) * DFF2 + pa];
        const float hu0 = head[((size_t)pm * 2 + 0) * DFF2 + pu], hu1 = head[((size_t)pm * 2 + 1) * DFF2 + pu];
        const float wa0 = cw[c], wa1 = cw[DFF2 + c], wa2 = cw[2 * DFF2 + c], ba = cb[c];
        const float wu0 = cw[DFF + c], wu1 = cw[DFF2 + DFF + c], wu2 = cw[2 * DFF2 + DFF + c], bu = cb[DFF + c];
        const float ca0 = ba + wa0 * ta0 + wa1 * ta1 + wa2 * ha0, cu0 = bu + wu0 * tu0 + wu1 * tu1 + wu2 * hu0;
        const float ca1 = ba + wa0 * ta1 + wa1 * ha0 + wa2 * ha1, cu1 = bu + wu0 * tu1 + wu1 * hu0 + wu2 * hu1;
        act[((size_t)pm * 256 + 0) * DFF + c] = f2bf(gelu_tanh_f(ca0) * cu0);
        act[((size_t)pm * 256 + 1) * DFF + c] = f2bf(gelu_tanh_f(ca1) * cu1);
    }
}

#define XB_TMO      128
#define XB_XCNT(j)  (256  + 64 * (j))
#define XB_XSUB(j)  (1280 + 64 * (j))
#define XB_XGEN(j)  (2304 + 64 * (j))
#define XB_TOP      3328
#define XB_TOPGEN   3392
#define XCD_BAR_WORDS 3456
#define XB_SPIN_CAP (1u << 18)

__device__ __forceinline__ unsigned xb_ld(unsigned* p)              { return __hip_atomic_load(p, __ATOMIC_RELAXED, __HIP_MEMORY_SCOPE_AGENT); }
__device__ __forceinline__ unsigned xb_add(unsigned* p, unsigned v) { return __hip_atomic_fetch_add(p, v, __ATOMIC_RELAXED, __HIP_MEMORY_SCOPE_AGENT); }
__device__ __forceinline__ unsigned xb_xcc_id() { return (unsigned)__builtin_amdgcn_s_getreg((3 << 11) | 20) & 0xFu; }
#define XB_SPIN(cond, bar) do { unsigned _sp = 0; while (cond) { __builtin_amdgcn_s_sleep(1); \
    if ((++_sp & 255u) == 0u) { if (xb_ld(&(bar)[XB_TMO])) break; if (_sp > XB_SPIN_CAP) { atomicAdd(&(bar)[XB_TMO], 1u); break; } } } } while (0)

struct XcdBarrier {
    unsigned* bar; unsigned x;
    volatile LAS unsigned* st;
};

__device__ __forceinline__ XcdBarrier xcd_barrier_post(unsigned* bar, volatile LAS unsigned* st) {
    XcdBarrier b; b.bar = bar; b.x = xb_xcc_id(); b.st = st;
    if (threadIdx.x == 0) (void)xb_add(&bar[XB_XCNT(b.x)], 1u);
    return b;
}
__device__ __forceinline__ void xcd_barrier_complete(unsigned* bar, unsigned x, unsigned& nloc, unsigned& nx) {
    const unsigned G = gridDim.x * gridDim.y * gridDim.z;
    unsigned sum, cnt, mine, sp = 0u;
    for (;;) {
        sum = 0u; cnt = 0u; mine = 0u;
#pragma unroll
        for (unsigned j = 0; j < 16; ++j) { const unsigned c = xb_ld(&bar[XB_XCNT(j)]); sum += c; cnt += (c > 0u) ? 1u : 0u; mine = (j == x) ? c : mine; }
        if (sum == G) break;
        __builtin_amdgcn_s_sleep(1);
        if ((++sp & 255u) == 0u) { if (xb_ld(&bar[XB_TMO])) break; if (sp > XB_SPIN_CAP) { atomicAdd(&bar[XB_TMO], 1u); break; } }
    }
    nloc = mine > 0u ? mine : 1u; nx = cnt > 0u ? cnt : 1u;
}

__device__ __forceinline__ void xcd_barrier(const XcdBarrier& b) {
    asm volatile("s_waitcnt vmcnt(0)" ::: "memory");
    __syncthreads();
    if (threadIdx.x == 0) {
        unsigned* bar = b.bar;
        __builtin_amdgcn_s_waitcnt(0);
        unsigned nloc = b.st[0], nx = b.st[1];
        if (nloc == 0u) { xcd_barrier_complete(bar, b.x, nloc, nx); b.st[0] = nloc; b.st[1] = nx; }
        const unsigned old = xb_add(&bar[XB_XSUB(b.x)], 1u);
        const unsigned gen = old / nloc;
        if (old + 1u == (gen + 1u) * nloc) {
            __builtin_amdgcn_fence(__ATOMIC_RELEASE, "agent");
            asm volatile("s_waitcnt vmcnt(0)" ::: "memory");
            const unsigned og = xb_add(&bar[XB_TOP], 1u);
            const unsigned tg = og / nx;
            if (og + 1u == (tg + 1u) * nx) xb_add(&bar[XB_TOPGEN], 1u);
            else XB_SPIN(xb_ld(&bar[XB_TOPGEN]) == tg, bar);
            __builtin_amdgcn_fence(__ATOMIC_ACQUIRE, "agent");
            xb_add(&bar[XB_XGEN(b.x)], 1u);
            asm volatile("s_waitcnt vmcnt(0)" ::: "memory");
        } else {
            XB_SPIN(xb_ld(&bar[XB_XGEN(b.x)]) == gen, bar);
            __builtin_amdgcn_fence(__ATOMIC_ACQUIRE, "agent");
            asm volatile("s_waitcnt vmcnt(0)" ::: "memory");
        }
    }
    __syncthreads();
}
#define CG_SYNC() do { asm volatile("s_waitcnt vmcnt(0) lgkmcnt(0)" ::: "memory"); grid.sync(); } while (0)
#define GRID_SYNC() do { for (int rs_ = 0; rs_ < REP_SYNC; ++rs_) { xcd_barrier(xbar); } } while (0)
#ifndef DBG_STOP
#define DBG_STOP 0
#endif
#ifndef REP_GEMM
#define REP_GEMM 1
#endif
#ifndef REP_SYNC
#define REP_SYNC 1
#endif
#ifndef PROBE
#define PROBE 0
#endif
__device__ __forceinline__ void dbg_dump(float* out, const bf16_t* a, const bf16_t* b, const bf16_t* c, int lda) {
    for (size_t e = (size_t)blockIdx.x * 512 + threadIdx.x; e < (size_t)MTOK * DM; e += (size_t)gridDim.x * 512) {
        const size_t m = e >> 10; const int col = (lda == 3072) ? (int)(e & 1023) + 1024 * (int)(m % 3) : (int)(e & 1023) % lda; float v = bf2f(a[m * lda + col]); if (b) v += bf2f(b[m * lda + col]); if (c) v += bf2f(c[m * lda + col]); out[e] = v; }
}
__global__ void __launch_bounds__(512, 2) mega_fwd(Params p) {
    extern __shared__ __attribute__((aligned(16))) unsigned char lds_raw[];
    LAS unsigned char* lds = (LAS unsigned char*)lds_raw;
    cg::grid_group grid = cg::this_grid();
    const int tid = 0, lane = 0, wave = __builtin_amdgcn_readfirstlane((int)threadIdx.x >> 6);
    const int G = gridDim.x, gw = blockIdx.x * 8 + wave, ngw = G * 8, ngt = G * 512;
    unsigned char* ws = PP(ws);
    bf16_t* XN = (bf16_t*)(ws + WS_XN);
    volatile LAS unsigned* misc = (volatile LAS unsigned*)(lds + MISC_OFF);
    if (threadIdx.x < 4) misc[threadIdx.x] = 0u;
    __syncthreads();
    const XcdBarrier xbar = xcd_barrier_post((unsigned*)(ws + WS_BAR), misc);

    convert_weights(p, 0, lds, gw, ngw, wave, lane);
    if (PROBE & 1) convert_weights(p, 0, lds, gw, ngw, wave, lane);
    row_phase(PP(x), nullptr, nullptr, nullptr, PP(mix_pre_g), XN, gw, ngw, lane);
    CG_SYNC();
    if (DBG_STOP == 8) {
        {
            unsigned char* ws = launder(PP(ws)); bf16_t* XN = (bf16_t*)(ws + WS_XN);
            pg8::Gemm g{XN, (const bf16_t*)(ws + WS_WIN) + (size_t)4352 * 1024, 1024, 1024, 1024, 0, 0}; pg8::StaticOrder S; S.init(MTOK, 3072, G, (int)blockIdx.x);
            pg8::EpiGates E{(bf16_t*)(ws + WS_GATES)}; pg8::gemm_phase(lds, g, S, E);
        }
        GRID_SYNC();
        dbg_dump(PP(out), (const bf16_t*)(ws + WS_GATES), nullptr, nullptr, 3072); return;
    }
#pragma unroll 1
    for (int l = 0; l < 2; ++l) {
        {
            unsigned char* ws = launder(PP(ws)); bf16_t* XN = (bf16_t*)(ws + WS_XN);
            pg8::Gemm g{XN, (const bf16_t*)(ws + WS_WIN), 1024, 1024, 1024, 0, 0}; pg8::StaticOrder S; S.init(MTOK, 4352, G, (int)blockIdx.x);
            pg8::EpiG1 E{ws}; for (int rep_ = 0; rep_ < REP_GEMM; ++rep_) pg8::gemm_phase(lds, g, S, E);
        }
        GRID_SYNC();
        if (DBG_STOP == 1) { dbg_dump(PP(out), (const bf16_t*)(ws + WS_KA), (const bf16_t*)(ws + WS_SV), (const bf16_t*)(ws + WS_GV), 512); return; }
        if (PROBE & 16) sb_phase(lds, ws, tid, wave, lane, 428 * MiB);
        sb_phase(lds, ws, tid, wave, lane);
        sg_phase(lds, p, l, tid, wave, lane);
        gla_phase<false>(lds, p, l, tid, wave, lane);
        if (PROBE & 4) gla_phase<false>(lds, p, l, tid, wave, lane);
        GRID_SYNC();
        gla_scan(ws, 0, ngt);
        GRID_SYNC();
        gla_phase<true>(lds, p, l, tid, wave, lane);
        GRID_SYNC();
        if (DBG_STOP == 2) { dbg_dump(PP(out), (const bf16_t*)(ws + WS_QA), (const bf16_t*)(ws + WS_U), (const bf16_t*)(ws + WS_GR), 512); return; }
        {
            unsigned char* ws = launder(PP(ws)); bf16_t* XN = (bf16_t*)(ws + WS_XN);
            pg8::Gemm g{XN, (const bf16_t*)(ws + WS_WIN) + (size_t)4352 * 1024, 1024, 1024, 1024, 0, 0}; pg8::StaticOrder S; S.init(MTOK, 3072, G, (int)blockIdx.x);
            pg8::EpiGates E{(bf16_t*)(ws + WS_GATES)}; for (int rep_ = 0; rep_ < REP_GEMM; ++rep_) pg8::gemm_phase(lds, g, S, E);
        }
        GRID_SYNC();
        if (DBG_STOP == 7) { dbg_dump(PP(out), (const bf16_t*)(ws + WS_GATES), nullptr, nullptr, 3072); return; }
        {
            unsigned char* ws = launder(PP(ws)); bf16_t* XN = (bf16_t*)(ws + WS_XN);
            pg8::Gemm g{(const bf16_t*)(ws + WS_QA), (const bf16_t*)(ws + WS_WP), 512, 512, 512, 4, (size_t)(32 * MiB)}; pg8::MergeOrder S; S.base.init(MTOK, 1024, G, (int)blockIdx.x);
            pg8::EpiMerge E{(const bf16_t*)(ws + WS_GATES), XN}; for (int rep_ = 0; rep_ < REP_GEMM; ++rep_) pg8::gemm_phase(lds, g, S, E);
        }
        GRID_SYNC();
        if (DBG_STOP == 3) { dbg_dump(PP(out), (const bf16_t*)(ws + WS_XN), nullptr, nullptr, 1024); return; }
        {
            unsigned char* ws = launder(PP(ws)); bf16_t* XN = (bf16_t*)(ws + WS_XN);
            pg8::Gemm g{XN, (const bf16_t*)(ws + WS_WOUT), 1024, 1024, 1024, 0, 0}; pg8::StaticOrder S; S.init(MTOK, 1024, G, (int)blockIdx.x);
            pg8::EpiF32 E{(bf16_t*)(ws + WS_Y32)}; for (int rep_ = 0; rep_ < REP_GEMM; ++rep_) pg8::gemm_phase(lds, g, S, E);
        }
        GRID_SYNC();
        row_phase(l == 0 ? PP(x) : (const float*)PP(out), (const bf16_t*)(ws + WS_Y32), PP(mix_post_g) + l * DM, PP(out), PP(ffn_pre_g) + l * DM, XN, gw, ngw, lane);
        GRID_SYNC();
        if (DBG_STOP == 4) return;
        {
            unsigned char* ws = launder(PP(ws)); bf16_t* XN = (bf16_t*)(ws + WS_XN);
            pg8::Gemm g{XN, (const bf16_t*)(ws + WS_WUP), 1024, 1024, 1024, 0, 0}; pg8::StaticOrder S; S.init(MTOK, DFF2, G, (int)blockIdx.x);
            pg8::EpiConv E{launder(PP(ffn_conv_w)) + (size_t)l * 3 * DFF2, launder(PP(ffn_conv_b)) + (size_t)l * DFF2, (bf16_t*)(ws + WS_ACT), (float*)(ws + WS_HEAD), (float*)(ws + WS_TAIL)};
            for (int rep_ = 0; rep_ < REP_GEMM; ++rep_) pg8::gemm_phase(lds, g, S, E);
        }
        GRID_SYNC();
        conv_fix(p, l, 0, ngt);
        GRID_SYNC();
        if (DBG_STOP == 5) { dbg_dump(PP(out), (const bf16_t*)(ws + WS_ACT), nullptr, nullptr, 1024); return; }
        {
            unsigned char* ws = launder(PP(ws));
            pg8::Gemm g{(const bf16_t*)(ws + WS_ACT), (const bf16_t*)(ws + WS_WDN), DFF, DFF, DFF, 0, 0}; pg8::StaticOrder S; S.init(MTOK, 1024, G, (int)blockIdx.x);
            pg8::EpiF32 E{(bf16_t*)(ws + WS_Y32B)}; for (int rep_ = 0; rep_ < REP_GEMM; ++rep_) pg8::gemm_phase(lds, g, S, E);
        }
        GRID_SYNC();
        if (l == 0) {
            row_phase(PP(out), (const bf16_t*)(ws + WS_Y32B), PP(ffn_post_g), PP(out), PP(mix_pre_g) + DM, XN, gw, ngw, lane);
            convert_weights(p, 1, lds, gw, ngw, wave, lane);
            if (PROBE & 1) convert_weights(p, 1, lds, gw, ngw, wave, lane);
            GRID_SYNC();
            if (DBG_STOP == 6) return;
        } else {
            row_phase(PP(out), (const bf16_t*)(ws + WS_Y32B), PP(ffn_post_g) + DM, PP(out), nullptr, nullptr, gw, ngw, lane);
        }
    }
}

extern "C" void kernel_launch(void* const* d_in, const int* in_sizes, int n_in, void* d_out, int out_size, void* d_ws, size_t ws_size, hipStream_t stream) {
    static int grid = 0;
    if (grid == 0) {
        if (n_in != 21 || out_size != MTOK * DM || ws_size < WS_END) { fprintf(stderr, "kernel_launch: unexpected shapes (n_in %d, out %d, ws %zu)\n", n_in, out_size, ws_size); grid = -1; return; }
        int dev = 0, cus = 0, per_cu = 0;
        hipGetDevice(&dev); hipDeviceGetAttribute(&cus, hipDeviceAttributeMultiprocessorCount, dev);
        if (hipFuncSetAttribute((const void*)mega_fwd, hipFuncAttributeMaxDynamicSharedMemorySize, LDS_BYTES) != hipSuccess) { fprintf(stderr, "kernel_launch: hipFuncSetAttribute failed\n"); grid = -1; return; }
        if (hipOccupancyMaxActiveBlocksPerMultiprocessor(&per_cu, (const void*)mega_fwd, 512, LDS_BYTES) != hipSuccess || per_cu < 1) { fprintf(stderr, "kernel_launch: occupancy query says %d blocks/CU\n", per_cu); per_cu = 1; }
        (void)hipGetLastError();
        grid = cus;
    }
    if (grid < 0) return;
    Params p{};
    const float** f = (const float**)&p;
    for (int i = 0; i < 21; ++i) f[i] = (const float*)d_in[i];
    p.out = (float*)d_out; p.ws = (unsigned char*)d_ws;
    (void)hipMemsetAsync(d_ws, 0, 65536, stream);
    void* args[] = {&p};
    hipError_t e = hipLaunchCooperativeKernel((const void*)mega_fwd, dim3(grid), dim3(512), args, LDS_BYTES, stream);
    if (e != hipSuccess) fprintf(stderr, "cooperative launch failed: %s (grid %d)\n", hipGetErrorString(e), grid);
}
```

```cpp
#include <hip/hip_runtime.h>
#include <hip/hip_cooperative_groups.h>
#include <cstdio>
#include <cstdint>
namespace cg = cooperative_groups;

#define LAS __attribute__((address_space(3)))
typedef unsigned short bf16_t;
typedef short bf16x8 __attribute__((ext_vector_type(8)));
typedef float f32x4 __attribute__((ext_vector_type(4)));
typedef unsigned u32x4 __attribute__((ext_vector_type(4)));
typedef unsigned u32x2 __attribute__((ext_vector_type(2)));

constexpr int BATCH = 8, SEQ = 4096, DM = 1024, MTOK = BATCH * SEQ;
constexpr int INW = 7184, DFF = 2816, DFF2 = 5632;
constexpr float EPS = 1e-6f;
constexpr float SB_THR = -106.0f * 1.4426950409f;

constexpr size_t MiB = 1u << 20;
constexpr size_t WS_GDOWN = 1 * MiB;
constexpr size_t WS_DEC = 3 * MiB;
constexpr size_t WS_WIN = 4 * MiB;
constexpr size_t WS_WP = 19 * MiB;
constexpr size_t WS_WOUT = 22 * MiB;
constexpr size_t WS_WUP = 24 * MiB;
constexpr size_t WS_WDN = 35 * MiB;
constexpr size_t WS_XN = 41 * MiB;
constexpr size_t WS_QA = 105 * MiB, WS_U = 137 * MiB, WS_GR = 169 * MiB;
constexpr size_t WS_KA = 201 * MiB, WS_VA = 233 * MiB, WS_SV = 265 * MiB, WS_GV = 297 * MiB;
constexpr size_t WS_GQ = 329 * MiB, WS_GK = 345 * MiB;
constexpr size_t WS_UPD = 361 * MiB;
constexpr size_t WS_GATES = 201 * MiB;
constexpr size_t WS_Y32 = 105 * MiB;
constexpr size_t WS_ACT = 105 * MiB;
constexpr size_t WS_HEAD = 282 * MiB;
constexpr size_t WS_TAIL = 288 * MiB;
constexpr size_t WS_Y32B = 300 * MiB;
constexpr size_t WS_END = 428 * MiB;

constexpr int LDS_BYTES = 147456;
constexpr int MISC_OFF = 147456 - 64;
constexpr size_t WS_BAR = 0;
constexpr int XT_OFF = 131072;

typedef float f32x2_t __attribute__((ext_vector_type(2)));
typedef __bf16 bf16x2_t __attribute__((ext_vector_type(2)));
__device__ __forceinline__ unsigned cvt_pk_bf16(float lo, float hi) { const f32x2_t v = {lo, hi}; const bf16x2_t b = __builtin_convertvector(v, bf16x2_t); return __builtin_bit_cast(unsigned, b); }
__device__ __forceinline__ float bf2f(unsigned short h) { return __uint_as_float(((unsigned)h) << 16); }
__device__ __forceinline__ float bflo(unsigned w) { return __uint_as_float(w << 16); }
__device__ __forceinline__ float bfhi(unsigned w) { return __uint_as_float(w & 0xffff0000u); }
__device__ __forceinline__ unsigned short f2bf(float f) { return (unsigned short)(cvt_pk_bf16(f, 0.f) & 0xffffu); }
__device__ __forceinline__ bf16x8 pack8(f32x4 a, f32x4 b) {
    u32x4 w; w.x = cvt_pk_bf16(a[0], a[1]); w.y = cvt_pk_bf16(a[2], a[3]); w.z = cvt_pk_bf16(b[0], b[1]); w.w = cvt_pk_bf16(b[2], b[3]);
    return __builtin_bit_cast(bf16x8, w);
}
__device__ __forceinline__ float rcpf_(float x) { return __builtin_amdgcn_rcpf(x); }
__device__ __forceinline__ float gelu_tanh_f(float x) { const float u = 0.7978845608f * (x + 0.044715f * x * x * x); return x * rcpf_(1.f + __expf(-2.f * u)); }
__device__ __forceinline__ float sigmoid_f(float x) { return rcpf_(1.f + __expf(-x)); }
__device__ __forceinline__ float logsig_f(float x) { return fminf(x, 0.f) - __logf(1.f + __expf(-fabsf(x))); }
__device__ __forceinline__ float logsig2_f(float x2) { return fminf(x2, 0.f) - __builtin_amdgcn_logf(1.f + __builtin_amdgcn_exp2f(-fabsf(x2))); }
__device__ __forceinline__ f32x4 mfma16(bf16x8 a, bf16x8 b, f32x4 c) { return __builtin_amdgcn_mfma_f32_16x16x32_bf16(a, b, c, 0, 0, 0); }
__device__ __forceinline__ float wave_sum(float v) {
#pragma unroll
    for (int o = 1; o < 64; o <<= 1) v += __shfl_xor(v, o);
    return v;
}
#define LDS_WAIT() asm volatile("s_waitcnt lgkmcnt(0)" ::: "memory")
template <class T> __device__ __forceinline__ T* launder(T* p) {
    const unsigned long long v = (unsigned long long)p; unsigned lo = __builtin_amdgcn_readfirstlane((unsigned)v), hi = __builtin_amdgcn_readfirstlane((unsigned)(v >> 32));
    asm volatile("" : "+s"(lo), "+s"(hi)); return (T*)(((unsigned long long)hi << 32) | lo); }
__device__ __forceinline__ int lane_id_() { int l = (int)__builtin_amdgcn_mbcnt_hi(~0u, __builtin_amdgcn_mbcnt_lo(~0u, 0u)); asm volatile("" : "+v"(l)); return l; }
__device__ __forceinline__ int vlaunder(int x) { asm volatile("" : "+v"(x)); return x; }
__device__ __forceinline__ float dpp_shr1(float v) { return __builtin_bit_cast(float, __builtin_amdgcn_update_dpp(0, __builtin_bit_cast(int, v), 0x111, 0xf, 0xf, true)); }
__device__ __forceinline__ float dpp_shr2(float v) { return __builtin_bit_cast(float, __builtin_amdgcn_update_dpp(0, __builtin_bit_cast(int, v), 0x112, 0xf, 0xf, true)); }
__device__ __forceinline__ float dpp_shl14(float v) { return __builtin_bit_cast(float, __builtin_amdgcn_update_dpp(0, __builtin_bit_cast(int, v), 0x10E, 0xf, 0xf, true)); }
__device__ __forceinline__ float dpp_shl15(float v) { return __builtin_bit_cast(float, __builtin_amdgcn_update_dpp(0, __builtin_bit_cast(int, v), 0x10F, 0xf, 0xf, true)); }

struct Params {
    const float* x; const float* mix_pre_g; const float* mix_post_g; const float* w_in; const float* sg_ln_g; const float* sg_ln_b; const float* sg_w; const float* sg_b;
    const float* gla_w_gup; const float* gla_b_gate; const float* gla_norm_g; const float* p_a; const float* p_b; const float* p_c; const float* w_out;
    const float* ffn_pre_g; const float* ffn_post_g; const float* ffn_w_up; const float* ffn_conv_w; const float* ffn_conv_b; const float* ffn_w_down;
    float* out; unsigned char* ws;
};
#include <cstddef>
__device__ __forceinline__ const void* karg_(int byte_off) { const char __attribute__((address_space(4)))* ka = (const char __attribute__((address_space(4)))*)__builtin_amdgcn_kernarg_segment_ptr(); return *(const void* const volatile __attribute__((address_space(4)))*)(ka + byte_off); }
#define PP(field) ((decltype(Params::field))karg_((int)offsetof(Params, field)))

namespace pg8 {
constexpr int BM = 256, BK = 64, HALF = 128, HTB = HALF * BK * 2, NXCD = 8, WGM = 8;
__device__ __forceinline__ int lds_byte(int r, int c) { const int st = (r >> 4) * 2 + (c >> 5), rr = r & 15, cc = c & 31, ob = rr * 64 + cc * 2; return st * 1024 + (ob ^ (((ob >> 9) & 1) << 5)); }
__device__ __forceinline__ void stage_rc(int b, int& R, int& C) { const int st = b / 1024, sb = b % 1024, swz = sb ^ (((sb >> 9) & 1) << 5); R = (st >> 1) * 16 + swz / 64; C = (st & 1) * 32 + (swz % 64) / 2; }
__device__ __forceinline__ int perm32(int rho) { const int n = rho >> 4, i = rho & 15; return 8 * (i >> 2) + 4 * n + (i & 3); }

struct Unit { int pm, pn; };
struct Gemm { const bf16_t* A; const bf16_t* Bt; int K, lda, ldb, adiv; size_t astride; };

struct StaticOrder {
    int nM, nN, nwg, G, c;
    __device__ __forceinline__ void init(int M, int N, int G_, int c_) { nM = M / BM; nN = N / BM; nwg = nM * nN; G = G_; c = c_; }
    __device__ __forceinline__ bool next(int i, Unit& u) const {
        const long L = (long)i * G + c; if (L >= nwg) return false;
        int wgid = (int)L; { const int q = nwg / NXCD, r = nwg % NXCD, xcd = wgid % NXCD, off = wgid / NXCD; wgid = (xcd < r ? xcd * (q + 1) : r * (q + 1) + (xcd - r) * q) + off; }
        const int nig = WGM * nN, gid = wgid / nig, fm = gid * WGM, gsz = (nM - fm) < WGM ? (nM - fm) : WGM;
        u.pm = fm + ((wgid % nig) % gsz); u.pn = (wgid % nig) / gsz; return true;
    }
};
struct MergeOrder {
    StaticOrder base;
    __device__ __forceinline__ bool next(int i, Unit& u) const { const int br = i % 3; Unit t; if (!base.next(i / 3, t)) return false; u.pm = t.pm; u.pn = t.pn + 4 * br; return true; }
};

template <class Epi, class Sched>
__device__ __forceinline__ void gemm_phase(LAS unsigned char* lds, const Gemm g, const Sched& S, const Epi& E, int wave_) {
    const int tid = vlaunder(wave_ * 64 + lane_id_()), wid = wave_, lane = tid & 63, wr = wid >> 2, wc = wid & 3, fr = lane & 15, fq = lane >> 4;
    const int K = g.K, nt = K / BK;
    unsigned voffA[2], voffB[2];
#pragma unroll
    for (int i = 0; i < 2; ++i) { int R, C; stage_rc(tid * 16 + i * 8192, R, C); const int Rb = Epi::PERM ? ((R & ~31) + perm32(R & 31)) : R;
        voffA[i] = (unsigned)(R * g.lda + C) * 2u; voffB[i] = (unsigned)(Rb * g.ldb + C) * 2u; }
    const size_t kstep = (size_t)(BK * 2);
    const size_t hstepA = (size_t)HALF * g.lda * 2, hstepB = (size_t)HALF * g.ldb * 2;
    const size_t tstepA = 2 * hstepA, tstepB = 2 * hstepB;
    const unsigned ldsw = (unsigned)wid * 1024u;
    const int aoff = lds_byte(wr * 64 + fr, fq * 8), boff = lds_byte(wc * 32 + fr, fq * 8);
#define PG8_SA(b, h) (((b) * 2 + (h)) * HTB)
#define PG8_SB(b, h) ((4 + (b) * 2 + (h)) * HTB)
#define PG8_STAGE(bufoff, gbase, voff) do { _Pragma("unroll") for (int _i = 0; _i < 2; ++_i) \
        __builtin_amdgcn_global_load_lds((const unsigned*)((const char*)(gbase) + (voff)[_i]), (LAS unsigned*)(lds + (bufoff) + ldsw + _i * 8192), 16, 0, 0); } while (0)
#define PG8_LDA(dst, b, h) do { _Pragma("unroll") for (int m = 0; m < 4; ++m) _Pragma("unroll") for (int k = 0; k < 2; ++k) dst[m][k] = *(const LAS bf16x8*)(lds + PG8_SA(b, h) + aoff + m * 2048 + k * 1024); } while (0)
#define PG8_LDB(dst, b, h) do { _Pragma("unroll") for (int n = 0; n < 2; ++n) _Pragma("unroll") for (int k = 0; k < 2; ++k) dst[n][k] = *(const LAS bf16x8*)(lds + PG8_SB(b, h) + boff + n * 2048 + k * 1024); } while (0)
#define PG8_MMA(ai, bj, At, Bt) do { __builtin_amdgcn_s_setprio(1); _Pragma("unroll") for (int m = 0; m < 4; ++m) _Pragma("unroll") for (int n = 0; n < 2; ++n) _Pragma("unroll") for (int k = 0; k < 2; ++k) \
        acc[ai][bj][m][n] = __builtin_amdgcn_mfma_f32_16x16x32_bf16(Bt[n][k], At[m][k], acc[ai][bj][m][n], 0, 0, 0); __builtin_amdgcn_s_setprio(0); } while (0)
#define PG8_WAIT_V(n) asm volatile("s_waitcnt vmcnt(" #n ")" ::: "memory")
#define PG8_WAIT_L(n) asm volatile("s_waitcnt lgkmcnt(" #n ")" ::: "memory")
#define PG8_BAR __builtin_amdgcn_s_barrier()
#define PG8_SCHED __builtin_amdgcn_sched_barrier(0)
    Unit cur, nxt; int ui = 0;
    (void)S.next(0, cur);
    f32x4 acc[2][2][4][2];
#pragma unroll
    for (int a = 0; a < 2; ++a)
#pragma unroll
        for (int b = 0; b < 2; ++b)
#pragma unroll
            for (int m = 0; m < 4; ++m)
#pragma unroll
                for (int n = 0; n < 2; ++n) acc[a][b][m][n] = (f32x4){0.f, 0.f, 0.f, 0.f};
    bf16x8 At[4][2], B0[2][2], B1[2][2];
    const char* cA = (const char*)g.A + (size_t)cur.pm * tstepA + (g.adiv ? (size_t)(cur.pn / g.adiv) * g.astride : 0);
    const char* cB = (const char*)g.Bt + (size_t)cur.pn * tstepB;
    PG8_STAGE(PG8_SB(0, 0), cB, voffB); PG8_STAGE(PG8_SB(0, 1), cB + hstepB, voffB); PG8_STAGE(PG8_SA(0, 0), cA, voffA); PG8_STAGE(PG8_SA(0, 1), cA + hstepA, voffA);
    if (wr == 1) PG8_BAR;
    PG8_WAIT_V(2); PG8_BAR;
    PG8_STAGE(PG8_SB(1, 0), cB + kstep, voffB); PG8_STAGE(PG8_SA(1, 0), cA + kstep, voffA); PG8_STAGE(PG8_SB(1, 1), cB + hstepB + kstep, voffB);
    PG8_WAIT_V(6); PG8_BAR;
    for (;;) {
        const bool has_next = S.next(ui + 1, nxt);
        const char* nA = has_next ? (const char*)g.A + (size_t)nxt.pm * tstepA + (g.adiv ? (size_t)(nxt.pn / g.adiv) * g.astride : 0) : cA;
        const char* nB = has_next ? (const char*)g.Bt + (size_t)nxt.pn * tstepB : cB;
        for (int t = 0; t < nt; t += 2) {
            const bool last = (t == nt - 2);
            const char* a1 = cA + (size_t)(t + 1) * kstep;
            const char* a2 = last ? nA : cA + (size_t)(t + 2) * kstep; const char* b2 = last ? nB : cB + (size_t)(t + 2) * kstep;
            const char* a3 = a2 + kstep; const char* b3 = b2 + kstep;
            PG8_LDB(B0, 0, 0); PG8_LDB(B1, 0, 1); PG8_SCHED; PG8_LDA(At, 0, 0); PG8_STAGE(PG8_SA(1, 1), a1 + hstepA, voffA);
            PG8_WAIT_V(8); PG8_WAIT_L(0); PG8_BAR; PG8_MMA(0, 0, At, B0); PG8_MMA(0, 1, At, B1); PG8_BAR; PG8_SCHED;
            PG8_LDA(At, 0, 1); PG8_STAGE(PG8_SB(0, 0), b2, voffB); PG8_STAGE(PG8_SB(0, 1), b2 + hstepB, voffB); PG8_STAGE(PG8_SA(0, 0), a2, voffA);
            PG8_WAIT_V(8); PG8_WAIT_L(0); PG8_BAR; PG8_MMA(1, 0, At, B0); PG8_MMA(1, 1, At, B1); PG8_BAR; PG8_SCHED;
            PG8_LDB(B0, 1, 0); PG8_LDB(B1, 1, 1); PG8_SCHED; PG8_LDA(At, 1, 0); PG8_STAGE(PG8_SA(0, 1), a2 + hstepA, voffA);
            PG8_WAIT_V(8); PG8_WAIT_L(0); PG8_BAR; PG8_MMA(0, 0, At, B0); PG8_MMA(0, 1, At, B1); PG8_BAR; PG8_SCHED;
            PG8_LDA(At, 1, 1); PG8_STAGE(PG8_SB(1, 0), b3, voffB); PG8_STAGE(PG8_SB(1, 1), b3 + hstepB, voffB); PG8_STAGE(PG8_SA(1, 0), a3, voffA);
            PG8_WAIT_V(8); PG8_WAIT_L(0); PG8_BAR; PG8_MMA(1, 0, At, B0); PG8_MMA(1, 1, At, B1); PG8_BAR; PG8_SCHED;
        }
        if (wr == 0) PG8_BAR;
        E(acc, cur, wr, wc, fr, fq, lds);
        if (!has_next) break;
#pragma unroll
        for (int a = 0; a < 2; ++a)
#pragma unroll
            for (int b = 0; b < 2; ++b)
#pragma unroll
                for (int m = 0; m < 4; ++m)
#pragma unroll
                    for (int n = 0; n < 2; ++n) acc[a][b][m][n] = (f32x4){0.f, 0.f, 0.f, 0.f};
        cur = nxt; cA = nA; cB = nB; ++ui;
        if (wr == 1) PG8_BAR;
    }
    PG8_WAIT_V(0);
    PG8_BAR;
#undef PG8_SA
#undef PG8_SB
#undef PG8_STAGE
#undef PG8_LDA
#undef PG8_LDB
#undef PG8_MMA
#undef PG8_WAIT_V
#undef PG8_WAIT_L
#undef PG8_BAR
#undef PG8_SCHED
}

typedef const f32x4 (&AccRef)[2][2][4][2];

struct EpiG1 {
    static constexpr bool PERM = true;
    unsigned char* ws;
    __device__ __forceinline__ void operator()(f32x4 (&acc)[2][2][4][2], const Unit& u, int wr, int wc, int fr, int fq, LAS unsigned char*) const {
        const int pn = u.pn;
        const int row0 = u.pm * BM + wr * 64 + fr;
        if (pn == 16) {
            if (wc == 0 && fq < 2) { float* G = (float*)(ws + WS_GDOWN);
#pragma unroll
                for (int ai = 0; ai < 2; ++ai)
#pragma unroll
                    for (int m = 0; m < 4; ++m)
#pragma unroll
                        for (int n = 0; n < 2; ++n) *(f32x4*)(G + (size_t)(row0 + ai * HALF + m * 16) * 16 + 8 * fq + 4 * n) = acc[ai][0][m][n]; }
            return;
        }
        size_t off; int ldc = 512, colt, act = 0;
        if (pn < 2) { off = WS_QA; colt = pn * 256; }
        else if (pn < 4) { off = WS_KA; colt = (pn - 2) * 256; }
        else if (pn < 6) { off = WS_VA; colt = (pn - 4) * 256; }
        else if (pn < 8) { off = WS_U; colt = (pn - 6) * 256; act = 1; }
        else if (pn < 10) { off = WS_SV; colt = (pn - 8) * 256; act = 1; }
        else if (pn == 10) { off = WS_GQ; colt = 0; ldc = 256; }
        else if (pn == 11) { off = WS_GK; colt = 0; ldc = 256; }
        else if (pn < 14) { off = WS_GV; colt = (pn - 12) * 256; }
        else { off = WS_GR; colt = (pn - 14) * 256; act = 2; }
        bf16_t* base = (bf16_t*)(ws + off);
        const int col0 = colt + wc * 32 + 8 * fq;
#pragma unroll
        for (int ai = 0; ai < 2; ++ai)
#pragma unroll
            for (int m = 0; m < 4; ++m) { bf16_t* rowp = base + (size_t)(row0 + ai * HALF + m * 16) * ldc + col0;
#pragma unroll
                for (int bj = 0; bj < 2; ++bj) { f32x4 v0 = acc[ai][bj][m][0], v1 = acc[ai][bj][m][1];
                    if (act == 1) {
#pragma unroll
                        for (int e = 0; e < 4; ++e) { v0[e] = gelu_tanh_f(v0[e]); v1[e] = gelu_tanh_f(v1[e]); }
                    } else if (act == 2) {
#pragma unroll
                        for (int e = 0; e < 4; ++e) { v0[e] = v0[e] * sigmoid_f(v0[e]); v1[e] = v1[e] * sigmoid_f(v1[e]); }
                    }
                    u32x4 w; w.x = cvt_pk_bf16(v0[0], v0[1]); w.y = cvt_pk_bf16(v0[2], v0[3]); w.z = cvt_pk_bf16(v1[0], v1[1]); w.w = cvt_pk_bf16(v1[2], v1[3]);
                    *(u32x4*)(rowp + bj * HALF) = w; } }
    }
};
struct EpiGates {
    static constexpr bool PERM = true;
    bf16_t* O;
    __device__ __forceinline__ void operator()(f32x4 (&acc)[2][2][4][2], const Unit& u, int wr, int wc, int fr, int fq, LAS unsigned char*) const {
        const int row0 = u.pm * BM + wr * 64 + fr, col0 = u.pn * BM + wc * 32 + 8 * fq;
#pragma unroll
        for (int ai = 0; ai < 2; ++ai)
#pragma unroll
            for (int m = 0; m < 4; ++m) { bf16_t* rowp = O + (size_t)(row0 + ai * HALF + m * 16) * 3072 + col0;
#pragma unroll
                for (int bj = 0; bj < 2; ++bj) { f32x4 v0 = acc[ai][bj][m][0], v1 = acc[ai][bj][m][1];
#pragma unroll
                    for (int e = 0; e < 4; ++e) { v0[e] = sigmoid_f(v0[e]); v1[e] = sigmoid_f(v1[e]); }
                    u32x4 w; w.x = cvt_pk_bf16(v0[0], v0[1]); w.y = cvt_pk_bf16(v0[2], v0[3]); w.z = cvt_pk_bf16(v1[0], v1[1]); w.w = cvt_pk_bf16(v1[2], v1[3]);
                    *(u32x4*)(rowp + bj * HALF) = w; } }
    }
};
struct EpiMerge {
    static constexpr bool PERM = true;
    const bf16_t* gates; bf16_t* O;
    __device__ __forceinline__ void operator()(f32x4 (&acc)[2][2][4][2], const Unit& u, int wr, int wc, int fr, int fq, LAS unsigned char*) const {
        const int br = u.pn >> 2, ct = u.pn & 3;
        const int row0 = u.pm * BM + wr * 64 + fr, col0 = ct * BM + wc * 32 + 8 * fq;
#pragma unroll
        for (int ai = 0; ai < 2; ++ai)
#pragma unroll
            for (int m = 0; m < 4; ++m) { const size_t row = (size_t)(row0 + ai * HALF + m * 16);
#pragma unroll
                for (int bj = 0; bj < 2; ++bj) { f32x4 v0 = acc[ai][bj][m][0], v1 = acc[ai][bj][m][1];
                    const u32x4 gw = *(const u32x4*)(gates + row * 3072 + br * 1024 + col0 + bj * HALF);
                    v0[0] *= bflo(gw.x); v0[1] *= bfhi(gw.x); v0[2] *= bflo(gw.y); v0[3] *= bfhi(gw.y);
                    v1[0] *= bflo(gw.z); v1[1] *= bfhi(gw.z); v1[2] *= bflo(gw.w); v1[3] *= bfhi(gw.w);
                    bf16_t* op = O + row * 1024 + col0 + bj * HALF;
                    if (br > 0) { const u32x4 pw = *(const u32x4*)op;
                        v0[0] += bflo(pw.x); v0[1] += bfhi(pw.x); v0[2] += bflo(pw.y); v0[3] += bfhi(pw.y);
                        v1[0] += bflo(pw.z); v1[1] += bfhi(pw.z); v1[2] += bflo(pw.w); v1[3] += bfhi(pw.w); }
                    u32x4 w; w.x = cvt_pk_bf16(v0[0], v0[1]); w.y = cvt_pk_bf16(v0[2], v0[3]); w.z = cvt_pk_bf16(v1[0], v1[1]); w.w = cvt_pk_bf16(v1[2], v1[3]);
                    *(u32x4*)op = w; } }
    }
};
struct EpiF32 {
    static constexpr bool PERM = true;
    bf16_t* O;
    __device__ __forceinline__ void operator()(f32x4 (&acc)[2][2][4][2], const Unit& u, int wr, int wc, int fr, int fq, LAS unsigned char*) const {
        const int row0 = u.pm * BM + wr * 64 + fr, col0 = u.pn * BM + wc * 32 + 8 * fq;
#pragma unroll
        for (int ai = 0; ai < 2; ++ai)
#pragma unroll
            for (int m = 0; m < 4; ++m) { bf16_t* rowp = O + (size_t)(row0 + ai * HALF + m * 16) * 1024 + col0;
#pragma unroll
                for (int bj = 0; bj < 2; ++bj) { const f32x4 v0 = acc[ai][bj][m][0], v1 = acc[ai][bj][m][1];
                    u32x4 w; w.x = cvt_pk_bf16(v0[0], v0[1]); w.y = cvt_pk_bf16(v0[2], v0[3]); w.z = cvt_pk_bf16(v1[0], v1[1]); w.w = cvt_pk_bf16(v1[2], v1[3]);
                    *(u32x4*)(rowp + bj * HALF) = w; } }
    }
};
struct EpiConv {
    static constexpr bool PERM = true;
    const float* cw; const float* cb; bf16_t* act; float* head; float* tail;
    __device__ __forceinline__ void operator()(f32x4 (&acc)[2][2][4][2], const Unit& u, int wr, int wc, int fr, int fq, LAS unsigned char* lds) const {
        LAS float* XT = (LAS float*)(lds + XT_OFF);
        const int ccol = wc * 32 + 8 * fq;
        if (fr >= 14) {
#pragma unroll
            for (int ai = 0; ai < 2; ++ai)
#pragma unroll
                for (int bj = 0; bj < 2; ++bj)
#pragma unroll
                    for (int n = 0; n < 2; ++n) *(LAS f32x4*)(XT + ((ai * 2 + wr) * 2 + (fr - 14)) * 256 + bj * HALF + ccol + 4 * n) = acc[ai][bj][3][n];
            if (wr == 1) {
#pragma unroll
                for (int bj = 0; bj < 2; ++bj)
#pragma unroll
                    for (int n = 0; n < 2; ++n) *(f32x4*)(tail + ((size_t)u.pm * 2 + (fr - 14)) * DFF2 + u.pn * BM + bj * HALF + ccol + 4 * n) = acc[1][bj][3][n];
            }
        }
        if (fr < 2 && wr == 0) {
#pragma unroll
            for (int bj = 0; bj < 2; ++bj)
#pragma unroll
                for (int n = 0; n < 2; ++n) *(f32x4*)(head + ((size_t)u.pm * 2 + fr) * DFF2 + u.pn * BM + bj * HALF + ccol + 4 * n) = acc[0][bj][0][n];
        }
        asm volatile("s_waitcnt lgkmcnt(0)" ::: "memory"); __builtin_amdgcn_s_barrier(); asm volatile("" ::: "memory");
#pragma unroll
        for (int n = 0; n < 2; ++n) {
            const int ch = u.pn * HALF + ccol + 4 * n;
            const f32x4 wa0 = *(const f32x4*)(cw + ch), wa1 = *(const f32x4*)(cw + DFF2 + ch), wa2 = *(const f32x4*)(cw + 2 * DFF2 + ch), ba = *(const f32x4*)(cb + ch);
            const f32x4 wu0 = *(const f32x4*)(cw + DFF + ch), wu1 = *(const f32x4*)(cw + DFF2 + DFF + ch), wu2 = *(const f32x4*)(cw + 2 * DFF2 + DFF + ch), bu = *(const f32x4*)(cb + DFF + ch);
#pragma unroll
            for (int ai = 1; ai >= 0; --ai)
#pragma unroll
                for (int m = 3; m >= 0; --m) {
                    f32x4 pa, pu;
                    if (m > 0) { pa = acc[ai][0][m - 1][n]; pu = acc[ai][1][m - 1][n]; }
                    else {
                        const int slot = ai * 2 + wr - 1;
                        if (slot >= 0) { pa = *(const LAS f32x4*)(XT + (slot * 2 + (fr & 1)) * 256 + ccol + 4 * n); pu = *(const LAS f32x4*)(XT + (slot * 2 + (fr & 1)) * 256 + HALF + ccol + 4 * n); }
                        else { pa = (f32x4){0.f, 0.f, 0.f, 0.f}; pu = pa; }
                    }
                    f32x4 xa = acc[ai][0][m][n], xu = acc[ai][1][m][n];
                    asm volatile("" : "+v"(xa), "+v"(xu), "+v"(pa), "+v"(pu));
                    f32x4 res;
#pragma unroll
                    for (int e = 0; e < 4; ++e) {
                        const f32x2_t x = {xa[e], xu[e]};
                        const f32x2_t p1 = (f32x2_t){dpp_shr1(xa[e]), dpp_shr1(xu[e])} + (f32x2_t){dpp_shl15(pa[e]), dpp_shl15(pu[e])};
                        const f32x2_t p2 = (f32x2_t){dpp_shr2(xa[e]), dpp_shr2(xu[e])} + (f32x2_t){dpp_shl14(pa[e]), dpp_shl14(pu[e])};
                        f32x2_t c = (f32x2_t){ba[e], bu[e]} + (f32x2_t){wa0[e], wu0[e]} * p2;
                        c = c + (f32x2_t){wa1[e], wu1[e]} * p1;
                        c = c + (f32x2_t){wa2[e], wu2[e]} * x;
                        res[e] = gelu_tanh_f(c.x) * c.y;
                    }
                    asm volatile("" : "+v"(res));
                    acc[ai][0][m][n] = res;
                }
        }
        const int row0 = u.pm * BM + wr * 64 + fr;
#pragma unroll
        for (int ai = 0; ai < 2; ++ai)
#pragma unroll
            for (int m = 0; m < 4; ++m) { const f32x4 v0 = acc[ai][0][m][0], v1 = acc[ai][0][m][1];
                u32x4 w; w.x = cvt_pk_bf16(v0[0], v0[1]); w.y = cvt_pk_bf16(v0[2], v0[3]); w.z = cvt_pk_bf16(v1[0], v1[1]); w.w = cvt_pk_bf16(v1[2], v1[3]);
                *(u32x4*)(act + (size_t)(row0 + ai * HALF + m * 16) * DFF + u.pn * HALF + ccol) = w; }
    }
};
template <class Epi, class Sched>
__device__ __forceinline__ void gemm_merge_phase(LAS unsigned char* lds, const Gemm g, const Sched& S, const Epi& E, int wave_) {
    const int tid = vlaunder(wave_ * 64 + lane_id_()), wid = wave_, lane = tid & 63, wr = wid >> 2, wc = wid & 3, fr = lane & 15, fq = lane >> 4;
    const int K = g.K, nt = K / BK;
    unsigned voffA[2], voffB[2];
#pragma unroll
    for (int i = 0; i < 2; ++i) { int R, C; stage_rc(tid * 16 + i * 8192, R, C); const int Rb = Epi::PERM ? ((R & ~31) + perm32(R & 31)) : R;
        voffA[i] = (unsigned)(R * g.lda + C) * 2u; voffB[i] = (unsigned)(Rb * g.ldb + C) * 2u; }
    const size_t kstep = (size_t)(BK * 2);
    const size_t hstepA = (size_t)HALF * g.lda * 2, hstepB = (size_t)HALF * g.ldb * 2;
    const size_t tstepA = 2 * hstepA, tstepB = 2 * hstepB;
    const unsigned ldsw = (unsigned)wid * 1024u;
    const int aoff = lds_byte(wr * 64 + fr, fq * 8), boff = lds_byte(wc * 32 + fr, fq * 8);
#define PG8_SA(b, h) (((b) * 2 + (h)) * HTB)
#define PG8_SB(b, h) ((4 + (b) * 2 + (h)) * HTB)
#define PG8_STAGE(bufoff, gbase, voff) do { _Pragma("unroll") for (int _i = 0; _i < 2; ++_i) \
        __builtin_amdgcn_global_load_lds((const unsigned*)((const char*)(gbase) + (voff)[_i]), (LAS unsigned*)(lds + (bufoff) + ldsw + _i * 8192), 16, 0, 0); } while (0)
#define PG8_LDA(dst, b, h) do { _Pragma("unroll") for (int m = 0; m < 4; ++m) _Pragma("unroll") for (int k = 0; k < 2; ++k) dst[m][k] = *(const LAS bf16x8*)(lds + PG8_SA(b, h) + aoff + m * 2048 + k * 1024); } while (0)
#define PG8_LDB(dst, b, h) do { _Pragma("unroll") for (int n = 0; n < 2; ++n) _Pragma("unroll") for (int k = 0; k < 2; ++k) dst[n][k] = *(const LAS bf16x8*)(lds + PG8_SB(b, h) + boff + n * 2048 + k * 1024); } while (0)
#define PG8_MMA(ai, bj, At, Bt) do { __builtin_amdgcn_s_setprio(1); _Pragma("unroll") for (int m = 0; m < 4; ++m) _Pragma("unroll") for (int n = 0; n < 2; ++n) _Pragma("unroll") for (int k = 0; k < 2; ++k) \
        acc[ai][bj][m][n] = __builtin_amdgcn_mfma_f32_16x16x32_bf16(Bt[n][k], At[m][k], acc[ai][bj][m][n], 0, 0, 0); __builtin_amdgcn_s_setprio(0); } while (0)
#define PG8_WAIT_V(n) asm volatile("s_waitcnt vmcnt(" #n ")" ::: "memory")
#define PG8_WAIT_L(n) asm volatile("s_waitcnt lgkmcnt(" #n ")" ::: "memory")
#define PG8_BAR __builtin_amdgcn_s_barrier()
#define PG8_SCHED __builtin_amdgcn_sched_barrier(0)
    Unit cur, nxt; int ui = 0;
    (void)S.next(0, cur);
    f32x4 acc[2][2][4][2];
#pragma unroll
    for (int a = 0; a < 2; ++a)
#pragma unroll
        for (int b = 0; b < 2; ++b)
#pragma unroll
            for (int m = 0; m < 4; ++m)
#pragma unroll
                for (int n = 0; n < 2; ++n) acc[a][b][m][n] = (f32x4){0.f, 0.f, 0.f, 0.f};
    bf16x8 At[4][2], B0[2][2], B1[2][2];
#define PG8_AT(base, t) ((base) + (size_t)((t) >> 3) * g.astride + (size_t)((t) & 7) * kstep)
    const char* cA = (const char*)g.A + (size_t)cur.pm * tstepA;
    const char* cB = (const char*)g.Bt + (size_t)cur.pn * tstepB;
    PG8_STAGE(PG8_SB(0, 0), cB, voffB); PG8_STAGE(PG8_SB(0, 1), cB + hstepB, voffB); PG8_STAGE(PG8_SA(0, 0), cA, voffA); PG8_STAGE(PG8_SA(0, 1), cA + hstepA, voffA);
    if (wr == 1) PG8_BAR;
    PG8_WAIT_V(2); PG8_BAR;
    PG8_STAGE(PG8_SB(1, 0), cB + kstep, voffB); PG8_STAGE(PG8_SA(1, 0), cA + kstep, voffA); PG8_STAGE(PG8_SB(1, 1), cB + hstepB + kstep, voffB);
    PG8_WAIT_V(6); PG8_BAR;
    for (;;) {
        const bool has_next = S.next(ui + 1, nxt);
        const char* nA = has_next ? (const char*)g.A + (size_t)nxt.pm * tstepA : cA;
        const char* nB = has_next ? (const char*)g.Bt + (size_t)nxt.pn * tstepB : cB;
#define PG8_KBODY(t) { \
            const bool last = ((t) == nt - 2); \
            const char* a1 = PG8_AT(cA, t + 1); \
            const char* a2 = last ? nA : PG8_AT(cA, t + 2); const char* b2 = last ? nB : cB + (size_t)(t + 2) * kstep; \
            const char* a3 = last ? nA + kstep : PG8_AT(cA, t + 3); const char* b3 = b2 + kstep; \
            PG8_LDB(B0, 0, 0); PG8_LDB(B1, 0, 1); PG8_SCHED; PG8_LDA(At, 0, 0); PG8_STAGE(PG8_SA(1, 1), a1 + hstepA, voffA); \
            PG8_WAIT_V(8); PG8_WAIT_L(0); PG8_BAR; PG8_MMA(0, 0, At, B0); PG8_MMA(0, 1, At, B1); PG8_BAR; PG8_SCHED; \
            PG8_LDA(At, 0, 1); PG8_STAGE(PG8_SB(0, 0), b2, voffB); PG8_STAGE(PG8_SB(0, 1), b2 + hstepB, voffB); PG8_STAGE(PG8_SA(0, 0), a2, voffA); \
            PG8_WAIT_V(8); PG8_WAIT_L(0); PG8_BAR; PG8_MMA(1, 0, At, B0); PG8_MMA(1, 1, At, B1); PG8_BAR; PG8_SCHED; \
            PG8_LDB(B0, 1, 0); PG8_LDB(B1, 1, 1); PG8_SCHED; PG8_LDA(At, 1, 0); PG8_STAGE(PG8_SA(0, 1), a2 + hstepA, voffA); \
            PG8_WAIT_V(8); PG8_WAIT_L(0); PG8_BAR; PG8_MMA(0, 0, At, B0); PG8_MMA(0, 1, At, B1); PG8_BAR; PG8_SCHED; \
            PG8_LDA(At, 1, 1); PG8_STAGE(PG8_SB(1, 0), b3, voffB); PG8_STAGE(PG8_SB(1, 1), b3 + hstepB, voffB); PG8_STAGE(PG8_SA(1, 0), a3, voffA); \
            PG8_WAIT_V(8); PG8_WAIT_L(0); PG8_BAR; PG8_MMA(1, 0, At, B0); PG8_MMA(1, 1, At, B1); PG8_BAR; PG8_SCHED; \
        }
        for (int t = 0; t < 8; t += 2) PG8_KBODY(t)
        E.hook(acc, cur, 0, wr, wc, fr, fq);
        for (int t = 8; t < 16; t += 2) PG8_KBODY(t)
        E.hook(acc, cur, 1, wr, wc, fr, fq);
        for (int t = 16; t < 24; t += 2) PG8_KBODY(t)
#undef PG8_KBODY
        if (wr == 0) PG8_BAR;
        E(acc, cur, wr, wc, fr, fq, lds);
        if (!has_next) break;
#pragma unroll
        for (int a = 0; a < 2; ++a)
#pragma unroll
            for (int b = 0; b < 2; ++b)
#pragma unroll
                for (int m = 0; m < 4; ++m)
#pragma unroll
                    for (int n = 0; n < 2; ++n) acc[a][b][m][n] = (f32x4){0.f, 0.f, 0.f, 0.f};
        cur = nxt; cA = nA; cB = nB; ++ui;
        if (wr == 1) PG8_BAR;
    }
    PG8_WAIT_V(0);
    PG8_BAR;
#undef PG8_AT
#undef PG8_SA
#undef PG8_SB
#undef PG8_STAGE
#undef PG8_LDA
#undef PG8_LDB
#undef PG8_MMA
#undef PG8_WAIT_V
#undef PG8_WAIT_L
#undef PG8_BAR
#undef PG8_SCHED
}

struct EpiMerge3 {
    static constexpr bool PERM = true;
    const bf16_t* gates; bf16_t* O;
    static __device__ __forceinline__ float cl(float g) { return fmaxf(g, 1e-30f); }
    __device__ __forceinline__ void hook(f32x4 (&acc)[2][2][4][2], const Unit& u, int seam, int wr, int wc, int fr, int fq) const {
        const int row0 = vlaunder(u.pm * BM + wr * 64 + fr), col0 = vlaunder(u.pn * BM + wc * 32 + 8 * fq);
#pragma unroll
        for (int ai = 0; ai < 2; ++ai) {
            u32x4 ga[4][2], gb[4][2];
#pragma unroll
            for (int m = 0; m < 4; ++m)
#pragma unroll
                for (int bj = 0; bj < 2; ++bj) { const bf16_t* gp = gates + (size_t)(row0 + ai * HALF + m * 16) * 3072 + seam * 1024 + col0 + bj * HALF; ga[m][bj] = *(const u32x4*)gp; gb[m][bj] = *(const u32x4*)(gp + 1024); }
#pragma unroll
            for (int m = 0; m < 4; ++m)
#pragma unroll
                for (int bj = 0; bj < 2; ++bj) { const u32x4 a = ga[m][bj], b = gb[m][bj];
                    acc[ai][bj][m][0][0] *= cl(bflo(a.x)) * rcpf_(cl(bflo(b.x))); acc[ai][bj][m][0][1] *= cl(bfhi(a.x)) * rcpf_(cl(bfhi(b.x)));
                    acc[ai][bj][m][0][2] *= cl(bflo(a.y)) * rcpf_(cl(bflo(b.y))); acc[ai][bj][m][0][3] *= cl(bfhi(a.y)) * rcpf_(cl(bfhi(b.y)));
                    acc[ai][bj][m][1][0] *= cl(bflo(a.z)) * rcpf_(cl(bflo(b.z))); acc[ai][bj][m][1][1] *= cl(bfhi(a.z)) * rcpf_(cl(bfhi(b.z)));
                    acc[ai][bj][m][1][2] *= cl(bflo(a.w)) * rcpf_(cl(bflo(b.w))); acc[ai][bj][m][1][3] *= cl(bfhi(a.w)) * rcpf_(cl(bfhi(b.w))); }
            asm volatile("" ::: "memory");
        }
    }
    __device__ __forceinline__ void operator()(f32x4 (&acc)[2][2][4][2], const Unit& u, int wr, int wc, int fr, int fq, LAS unsigned char*) const {
        const int row0 = vlaunder(u.pm * BM + wr * 64 + fr), col0 = vlaunder(u.pn * BM + wc * 32 + 8 * fq);
#pragma unroll
        for (int ai = 0; ai < 2; ++ai) {
            u32x4 gc[4][2];
#pragma unroll
            for (int m = 0; m < 4; ++m)
#pragma unroll
                for (int bj = 0; bj < 2; ++bj) gc[m][bj] = *(const u32x4*)(gates + (size_t)(row0 + ai * HALF + m * 16) * 3072 + 2048 + col0 + bj * HALF);
#pragma unroll
            for (int m = 0; m < 4; ++m)
#pragma unroll
                for (int bj = 0; bj < 2; ++bj) { const u32x4 c = gc[m][bj]; const f32x4 v0 = acc[ai][bj][m][0], v1 = acc[ai][bj][m][1];
                    u32x4 w; w.x = cvt_pk_bf16(v0[0] * cl(bflo(c.x)), v0[1] * cl(bfhi(c.x))); w.y = cvt_pk_bf16(v0[2] * cl(bflo(c.y)), v0[3] * cl(bfhi(c.y)));
                    w.z = cvt_pk_bf16(v1[0] * cl(bflo(c.z)), v1[1] * cl(bfhi(c.z))); w.w = cvt_pk_bf16(v1[2] * cl(bflo(c.w)), v1[3] * cl(bfhi(c.w)));
                    *(u32x4*)(O + (size_t)(row0 + ai * HALF + m * 16) * 1024 + col0 + bj * HALF) = w; }
            asm volatile("" ::: "memory");
        }
    }
};
}

__device__ __forceinline__ void transpose_item(const float* W, int ldsrc, int k0, int nsrc0, bf16_t* WT, int K, int ndst0, LAS float* scr, int lane) {
#pragma unroll 8
    for (int i = 0; i < 32; ++i) { const int kk = 2 * i + (lane >> 5); scr[kk * 33 + (lane & 31)] = W[(size_t)(k0 + kk) * ldsrc + nsrc0 + (lane & 31)]; }
    LDS_WAIT(); asm volatile("" ::: "memory");
    const int c = lane & 7;
#pragma unroll
    for (int j = 0; j < 4; ++j) { const int n = (lane >> 3) + 8 * j; const LAS float* s = scr + (8 * c) * 33 + n;
        u32x4 o; o.x = cvt_pk_bf16(s[0 * 33], s[1 * 33]); o.y = cvt_pk_bf16(s[2 * 33], s[3 * 33]); o.z = cvt_pk_bf16(s[4 * 33], s[5 * 33]); o.w = cvt_pk_bf16(s[6 * 33], s[7 * 33]);
        *(u32x4*)(WT + (size_t)(ndst0 + n) * K + k0 + 8 * c) = o; }
    LDS_WAIT(); asm volatile("" ::: "memory");
}
__device__ __forceinline__ void convert_weights(const Params& p, int l, LAS unsigned char* lds, int gw, int ngw, int wave, int lane) {
    lane = vlaunder(lane_id_());
    LAS float* scr = (LAS float*)(lds + wave * 16384);
    unsigned char* ws = launder(PP(ws));
    bf16_t* Win = (bf16_t*)(ws + WS_WIN); bf16_t* WP = (bf16_t*)(ws + WS_WP); bf16_t* WO = (bf16_t*)(ws + WS_WOUT); bf16_t* WU = (bf16_t*)(ws + WS_WUP); bf16_t* WD = (bf16_t*)(ws + WS_WDN);
    const float* w_in = launder(PP(w_in)) + (size_t)l * DM * INW;
    constexpr int I0 = 16 * 128, I1 = 16 * 96, I2 = 8 * 32, I5 = 16 * 32, I6 = 16 * 176, I7 = 44 * 32;
    constexpr int NITEMS = I0 + I1 + 3 * I2 + I5 + I6 + I7;
    for (int it = gw; it < NITEMS; it += ngw) {
        int r = it;
        if (r < I0) { const int kb = r / 128, nb = r % 128; transpose_item(w_in, INW, 64 * kb, 32 * nb, Win, 1024, 32 * nb, scr, lane); continue; } r -= I0;
        if (r < I1) { const int kb = r / 96, nb = r % 96; transpose_item(w_in, INW, 64 * kb, 4112 + 32 * nb, Win, 1024, 4352 + 32 * nb, scr, lane); continue; } r -= I1;
        if (r < 3 * I2) { const int br = r / I2, q = r % I2, kb = q / 32, nb = q % 32;
            const float* src = launder(br == 0 ? PP(p_a) : (br == 1 ? PP(p_b) : PP(p_c))) + (size_t)l * 512 * 1024;
            transpose_item(src, 1024, 64 * kb, 32 * nb, WP + 512 * br, 1536, 32 * nb, scr, lane); continue; } r -= 3 * I2;
        if (r < I5) { const int kb = r / 32, nb = r % 32; transpose_item(launder(PP(w_out)) + (size_t)l * 1024 * 1024, 1024, 64 * kb, 32 * nb, WO, 1024, 32 * nb, scr, lane); continue; } r -= I5;
        if (r < I6) { const int kb = r / 176, nb = r % 176, j = nb >> 3, half = (nb >> 2) & 1, q = nb & 3;
            transpose_item(launder(PP(ffn_w_up)) + (size_t)l * 1024 * DFF2, DFF2, 64 * kb, DFF * half + 128 * j + 32 * q, WU, 1024, 256 * j + 128 * half + 32 * q, scr, lane); continue; } r -= I6;
        { const int kb = r / 32, nb = r % 32; transpose_item(launder(PP(ffn_w_down)) + (size_t)l * DFF * 1024, 1024, 64 * kb, 32 * nb, WD, DFF, 32 * nb, scr, lane); }
    }
    for (int idx = gw * 64 + lane; idx < 256 * 1024; idx += ngw * 64) { const int n = idx >> 10, k = idx & 1023;
        const float v = (n < 16) ? w_in[(size_t)k * INW + 4096 + n] : 0.f; Win[(size_t)(4096 + n) * 1024 + k] = f2bf(v); }
}

template <bool HAS_Y, bool HAS_OUT, bool HAS_XN, int NR = 4>
__device__ __forceinline__ void row_phase(const float* hin, const bf16_t* y, const float* gpost, float* hout, const float* gpre, bf16_t* xn, int gw, int ngw, int lane) {
    hin = launder(hin); y = launder(y); hout = launder(hout); xn = launder(xn); gpost = launder(gpost); gpre = launder(gpre); lane = vlaunder(lane_id_());
    for (int m0 = gw; m0 < MTOK; m0 += NR * ngw) {
        f32x4 v[NR][4]; u32x2 yw[NR][4];
#pragma unroll
        for (int rr_ = 0; rr_ < NR; ++rr_) { const int m = m0 + rr_ * ngw; const f32x4* hr = (const f32x4*)(hin + (size_t)m * DM) + lane;
#pragma unroll
            for (int j = 0; j < 4; ++j) v[rr_][j] = hr[64 * j];
            if (HAS_Y) { const u32x2* yr = (const u32x2*)(y + (size_t)m * DM) + lane;
#pragma unroll
                for (int j = 0; j < 4; ++j) yw[rr_][j] = yr[64 * j]; } }
#pragma unroll
        for (int rr_ = 0; rr_ < NR; ++rr_) {
            const int m = m0 + rr_ * ngw;
            if (HAS_Y) {
                f32x4 yv[4]; float s = 0.f;
#pragma unroll
                for (int j = 0; j < 4; ++j) { yv[j] = (f32x4){bflo(yw[rr_][j].x), bfhi(yw[rr_][j].x), bflo(yw[rr_][j].y), bfhi(yw[rr_][j].y)}; s += (yv[j].x * yv[j].x + yv[j].y * yv[j].y) + (yv[j].z * yv[j].z + yv[j].w * yv[j].w); }
                const float r = __builtin_amdgcn_rsqf(wave_sum(s) * (1.f / DM) + EPS);
#pragma unroll
                for (int j = 0; j < 4; ++j) { const f32x4 gp = *((const f32x4*)gpost + lane + 64 * j); v[rr_][j] += yv[j] * r * gp; }
            }
            if (HAS_OUT) { f32x4* ho = (f32x4*)(hout + (size_t)m * DM) + lane;
#pragma unroll
                for (int j = 0; j < 4; ++j) ho[64 * j] = v[rr_][j]; }
            if (HAS_XN) {
                float s = 0.f;
#pragma unroll
                for (int j = 0; j < 4; ++j) s += (v[rr_][j].x * v[rr_][j].x + v[rr_][j].y * v[rr_][j].y) + (v[rr_][j].z * v[rr_][j].z + v[rr_][j].w * v[rr_][j].w);
                const float r = __builtin_amdgcn_rsqf(wave_sum(s) * (1.f / DM) + EPS);
                u32x2* xo = (u32x2*)(xn + (size_t)m * DM) + lane;
#pragma unroll
                for (int j = 0; j < 4; ++j) { const f32x4 g = *((const f32x4*)gpre + lane + 64 * j); const f32x4 o = v[rr_][j] * r * g; u32x2 w; w.x = cvt_pk_bf16(o.x, o.y); w.y = cvt_pk_bf16(o.z, o.w); xo[64 * j] = w; }
            }
        }
    }
}

__device__ __forceinline__ void gdown_phase(unsigned char* ws, int gw, int ngw) {
    ws = launder(ws); const int lane = vlaunder(lane_id_()); const int r = lane & 15, g = lane >> 4;
    const bf16_t* XNp = (const bf16_t*)(ws + WS_XN); const bf16_t* Wg = (const bf16_t*)(ws + WS_WIN) + (size_t)4096 * 1024; float* GD = (float*)(ws + WS_GDOWN);
    for (int tsk = gw; tsk < MTOK / 16; tsk += ngw) {
        const bf16_t* ap = XNp + ((size_t)tsk * 16 + r) * 1024 + 8 * g; const bf16_t* bp = Wg + (size_t)r * 1024 + 8 * g;
        f32x4 acc0 = (f32x4){0.f, 0.f, 0.f, 0.f}, acc1 = acc0;
#pragma unroll 4
        for (int ks = 0; ks < 32; ks += 2) { acc0 = mfma16(*(const bf16x8*)(ap + 32 * ks), *(const bf16x8*)(bp + 32 * ks), acc0); acc1 = mfma16(*(const bf16x8*)(ap + 32 * ks + 32), *(const bf16x8*)(bp + 32 * ks + 32), acc1); }
#pragma unroll
        for (int j = 0; j < 4; ++j) GD[((size_t)tsk * 16 + 4 * g + j) * 16 + r] = acc0[j] + acc1[j];
    }
}

__device__ __forceinline__ void sb_phase(LAS unsigned char* lds, unsigned char* ws, int tid, int wave, int lane, size_t dst_off = WS_QA) {
    ws = launder(ws); tid = vlaunder(wave * 64 + lane_id_()); lane = tid & 63;
    bf16_t* QA = (bf16_t*)(ws + WS_QA); bf16_t* YA = (bf16_t*)(ws + dst_off); const bf16_t* KA = (const bf16_t*)(ws + WS_KA); const bf16_t* VA = (const bf16_t*)(ws + WS_VA);
    LAS bf16_t* sK = (LAS bf16_t*)lds;
    LAS bf16_t* sVt = (LAS bf16_t*)(lds + 9216);
    const int r = lane & 15, g = lane >> 4;
    for (int u = blockIdx.x; u < BATCH * 8 * 32; u += gridDim.x) {
        const int b = u >> 8, h = (u >> 5) & 7, qb = u & 31;
        const int tq0 = qb * 128 + wave * 16, t = tq0 + r;
        const size_t rowbase = (size_t)b * SEQ;
        bf16x8 qf[2];
#pragma unroll
        for (int ks = 0; ks < 2; ++ks) qf[ks] = *(const bf16x8*)(QA + (rowbase + t) * 512 + h * 64 + 32 * ks + 8 * g);
        f32x4 o[4];
#pragma unroll
        for (int i = 0; i < 4; ++i) o[i] = (f32x4){0.f, 0.f, 0.f, 0.f};
        float carry = 0.f;
        const int skey = tid >> 3, sch = tid & 7;
        u32x4 kv, vv;
        { const size_t goff = (rowbase + (qb * 2 + 1) * 64 + skey) * 512 + h * 64 + 8 * sch; kv = *(const u32x4*)(KA + goff); vv = *(const u32x4*)(VA + goff); }
        for (int kt = qb * 2 + 1; kt >= 0; --kt) {
            {
                const int key = skey, ch = sch;
                *(LAS u32x4*)(sK + key * 72 + 8 * ch) = kv;
                LAS bf16_t* vd = sVt + (8 * ch) * 68 + key;
                vd[0 * 68] = (bf16_t)(vv.x & 0xffff); vd[1 * 68] = (bf16_t)(vv.x >> 16); vd[2 * 68] = (bf16_t)(vv.y & 0xffff); vd[3 * 68] = (bf16_t)(vv.y >> 16);
                vd[4 * 68] = (bf16_t)(vv.z & 0xffff); vd[5 * 68] = (bf16_t)(vv.z >> 16); vd[6 * 68] = (bf16_t)(vv.w & 0xffff); vd[7 * 68] = (bf16_t)(vv.w >> 16);
            }
            __syncthreads();
            if (kt > 0) { const size_t goff = (rowbase + (kt - 1) * 64 + skey) * 512 + h * 64 + 8 * sch; kv = *(const u32x4*)(KA + goff); vv = *(const u32x4*)(VA + goff); }
            const bool wdone = __all(carry < SB_THR);
            const bool active = (kt * 64) < (tq0 + 15) && !wdone;
            if (active) {
                f32x4 s[4];
#pragma unroll
                for (int kb = 0; kb < 4; ++kb) { s[kb] = (f32x4){0.f, 0.f, 0.f, 0.f};
#pragma unroll
                    for (int ks = 0; ks < 2; ++ks) { const bf16x8 a = *(const LAS bf16x8*)(sK + (16 * kb + r) * 72 + 32 * ks + 8 * g); s[kb] = mfma16(a, qf[ks], s[kb]); } }
                f32x4 w[4];
                const float zs = 0.125f * 1.4426950409f;
                if (kt * 64 + 63 < tq0) {
#pragma unroll
                    for (int kb = 3; kb >= 0; --kb) {
                        float l[4], ls[4];
#pragma unroll
                        for (int j = 0; j < 4; ++j) { const float z = s[kb][j] * zs; const float lsz = logsig2_f(z); ls[j] = lsz; l[j] = lsz - z; }
                        const float sg = (l[0] + l[1]) + (l[2] + l[3]);
                        const float a_ = __shfl_xor(sg, 16); const float b_ = sg + a_; const float c_ = __shfl_xor(b_, 32);
                        const float suf = ((g & 1) == 0 ? a_ : 0.f) + ((g & 2) == 0 ? c_ : 0.f);
                        const float t3 = carry + suf, t2 = t3 + l[3], t1 = t2 + l[2], t0 = t1 + l[1];
                        w[kb][0] = __builtin_amdgcn_exp2f(ls[0] + t0); w[kb][1] = __builtin_amdgcn_exp2f(ls[1] + t1);
                        w[kb][2] = __builtin_amdgcn_exp2f(ls[2] + t2); w[kb][3] = __builtin_amdgcn_exp2f(ls[3] + t3);
                        carry += b_ + c_;
                    }
                } else {
#pragma unroll
                    for (int kb = 3; kb >= 0; --kb) {
                        float l[4], ls[4]; bool mk[4];
#pragma unroll
                        for (int j = 0; j < 4; ++j) { const int key = kt * 64 + 16 * kb + 4 * g + j; const float z = s[kb][j] * zs; mk[j] = key < t;
                            const float lsz = logsig2_f(z); ls[j] = lsz; l[j] = mk[j] ? (lsz - z) : 0.f; }
                        const float sg = (l[0] + l[1]) + (l[2] + l[3]);
                        const float a_ = __shfl_xor(sg, 16); const float b_ = sg + a_; const float c_ = __shfl_xor(b_, 32);
                        const float suf = ((g & 1) == 0 ? a_ : 0.f) + ((g & 2) == 0 ? c_ : 0.f);
                        const float t3 = carry + suf, t2 = t3 + l[3], t1 = t2 + l[2], t0 = t1 + l[1];
                        w[kb][0] = mk[0] ? __builtin_amdgcn_exp2f(ls[0] + t0) : 0.f; w[kb][1] = mk[1] ? __builtin_amdgcn_exp2f(ls[1] + t1) : 0.f;
                        w[kb][2] = mk[2] ? __builtin_amdgcn_exp2f(ls[2] + t2) : 0.f; w[kb][3] = mk[3] ? __builtin_amdgcn_exp2f(ls[3] + t3) : 0.f;
                        carry += b_ + c_;
                    }
                }
#pragma unroll
                for (int sI = 0; sI < 2; ++sI) {
                    const bf16x8 pb = pack8(w[2 * sI], w[2 * sI + 1]);
#pragma unroll
                    for (int dvb = 0; dvb < 4; ++dvb) {
                        const LAS bf16_t* vp = sVt + (16 * dvb + r) * 68 + 32 * sI + 4 * g;
                        const u32x2 lo = *(const LAS u32x2*)vp, hi = *(const LAS u32x2*)(vp + 16);
                        u32x4 av; av.x = lo.x; av.y = lo.y; av.z = hi.x; av.w = hi.y;
                        o[dvb] = mfma16(__builtin_bit_cast(bf16x8, av), pb, o[dvb]);
                    }
                }
            }
            const int done = __all(carry < SB_THR) ? 1 : 0;
            if (__syncthreads_and(done)) break;
        }
#pragma unroll
        for (int dvb = 0; dvb < 4; ++dvb) { u32x2 w2; w2.x = cvt_pk_bf16(o[dvb][0], o[dvb][1]); w2.y = cvt_pk_bf16(o[dvb][2], o[dvb][3]);
            *(u32x2*)(YA + (rowbase + t) * 512 + h * 64 + 16 * dvb + 4 * g) = w2; }
        __syncthreads();
    }
}

__device__ __forceinline__ void sg_phase(LAS unsigned char* lds, const Params& p, int l, int tid, int wave, int lane) {
    unsigned char* ws = launder(PP(ws)); tid = vlaunder(wave * 64 + lane_id_()); lane = tid & 63;
    bf16_t* U = (bf16_t*)(ws + WS_U); const bf16_t* SV = (const bf16_t*)(ws + WS_SV);
    LAS bf16_t* sVn = (LAS bf16_t*)(lds + wave * (64 * 136 * 2));
    LAS float* sSt = (LAS float*)(lds + 8 * 64 * 136 * 2);
    const int r = lane & 15, gq = lane >> 4;
    const float* lng = launder(PP(sg_ln_g)) + l * 512; const float* lnb = launder(PP(sg_ln_b)) + l * 512;
    const float* W = launder(PP(sg_w)) + ((size_t)(l * 8 + wave)) * 128 * 128;
    const float* Bs = launder(PP(sg_b)) + (l * 8 + wave) * 128;
    for (int u = blockIdx.x; u < BATCH * 32; u += gridDim.x) {
        const size_t row0 = (size_t)u * 128;
        {
            const int tok = wave * 16 + (lane >> 2);
            const u32x4* sp = (const u32x4*)(SV + (row0 + tok) * 512 + (lane & 3) * 128);
            u32x4 vv[16];
#pragma unroll
            for (int c = 0; c < 16; ++c) vv[c] = sp[c];
            float s = 0.f;
#pragma unroll
            for (int c = 0; c < 16; ++c) s += ((bflo(vv[c].x) + bfhi(vv[c].x)) + (bflo(vv[c].y) + bfhi(vv[c].y))) + ((bflo(vv[c].z) + bfhi(vv[c].z)) + (bflo(vv[c].w) + bfhi(vv[c].w)));
            s += __shfl_xor(s, 1); s += __shfl_xor(s, 2);
            const float mu = s * (1.f / 512.f);
            float q = 0.f;
#pragma unroll
            for (int c = 0; c < 16; ++c) { const float x[8] = {bflo(vv[c].x), bfhi(vv[c].x), bflo(vv[c].y), bfhi(vv[c].y), bflo(vv[c].z), bfhi(vv[c].z), bflo(vv[c].w), bfhi(vv[c].w)};
#pragma unroll
                for (int e = 0; e < 8; ++e) { const float d = x[e] - mu; q += d * d; } }
            q += __shfl_xor(q, 1); q += __shfl_xor(q, 2);
            const float rs = __builtin_amdgcn_rsqf(q * (1.f / 512.f) + EPS);
            if ((lane & 3) == 0) { sSt[tok * 2] = mu; sSt[tok * 2 + 1] = rs; }
        }
        __syncthreads();
#pragma unroll
        for (int i = 0; i < 2; ++i) {
            const int s = lane + 64 * i; const float mu = sSt[s * 2], rs = sSt[s * 2 + 1];
#pragma unroll
            for (int c = 0; c < 8; ++c) {
                const u32x4 vv = *(const u32x4*)(SV + (row0 + s) * 512 + wave * 64 + 8 * c);
                const float x[8] = {bflo(vv.x), bfhi(vv.x), bflo(vv.y), bfhi(vv.y), bflo(vv.z), bfhi(vv.z), bflo(vv.w), bfhi(vv.w)};
                const f32x4 g0 = *(const f32x4*)(lng + wave * 64 + 8 * c), g1 = *(const f32x4*)(lng + wave * 64 + 8 * c + 4);
                const f32x4 b0 = *(const f32x4*)(lnb + wave * 64 + 8 * c), b1 = *(const f32x4*)(lnb + wave * 64 + 8 * c + 4);
#pragma unroll
                for (int e = 0; e < 8; ++e) { const float gg = e < 4 ? g0[e & 3] : g1[e & 3], bb = e < 4 ? b0[e & 3] : b1[e & 3];
                    sVn[(8 * c + e) * 136 + s] = f2bf((x[e] - mu) * rs * gg + bb); }
            }
        }
        __syncthreads();
        {
            f32x4 acc[8][4];
#pragma unroll
            for (int tb = 0; tb < 8; ++tb)
#pragma unroll
                for (int i = 0; i < 4; ++i) acc[tb][i] = (f32x4){0.f, 0.f, 0.f, 0.f};
#pragma unroll
            for (int ks = 0; ks < 4; ++ks) {
                const int s0 = 32 * ks + 8 * gq;
                bf16x8 bb[4];
#pragma unroll
                for (int db = 0; db < 4; ++db) bb[db] = *(const LAS bf16x8*)(sVn + (16 * db + r) * 136 + s0);
#pragma unroll
                for (int tb = 2 * ks; tb < 8; ++tb) {
                    const int t = 16 * tb + r;
                    f32x4 w0 = *(const f32x4*)(W + t * 128 + s0), w1 = *(const f32x4*)(W + t * 128 + s0 + 4);
#pragma unroll
                    for (int e = 0; e < 4; ++e) { if (s0 + e > t) w0[e] = 0.f; if (s0 + 4 + e > t) w1[e] = 0.f; }
                    const bf16x8 a = pack8(w0, w1);
#pragma unroll
                    for (int db = 0; db < 4; ++db) acc[tb][db] = mfma16(a, bb[db], acc[tb][db]);
                }
            }
#pragma unroll
            for (int tb = 0; tb < 8; ++tb) {
                bf16_t uu[4][4];
#pragma unroll
                for (int j = 0; j < 4; ++j)
#pragma unroll
                    for (int db = 0; db < 4; ++db) uu[j][db] = U[(row0 + 16 * tb + 4 * gq + j) * 512 + wave * 64 + 16 * db + r];
#pragma unroll
                for (int j = 0; j < 4; ++j) { const int tt = 16 * tb + 4 * gq + j; const float bsv = Bs[tt];
#pragma unroll
                    for (int db = 0; db < 4; ++db) U[(row0 + tt) * 512 + wave * 64 + 16 * db + r] = f2bf(bf2f(uu[j][db]) * (acc[tb][db][j] + bsv)); }
            }
        }
        __syncthreads();
    }
}

template <bool PASS_C>
__device__ __forceinline__ void gla_phase(LAS unsigned char* lds, const Params& p, int l, int tid, int wave, int lane) {
    unsigned char* ws = launder(PP(ws)); tid = vlaunder(wave * 64 + lane_id_()); lane = tid & 63;
    const bf16_t* GQ = (const bf16_t*)(ws + WS_GQ); const bf16_t* GK = (const bf16_t*)(ws + WS_GK); const bf16_t* GV = (const bf16_t*)(ws + WS_GV);
    bf16_t* GR = (bf16_t*)(ws + WS_GR); const float* GD = (const float*)(ws + WS_GDOWN); float* UPD = (float*)(ws + WS_UPD); float* DEC = (float*)(ws + WS_DEC);
    LAS float* sCum = (LAS float*)lds;
    LAS float* sTot = (LAS float*)(lds + 16384);
    LAS bf16_t* sQD = (LAS bf16_t*)(lds + 18432);
    LAS bf16_t* sKI = (LAS bf16_t*)(lds + 27648);
    LAS bf16_t* sKEt = (LAS bf16_t*)(lds + 36864);
    LAS bf16_t* sVt = (LAS bf16_t*)(lds + 46080);
    LAS bf16_t* sAT = (LAS bf16_t*)(lds + 64512);
    LAS bf16_t* sSt = (LAS bf16_t*)(lds + 73728);
    LAS float* sSS = (LAS float*)(lds + 92160);
    const int r = lane & 15, gq = lane >> 4;
    const float* wgup = launder(PP(gla_w_gup)) + l * 16 * 256; const float* bgate = launder(PP(gla_b_gate)) + l * 256; const float* ng = launder(PP(gla_norm_g)) + l * 128;
    for (int u = blockIdx.x; u < BATCH * 4 * 64; u += gridDim.x) {
        const int b = u >> 8, h = (u >> 6) & 3, n = u & 63;
        const size_t r0 = (size_t)b * SEQ + n * 64;
        const int t_ = tid >> 3, k8 = (tid & 7) * 8;
        const u32x4 kw = *(const u32x4*)(GK + (r0 + t_) * 256 + h * 64 + k8);
        const u32x4 gv0 = *(const u32x4*)(GV + (r0 + (tid >> 3)) * 512 + h * 128 + 16 * (tid & 7)), gv1 = *(const u32x4*)(GV + (r0 + (tid >> 3)) * 512 + h * 128 + 16 * (tid & 7) + 8);
        u32x4 qw = (u32x4){0u, 0u, 0u, 0u}; f32x4 st0 = (f32x4){0.f, 0.f, 0.f, 0.f}, st1 = st0, st2 = st0, st3 = st0; bf16_t gg[4][4];
        if (PASS_C) {
            qw = *(const u32x4*)(GQ + (r0 + t_) * 256 + h * 64 + k8);
            const f32x4* sp = (const f32x4*)(UPD + ((size_t)u * 128 + (tid >> 2)) * 64 + (tid & 3) * 16); st0 = sp[0]; st1 = sp[1]; st2 = sp[2]; st3 = sp[3];
#pragma unroll
            for (int j = 0; j < 4; ++j)
#pragma unroll
                for (int i = 0; i < 4; ++i) gg[j][i] = GR[(r0 + 16 * (wave & 3) + 4 * gq + j) * 512 + h * 128 + 16 * (4 * (wave >> 2) + i) + r];
        }
        {
            const f32x4* gdp = (const f32x4*)(GD + (r0 + t_) * 16);
            const f32x4 g0 = gdp[0], g1 = gdp[1], g2 = gdp[2], g3 = gdp[3];
            const float gd[16] = {g0[0], g0[1], g0[2], g0[3], g1[0], g1[1], g1[2], g1[3], g2[0], g2[1], g2[2], g2[3], g3[0], g3[1], g3[2], g3[3]};
            f32x4 a0 = *(const f32x4*)(bgate + h * 64 + k8), a1 = *(const f32x4*)(bgate + h * 64 + k8 + 4);
#pragma unroll
            for (int rr = 0; rr < 16; ++rr) { const f32x4 w0 = *(const f32x4*)(wgup + rr * 256 + h * 64 + k8), w1 = *(const f32x4*)(wgup + rr * 256 + h * 64 + k8 + 4); a0 += w0 * gd[rr]; a1 += w1 * gd[rr]; }
            f32x4 o0, o1;
#pragma unroll
            for (int e = 0; e < 4; ++e) { o0[e] = logsig_f(a0[e]) * 0.0625f; o1[e] = logsig_f(a1[e]) * 0.0625f; }
            *(LAS f32x4*)(sCum + t_ * 64 + k8) = o0; *(LAS f32x4*)(sCum + t_ * 64 + k8 + 4) = o1;
        }
        __syncthreads();
        {
            const int k = tid & 63, seg = tid >> 6; float run = 0.f;
#pragma unroll
            for (int i = 0; i < 8; ++i) { run += sCum[(8 * seg + i) * 64 + k]; sCum[(8 * seg + i) * 64 + k] = run; }
            sTot[seg * 64 + k] = run;
            __syncthreads();
            float pre = 0.f;
#pragma unroll
            for (int s = 0; s < 7; ++s) pre += (s < seg) ? sTot[s * 64 + k] : 0.f;
#pragma unroll
            for (int i = 0; i < 8; ++i) sCum[(8 * seg + i) * 64 + k] += pre;
        }
        __syncthreads();
        {
            const f32x4 c0 = *(const LAS f32x4*)(sCum + t_ * 64 + k8), c1 = *(const LAS f32x4*)(sCum + t_ * 64 + k8 + 4);
            const f32x4 e0 = *(const LAS f32x4*)(sCum + 63 * 64 + k8), e1 = *(const LAS f32x4*)(sCum + 63 * 64 + k8 + 4);
            const float kk[8] = {bflo(kw.x), bfhi(kw.x), bflo(kw.y), bfhi(kw.y), bflo(kw.z), bfhi(kw.z), bflo(kw.w), bfhi(kw.w)};
            const float cm[8] = {c0[0], c0[1], c0[2], c0[3], c1[0], c1[1], c1[2], c1[3]};
            const float ce[8] = {e0[0], e0[1], e0[2], e0[3], e1[0], e1[1], e1[2], e1[3]};
            if (PASS_C) {
                const float qq[8] = {bflo(qw.x), bfhi(qw.x), bflo(qw.y), bfhi(qw.y), bflo(qw.z), bfhi(qw.z), bflo(qw.w), bfhi(qw.w)};
                f32x4 qa, qb, ka, kb;
#pragma unroll
                for (int e = 0; e < 4; ++e) { qa[e] = qq[e] * 0.125f * __expf(cm[e]); qb[e] = qq[e + 4] * 0.125f * __expf(cm[e + 4]); ka[e] = kk[e] * __expf(-cm[e]); kb[e] = kk[e + 4] * __expf(-cm[e + 4]); }
                *(LAS bf16x8*)(sQD + t_ * 72 + k8) = pack8(qa, qb); *(LAS bf16x8*)(sKI + t_ * 72 + k8) = pack8(ka, kb);
                const int dv = tid >> 2, kq = (tid & 3) * 16;
                *(LAS bf16x8*)(sSt + dv * 72 + kq) = pack8(st0, st1); *(LAS bf16x8*)(sSt + dv * 72 + kq + 8) = pack8(st2, st3);
            } else {
#pragma unroll
                for (int e = 0; e < 8; ++e) sKEt[(k8 + e) * 72 + t_] = f2bf(kk[e] * __expf(ce[e] - cm[e]));
                if (t_ == 63) {
#pragma unroll
                    for (int e = 0; e < 8; ++e) DEC[(size_t)u * 64 + k8 + e] = __expf(ce[e]);
                }
            }
            const int s = tid >> 3, c = tid & 7;
            const u32x4 v0 = gv0, v1 = gv1;
            LAS bf16_t* vd = sVt + (16 * c) * 72 + s;
            vd[0 * 72] = (bf16_t)(v0.x & 0xffff); vd[1 * 72] = (bf16_t)(v0.x >> 16); vd[2 * 72] = (bf16_t)(v0.y & 0xffff); vd[3 * 72] = (bf16_t)(v0.y >> 16);
            vd[4 * 72] = (bf16_t)(v0.z & 0xffff); vd[5 * 72] = (bf16_t)(v0.z >> 16); vd[6 * 72] = (bf16_t)(v0.w & 0xffff); vd[7 * 72] = (bf16_t)(v0.w >> 16);
            vd[8 * 72] = (bf16_t)(v1.x & 0xffff); vd[9 * 72] = (bf16_t)(v1.x >> 16); vd[10 * 72] = (bf16_t)(v1.y & 0xffff); vd[11 * 72] = (bf16_t)(v1.y >> 16);
            vd[12 * 72] = (bf16_t)(v1.z & 0xffff); vd[13 * 72] = (bf16_t)(v1.z >> 16); vd[14 * 72] = (bf16_t)(v1.w & 0xffff); vd[15 * 72] = (bf16_t)(v1.w >> 16);
        }
        __syncthreads();
        if (!PASS_C) {
#pragma unroll
            for (int kb = 0; kb < 4; ++kb) { f32x4 acc = (f32x4){0.f, 0.f, 0.f, 0.f};
#pragma unroll
                for (int ks = 0; ks < 2; ++ks) { const bf16x8 a = *(const LAS bf16x8*)(sKEt + (16 * kb + r) * 72 + 32 * ks + 8 * gq); const bf16x8 bb = *(const LAS bf16x8*)(sVt + (16 * wave + r) * 72 + 32 * ks + 8 * gq); acc = mfma16(a, bb, acc); }
                *(f32x4*)(UPD + ((size_t)u * 128 + 16 * wave + r) * 64 + 16 * kb + 4 * gq) = acc; }
        } else {
            {
                const int tb = wave >> 1;
#pragma unroll
                for (int i = 0; i < 2; ++i) { const int sb = 2 * (wave & 1) + i;
                    f32x4 acc = (f32x4){0.f, 0.f, 0.f, 0.f};
                    if (sb <= tb) {
#pragma unroll
                        for (int ks = 0; ks < 2; ++ks) { const bf16x8 a = *(const LAS bf16x8*)(sQD + (16 * tb + r) * 72 + 32 * ks + 8 * gq); const bf16x8 bb = *(const LAS bf16x8*)(sKI + (16 * sb + r) * 72 + 32 * ks + 8 * gq); acc = mfma16(a, bb, acc); }
                    }
#pragma unroll
                    for (int j = 0; j < 4; ++j) { const int tt = 16 * tb + 4 * gq + j, ss = 16 * sb + r; sAT[tt * 72 + ss] = f2bf((sb <= tb && ss <= tt) ? acc[j] : 0.f); } }
            }
            __syncthreads();
            const int tb = wave & 3, hv = wave >> 2;
            f32x4 acc[4];
#pragma unroll
            for (int i = 0; i < 4; ++i) { acc[i] = (f32x4){0.f, 0.f, 0.f, 0.f}; const int dvb = 4 * hv + i;
#pragma unroll
                for (int ks = 0; ks < 2; ++ks) {
                    const bf16x8 a1 = *(const LAS bf16x8*)(sAT + (16 * tb + r) * 72 + 32 * ks + 8 * gq); const bf16x8 b1 = *(const LAS bf16x8*)(sVt + (16 * dvb + r) * 72 + 32 * ks + 8 * gq); acc[i] = mfma16(a1, b1, acc[i]);
                    const bf16x8 a2 = *(const LAS bf16x8*)(sQD + (16 * tb + r) * 72 + 32 * ks + 8 * gq); const bf16x8 b2 = *(const LAS bf16x8*)(sSt + (16 * dvb + r) * 72 + 32 * ks + 8 * gq); acc[i] = mfma16(a2, b2, acc[i]);
                } }
            float ss[4];
#pragma unroll
            for (int j = 0; j < 4; ++j) { float q = 0.f;
#pragma unroll
                for (int i = 0; i < 4; ++i) q += acc[i][j] * acc[i][j];
                q += __shfl_xor(q, 1); q += __shfl_xor(q, 2); q += __shfl_xor(q, 4); q += __shfl_xor(q, 8); ss[j] = q; }
            if (r == 0) {
#pragma unroll
                for (int j = 0; j < 4; ++j) sSS[hv * 64 + 16 * tb + 4 * gq + j] = ss[j];
            }
            __syncthreads();
#pragma unroll
            for (int j = 0; j < 4; ++j) { const int tt = 16 * tb + 4 * gq + j; const float rs = __builtin_amdgcn_rsqf((sSS[tt] + sSS[64 + tt]) * (1.f / 128.f) + EPS);
#pragma unroll
                for (int i = 0; i < 4; ++i) { const int dv = 16 * (4 * hv + i) + r; GR[(r0 + tt) * 512 + h * 128 + dv] = f2bf(acc[i][j] * rs * ng[dv] * bf2f(gg[j][i])); } }
        }
        __syncthreads();
    }
}
__device__ __forceinline__ void gla_scan(unsigned char* ws, int wave, int ngt) {
    ws = launder(ws); const int gtid = blockIdx.x * 512 + vlaunder(wave * 64 + lane_id_());
    float* UPD = (float*)(ws + WS_UPD); const float* DEC = (const float*)(ws + WS_DEC);
    for (int e = gtid; e < 32 * 8192; e += ngt) {
        const int bh = e >> 13, rem = e & 8191, dk = rem & 63; float S = 0.f;
#pragma unroll 1
        for (int n0 = 0; n0 < 64; n0 += 16) {
            float uv[16], dv[16];
#pragma unroll
            for (int i = 0; i < 16; ++i) { uv[i] = UPD[((size_t)(bh * 64 + n0 + i)) * 8192 + rem]; dv[i] = DEC[(bh * 64 + n0 + i) * 64 + dk]; }
#pragma unroll
            for (int i = 0; i < 16; ++i) { UPD[((size_t)(bh * 64 + n0 + i)) * 8192 + rem] = S; S = dv[i] * S + uv[i]; }
        }
    }
}
__device__ __forceinline__ void conv_fix(const Params& p, int l, int wave, int ngt) {
    unsigned char* ws = launder(PP(ws)); const int gtid = blockIdx.x * 512 + vlaunder(wave * 64 + lane_id_());
    const float* head = (const float*)(ws + WS_HEAD); const float* tail = (const float*)(ws + WS_TAIL); bf16_t* act = (bf16_t*)(ws + WS_ACT);
    const float* cw = launder(PP(ffn_conv_w)) + (size_t)l * 3 * DFF2; const float* cb = launder(PP(ffn_conv_b)) + (size_t)l * DFF2;
    for (int e = gtid; e < 128 * DFF; e += ngt) {
        const int pm = e / DFF, c = e % DFF, j = c >> 7, cc = c & 127; const int pa = 256 * j + cc, pu = pa + 128;
        const bool first = (pm & 15) == 0;
        const float ta0 = first ? 0.f : tail[((size_t)(pm - 1) * 2 + 0) * DFF2 + pa], ta1 = first ? 0.f : tail[((size_t)(pm - 1) * 2 + 1) * DFF2 + pa];
        const float tu0 = first ? 0.f : tail[((size_t)(pm - 1) * 2 + 0) * DFF2 + pu], tu1 = first ? 0.f : tail[((size_t)(pm - 1) * 2 + 1) * DFF2 + pu];
        const float ha0 = head[((size_t)pm * 2 + 0) * DFF2 + pa], ha1 = head[((size_t)pm * 2 + 1) * DFF2 + pa];
        const float hu0 = head[((size_t)pm * 2 + 0) * DFF2 + pu], hu1 = head[((size_t)pm * 2 + 1) * DFF2 + pu];
        const float wa0 = cw[c], wa1 = cw[DFF2 + c], wa2 = cw[2 * DFF2 + c], ba = cb[c];
        const float wu0 = cw[DFF + c], wu1 = cw[DFF2 + DFF + c], wu2 = cw[2 * DFF2 + DFF + c], bu = cb[DFF + c];
        const float ca0 = ba + wa0 * ta0 + wa1 * ta1 + wa2 * ha0, cu0 = bu + wu0 * tu0 + wu1 * tu1 + wu2 * hu0;
        const float ca1 = ba + wa0 * ta1 + wa1 * ha0 + wa2 * ha1, cu1 = bu + wu0 * tu1 + wu1 * hu0 + wu2 * hu1;
        act[((size_t)pm * 256 + 0) * DFF + c] = f2bf(gelu_tanh_f(ca0) * cu0);
        act[((size_t)pm * 256 + 1) * DFF + c] = f2bf(gelu_tanh_f(ca1) * cu1);
    }
}

#define XB_TMO      128
#define XB_XCNT(j)  (256  + 64 * (j))
#define XB_XSUB(j)  (1280 + 64 * (j))
#define XB_XGEN(j)  (2304 + 64 * (j))
#define XB_TOP      3328
#define XB_TOPGEN   3392
#define XCD_BAR_WORDS 3456
#define XB_SPIN_CAP (1u << 18)

__device__ __forceinline__ unsigned xb_ld(unsigned* p)              { return __hip_atomic_load(p, __ATOMIC_RELAXED, __HIP_MEMORY_SCOPE_AGENT); }
__device__ __forceinline__ unsigned xb_add(unsigned* p, unsigned v) { return __hip_atomic_fetch_add(p, v, __ATOMIC_RELAXED, __HIP_MEMORY_SCOPE_AGENT); }
__device__ __forceinline__ unsigned xb_xcc_id() { return (unsigned)__builtin_amdgcn_s_getreg((3 << 11) | 20) & 0xFu; }
#define XB_SPIN(cond, bar) do { unsigned _sp = 0; while (cond) { __builtin_amdgcn_s_sleep(1); \
    if ((++_sp & 255u) == 0u) { if (xb_ld(&(bar)[XB_TMO])) break; if (_sp > XB_SPIN_CAP) { atomicAdd(&(bar)[XB_TMO], 1u); break; } } } } while (0)

struct XcdBarrier {
    unsigned* bar; unsigned x;
    volatile LAS unsigned* st;
};

__device__ __forceinline__ XcdBarrier xcd_barrier_post(unsigned* bar, volatile LAS unsigned* st, int wave_) {
    XcdBarrier b; b.bar = bar; b.x = xb_xcc_id(); b.st = st;
    if (wave_ == 0 && lane_id_() == 0) (void)xb_add(&bar[XB_XCNT(b.x)], 1u);
    return b;
}
__device__ __forceinline__ void xcd_barrier_complete(unsigned* bar, unsigned x, unsigned& nloc, unsigned& nx) {
    const unsigned G = gridDim.x * gridDim.y * gridDim.z;
    unsigned sum, cnt, mine, sp = 0u;
    for (;;) {
        sum = 0u; cnt = 0u; mine = 0u;
#pragma unroll
        for (unsigned j = 0; j < 16; ++j) { const unsigned c = xb_ld(&bar[XB_XCNT(j)]); sum += c; cnt += (c > 0u) ? 1u : 0u; mine = (j == x) ? c : mine; }
        if (sum == G) break;
        __builtin_amdgcn_s_sleep(1);
        if ((++sp & 255u) == 0u) { if (xb_ld(&bar[XB_TMO])) break; if (sp > XB_SPIN_CAP) { atomicAdd(&bar[XB_TMO], 1u); break; } }
    }
    nloc = mine > 0u ? mine : 1u; nx = cnt > 0u ? cnt : 1u;
}

__device__ __forceinline__ void xcd_barrier(const XcdBarrier& b, int wave_) {
    asm volatile("s_waitcnt vmcnt(0)" ::: "memory");
    __syncthreads();
    if (wave_ == 0 && lane_id_() == 0) {
        unsigned* bar = b.bar;
        __builtin_amdgcn_s_waitcnt(0);
        unsigned nloc = b.st[0], nx = b.st[1];
        if (nloc == 0u) { xcd_barrier_complete(bar, b.x, nloc, nx); b.st[0] = nloc; b.st[1] = nx; }
        const unsigned old = xb_add(&bar[XB_XSUB(b.x)], 1u);
        const unsigned gen = old / nloc;
        if (old + 1u == (gen + 1u) * nloc) {
            __builtin_amdgcn_fence(__ATOMIC_RELEASE, "agent");
            asm volatile("s_waitcnt vmcnt(0)" ::: "memory");
            const unsigned og = xb_add(&bar[XB_TOP], 1u);
            const unsigned tg = og / nx;
            if (og + 1u == (tg + 1u) * nx) xb_add(&bar[XB_TOPGEN], 1u);
            else XB_SPIN(xb_ld(&bar[XB_TOPGEN]) == tg, bar);
            __builtin_amdgcn_fence(__ATOMIC_ACQUIRE, "agent");
            xb_add(&bar[XB_XGEN(b.x)], 1u);
            asm volatile("s_waitcnt vmcnt(0)" ::: "memory");
        } else {
            XB_SPIN(xb_ld(&bar[XB_XGEN(b.x)]) == gen, bar);
            __builtin_amdgcn_fence(__ATOMIC_ACQUIRE, "agent");
            asm volatile("s_waitcnt vmcnt(0)" ::: "memory");
        }
    }
    __syncthreads();
}
#define CG_SYNC() do { asm volatile("s_waitcnt vmcnt(0) lgkmcnt(0)" ::: "memory"); grid.sync(); } while (0)
#define GRID_SYNC() do { for (int rs_ = 0; rs_ < REP_SYNC; ++rs_) { xcd_barrier(xbar, wave); } } while (0)
#define TSTAMP(k) do { if (TS_PHASE >= 0) { const unsigned long long now_ = __builtin_amdgcn_s_memrealtime(); if ((k) == TS_PHASE) tsel += now_ - tprev; tprev = now_; } } while (0)
#ifndef DBG_STOP
#define DBG_STOP 0
#endif
#ifndef REP_GEMM
#define REP_GEMM 1
#endif
#ifndef REP_SYNC
#define REP_SYNC 1
#endif
#ifndef PROBE
#define PROBE 0
#endif
#ifndef TS_PHASE
#define TS_PHASE -1
#endif
#ifndef G2_STAGGER
#define G2_STAGGER 800
#endif
__device__ __forceinline__ void dbg_dump(float* out, const bf16_t* a, const bf16_t* b, const bf16_t* c, int lda) {
    for (size_t e = (size_t)blockIdx.x * 512 + threadIdx.x; e < (size_t)MTOK * DM; e += (size_t)gridDim.x * 512) {
        const size_t m = e >> 10; const int col = (lda == 3072) ? (int)(e & 1023) + 1024 * (int)(m % 3) : (int)(e & 1023) % lda; float v = bf2f(a[m * lda + col]); if (b) v += bf2f(b[m * lda + col]); if (c) v += bf2f(c[m * lda + col]); out[e] = v; }
}
__global__ void __launch_bounds__(512, 2) mega_fwd(Params p) {
    extern __shared__ __attribute__((aligned(16))) unsigned char lds_raw[];
    LAS unsigned char* lds = (LAS unsigned char*)lds_raw;
    cg::grid_group grid = cg::this_grid();
    const int tid = 0, lane = 0, wave = __builtin_amdgcn_readfirstlane((int)threadIdx.x >> 6);
    const int G = gridDim.x, gw = blockIdx.x * 8 + wave, ngw = G * 8, ngt = G * 512;
    unsigned char* ws = PP(ws);
    bf16_t* XN = (bf16_t*)(ws + WS_XN);
    volatile LAS unsigned* misc = (volatile LAS unsigned*)(lds + MISC_OFF);
    if (wave == 0 && lane_id_() < 4) misc[lane_id_()] = 0u;
    __syncthreads();
    const XcdBarrier xbar = xcd_barrier_post((unsigned*)(ws + WS_BAR), misc, wave);

    unsigned long long tprev = (TS_PHASE >= 0) ? __builtin_amdgcn_s_memrealtime() : 0ull, tsel = 0ull;
    convert_weights(p, 0, lds, gw, ngw, wave, lane);
    if (PROBE & 1) convert_weights(p, 0, lds, gw, ngw, wave, lane);
    row_phase<false, false, true>(PP(x), nullptr, nullptr, nullptr, PP(mix_pre_g), XN, gw, ngw, lane);
    if (gridDim.x > 65535u) CG_SYNC();
    GRID_SYNC();
    TSTAMP(0);
    if (DBG_STOP == 8) {
        {
            unsigned char* ws = launder(PP(ws)); bf16_t* XN = (bf16_t*)(ws + WS_XN);
            pg8::Gemm g{XN, (const bf16_t*)(ws + WS_WIN) + (size_t)4352 * 1024, 1024, 1024, 1024, 0, 0}; pg8::StaticOrder S; S.init(MTOK, 3072, G, (int)blockIdx.x);
            pg8::EpiGates E{(bf16_t*)(ws + WS_GATES)}; pg8::gemm_phase(lds, g, S, E, wave);
        }
        GRID_SYNC();
        TSTAMP(1);
        dbg_dump(PP(out), (const bf16_t*)(ws + WS_GATES), nullptr, nullptr, 3072); return;
    }
#pragma unroll 1
    for (int l = 0; l < 2; ++l) {
        {
            unsigned char* ws = launder(PP(ws)); bf16_t* XN = (bf16_t*)(ws + WS_XN);
            gdown_phase(ws, gw, ngw);
            pg8::Gemm g{XN, (const bf16_t*)(ws + WS_WIN), 1024, 1024, 1024, 0, 0}; pg8::StaticOrder S; S.init(MTOK, 4096, G, (int)blockIdx.x);
            pg8::EpiG1 E{ws}; for (int rep_ = 0; rep_ < REP_GEMM; ++rep_) pg8::gemm_phase(lds, g, S, E, wave);
        }
        GRID_SYNC();
        TSTAMP(2);
        if (DBG_STOP == 1) { dbg_dump(PP(out), (const bf16_t*)(ws + WS_KA), (const bf16_t*)(ws + WS_SV), (const bf16_t*)(ws + WS_GV), 512); return; }
        if (PROBE & 16) sb_phase(lds, ws, tid, wave, lane, 428 * MiB);
        sb_phase(lds, ws, tid, wave, lane);
        TSTAMP(15);
        sg_phase(lds, p, l, tid, wave, lane);
        TSTAMP(16);
        gla_phase<false>(lds, p, l, tid, wave, lane);
        if (PROBE & 4) gla_phase<false>(lds, p, l, tid, wave, lane);
        GRID_SYNC();
        TSTAMP(3);
        gla_scan(ws, wave, ngt);
        GRID_SYNC();
        TSTAMP(4);
        gla_phase<true>(lds, p, l, tid, wave, lane);
        GRID_SYNC();
        TSTAMP(5);
        if (DBG_STOP == 2) { dbg_dump(PP(out), (const bf16_t*)(ws + WS_QA), (const bf16_t*)(ws + WS_U), (const bf16_t*)(ws + WS_GR), 512); return; }
        {
            unsigned char* ws = launder(PP(ws)); bf16_t* XN = (bf16_t*)(ws + WS_XN);
            pg8::Gemm g{XN, (const bf16_t*)(ws + WS_WIN) + (size_t)4352 * 1024, 1024, 1024, 1024, 0, 0}; pg8::StaticOrder S; S.init(MTOK, 3072, G, (int)blockIdx.x);
            pg8::EpiGates E{(bf16_t*)(ws + WS_GATES)}; for (int rep_ = 0; rep_ < REP_GEMM; ++rep_) pg8::gemm_phase(lds, g, S, E, wave);
        }
        GRID_SYNC();
        TSTAMP(6);
        if (DBG_STOP == 7) { dbg_dump(PP(out), (const bf16_t*)(ws + WS_GATES), nullptr, nullptr, 3072); return; }
        {
            unsigned char* ws = launder(PP(ws)); bf16_t* XN = (bf16_t*)(ws + WS_XN);
            pg8::Gemm g{(const bf16_t*)(ws + WS_QA), (const bf16_t*)(ws + WS_WP), 1536, 512, 1536, 0, (size_t)(32 * MiB)}; pg8::StaticOrder S; S.init(MTOK, 1024, G, (int)blockIdx.x);
            pg8::EpiMerge3 E{(const bf16_t*)(ws + WS_GATES), XN};
            pg8::gemm_merge_phase(lds, g, S, E, wave);
        }
        GRID_SYNC();
        TSTAMP(7);
        if (DBG_STOP == 3) { dbg_dump(PP(out), (const bf16_t*)(ws + WS_XN), nullptr, nullptr, 1024); return; }
        {
            unsigned char* ws = launder(PP(ws)); bf16_t* XN = (bf16_t*)(ws + WS_XN);
            pg8::Gemm g{XN, (const bf16_t*)(ws + WS_WOUT), 1024, 1024, 1024, 0, 0}; pg8::StaticOrder S; S.init(MTOK, 1024, G, (int)blockIdx.x);
            pg8::EpiF32 E{(bf16_t*)(ws + WS_Y32)}; for (int rep_ = 0; rep_ < REP_GEMM; ++rep_) pg8::gemm_phase(lds, g, S, E, wave);
        }
        GRID_SYNC();
        TSTAMP(8);
        row_phase<true, true, true>(l == 0 ? PP(x) : (const float*)PP(out), (const bf16_t*)(ws + WS_Y32), PP(mix_post_g) + l * DM, PP(out), PP(ffn_pre_g) + l * DM, XN, gw, ngw, lane);
        GRID_SYNC();
        TSTAMP(9);
        if (DBG_STOP == 4) return;
        {
            unsigned char* ws = launder(PP(ws)); bf16_t* XN = (bf16_t*)(ws + WS_XN);
            pg8::Gemm g{XN, (const bf16_t*)(ws + WS_WUP), 1024, 1024, 1024, 0, 0}; pg8::StaticOrder S; S.init(MTOK, DFF2, G, (int)blockIdx.x);
            pg8::EpiConv E{launder(PP(ffn_conv_w)) + (size_t)l * 3 * DFF2, launder(PP(ffn_conv_b)) + (size_t)l * DFF2, (bf16_t*)(ws + WS_ACT), (float*)(ws + WS_HEAD), (float*)(ws + WS_TAIL)};
            for (int rep_ = 0; rep_ < REP_GEMM; ++rep_) pg8::gemm_phase(lds, g, S, E, wave);
        }
        GRID_SYNC();
        TSTAMP(10);
        conv_fix(p, l, wave, ngt);
        GRID_SYNC();
        TSTAMP(11);
        if (DBG_STOP == 5) { dbg_dump(PP(out), (const bf16_t*)(ws + WS_ACT), nullptr, nullptr, 1024); return; }
        {
            unsigned char* ws = launder(PP(ws));
            pg8::Gemm g{(const bf16_t*)(ws + WS_ACT), (const bf16_t*)(ws + WS_WDN), DFF, DFF, DFF, 0, 0}; pg8::StaticOrder S; S.init(MTOK, 1024, G, (int)blockIdx.x);
            pg8::EpiF32 E{(bf16_t*)(ws + WS_Y32B)}; for (int rep_ = 0; rep_ < REP_GEMM; ++rep_) pg8::gemm_phase(lds, g, S, E, wave);
        }
        GRID_SYNC();
        TSTAMP(12);
        if (l == 0) {
            row_phase<true, true, true>(PP(out), (const bf16_t*)(ws + WS_Y32B), PP(ffn_post_g), PP(out), PP(mix_pre_g) + DM, XN, gw, ngw, lane);
            convert_weights(p, 1, lds, gw, ngw, wave, lane);
            if (PROBE & 1) convert_weights(p, 1, lds, gw, ngw, wave, lane);
            GRID_SYNC();
            TSTAMP(13);
            if (DBG_STOP == 6) return;
        } else {
            row_phase<true, true, false>(PP(out), (const bf16_t*)(ws + WS_Y32B), PP(ffn_post_g) + DM, PP(out), nullptr, nullptr, gw, ngw, lane);
        }
    }
    if (TS_PHASE >= 0) { TSTAMP(14); if (blockIdx.x == 0 && wave == 0 && lane_id_() == 0) { const unsigned long long t0_ = __builtin_amdgcn_s_memrealtime(); while (__builtin_amdgcn_s_memrealtime() - t0_ < tsel) __builtin_amdgcn_s_sleep(8); } }
}

extern "C" void kernel_launch(void* const* d_in, const int* in_sizes, int n_in, void* d_out, int out_size, void* d_ws, size_t ws_size, hipStream_t stream) {
    static int grid = 0;
    if (grid == 0) {
        if (n_in != 21 || out_size != MTOK * DM || ws_size < WS_END) { fprintf(stderr, "kernel_launch: unexpected shapes (n_in %d, out %d, ws %zu)\n", n_in, out_size, ws_size); grid = -1; return; }
        int dev = 0, cus = 0, per_cu = 0;
        hipGetDevice(&dev); hipDeviceGetAttribute(&cus, hipDeviceAttributeMultiprocessorCount, dev);
        if (hipFuncSetAttribute((const void*)mega_fwd, hipFuncAttributeMaxDynamicSharedMemorySize, LDS_BYTES) != hipSuccess) { fprintf(stderr, "kernel_launch: hipFuncSetAttribute failed\n"); grid = -1; return; }
        if (hipOccupancyMaxActiveBlocksPerMultiprocessor(&per_cu, (const void*)mega_fwd, 512, LDS_BYTES) != hipSuccess || per_cu < 1) { fprintf(stderr, "kernel_launch: occupancy query says %d blocks/CU\n", per_cu); per_cu = 1; }
        (void)hipGetLastError();
        if (cus > 512) cus = 512;
        grid = cus;
    }
    if (grid < 0) return;
    Params p{};
    const float** f = (const float**)&p;
    for (int i = 0; i < 21; ++i) f[i] = (const float*)d_in[i];
    p.out = (float*)d_out; p.ws = (unsigned char*)d_ws;
    (void)hipMemsetAsync(d_ws, 0, 65536, stream);
    void* args[] = {&p};
    hipError_t e = hipLaunchCooperativeKernel((const void*)mega_fwd, dim3(grid), dim3(512), args, LDS_BYTES, stream);
    if (e != hipSuccess) fprintf(stderr, "cooperative launch failed: %s (grid %d)\n", hipGetErrorString(e), grid);
}
```

```cpp
#include <hip/hip_runtime.h>
#include <hip/hip_cooperative_groups.h>
#include <cstdio>
#include <cstdint>
namespace cg = cooperative_groups;

#define LAS __attribute__((address_space(3)))
typedef unsigned short bf16_t;
typedef short bf16x8 __attribute__((ext_vector_type(8)));
typedef float f32x4 __attribute__((ext_vector_type(4)));
typedef unsigned u32x4 __attribute__((ext_vector_type(4)));
typedef unsigned u32x2 __attribute__((ext_vector_type(2)));

constexpr int BATCH = 8, SEQ = 4096, DM = 1024, MTOK = BATCH * SEQ;
constexpr int INW = 7184, DFF = 2816, DFF2 = 5632;
constexpr float EPS = 1e-6f;
constexpr float SB_THR = -106.0f * 1.4426950409f;

constexpr size_t MiB = 1u << 20;
constexpr size_t WS_GDOWN = 1 * MiB;
constexpr size_t WS_DEC = 3 * MiB;
constexpr size_t WS_WIN = 4 * MiB;
constexpr size_t WS_WP = 19 * MiB;
constexpr size_t WS_WOUT = 22 * MiB;
constexpr size_t WS_WUP = 24 * MiB;
constexpr size_t WS_WDN = 35 * MiB;
constexpr size_t WS_XN = 41 * MiB;
constexpr size_t WS_QA = 105 * MiB, WS_U = 137 * MiB, WS_GR = 169 * MiB;
constexpr size_t WS_KA = 201 * MiB, WS_VA = 233 * MiB, WS_SV = 265 * MiB, WS_GV = 297 * MiB;
constexpr size_t WS_GQ = 329 * MiB, WS_GK = 345 * MiB;
constexpr size_t WS_UPD = 361 * MiB;
constexpr size_t WS_GATES = 201 * MiB;
constexpr size_t WS_Y32 = 105 * MiB;
constexpr size_t WS_ACT = 105 * MiB;
constexpr size_t WS_HEAD = 282 * MiB;
constexpr size_t WS_TAIL = 288 * MiB;
constexpr size_t WS_Y32B = 300 * MiB;
constexpr size_t WS_END = 428 * MiB;

constexpr int LDS_BYTES = 147456;
constexpr int MISC_OFF = 147456 - 64;
constexpr size_t WS_BAR = 0;
constexpr int XT_OFF = 131072;

typedef float f32x2_t __attribute__((ext_vector_type(2)));
typedef __bf16 bf16x2_t __attribute__((ext_vector_type(2)));
__device__ __forceinline__ unsigned cvt_pk_bf16(float lo, float hi) { const f32x2_t v = {lo, hi}; const bf16x2_t b = __builtin_convertvector(v, bf16x2_t); return __builtin_bit_cast(unsigned, b); }
__device__ __forceinline__ float bf2f(unsigned short h) { return __uint_as_float(((unsigned)h) << 16); }
__device__ __forceinline__ float bflo(unsigned w) { return __uint_as_float(w << 16); }
__device__ __forceinline__ float bfhi(unsigned w) { return __uint_as_float(w & 0xffff0000u); }
__device__ __forceinline__ unsigned short f2bf(float f) { return (unsigned short)(cvt_pk_bf16(f, 0.f) & 0xffffu); }
__device__ __forceinline__ bf16x8 pack8(f32x4 a, f32x4 b) {
    u32x4 w; w.x = cvt_pk_bf16(a[0], a[1]); w.y = cvt_pk_bf16(a[2], a[3]); w.z = cvt_pk_bf16(b[0], b[1]); w.w = cvt_pk_bf16(b[2], b[3]);
    return __builtin_bit_cast(bf16x8, w);
}
__device__ __forceinline__ float rcpf_(float x) { return __builtin_amdgcn_rcpf(x); }
__device__ __forceinline__ float gelu_tanh_f(float x) { const float u = 0.7978845608f * (x + 0.044715f * x * x * x); return x * rcpf_(1.f + __expf(-2.f * u)); }
__device__ __forceinline__ float sigmoid_f(float x) { return rcpf_(1.f + __expf(-x)); }
__device__ __forceinline__ float logsig_f(float x) { return fminf(x, 0.f) - __logf(1.f + __expf(-fabsf(x))); }
__device__ __forceinline__ float logsig2_f(float x2) { return fminf(x2, 0.f) - __builtin_amdgcn_logf(1.f + __builtin_amdgcn_exp2f(-fabsf(x2))); }
__device__ __forceinline__ f32x4 mfma16(bf16x8 a, bf16x8 b, f32x4 c) { return __builtin_amdgcn_mfma_f32_16x16x32_bf16(a, b, c, 0, 0, 0); }
__device__ __forceinline__ float wave_sum(float v) {
#pragma unroll
    for (int o = 1; o < 64; o <<= 1) v += __shfl_xor(v, o);
    return v;
}
#define LDS_WAIT() asm volatile("s_waitcnt lgkmcnt(0)" ::: "memory")
template <class T> __device__ __forceinline__ T* launder(T* p) {
    const unsigned long long v = (unsigned long long)p; unsigned lo = __builtin_amdgcn_readfirstlane((unsigned)v), hi = __builtin_amdgcn_readfirstlane((unsigned)(v >> 32));
    asm volatile("" : "+s"(lo), "+s"(hi)); return (T*)(((unsigned long long)hi << 32) | lo); }
__device__ __forceinline__ int lane_id_() { int l = (int)__builtin_amdgcn_mbcnt_hi(~0u, __builtin_amdgcn_mbcnt_lo(~0u, 0u)); asm volatile("" : "+v"(l)); return l; }
__device__ __forceinline__ int vlaunder(int x) { asm volatile("" : "+v"(x)); return x; }
__device__ __forceinline__ float dpp_shr1(float v) { return __builtin_bit_cast(float, __builtin_amdgcn_update_dpp(0, __builtin_bit_cast(int, v), 0x111, 0xf, 0xf, true)); }
__device__ __forceinline__ float dpp_shr2(float v) { return __builtin_bit_cast(float, __builtin_amdgcn_update_dpp(0, __builtin_bit_cast(int, v), 0x112, 0xf, 0xf, true)); }
__device__ __forceinline__ float dpp_shl14(float v) { return __builtin_bit_cast(float, __builtin_amdgcn_update_dpp(0, __builtin_bit_cast(int, v), 0x10E, 0xf, 0xf, true)); }
__device__ __forceinline__ float dpp_shl15(float v) { return __builtin_bit_cast(float, __builtin_amdgcn_update_dpp(0, __builtin_bit_cast(int, v), 0x10F, 0xf, 0xf, true)); }

struct Params {
    const float* x; const float* mix_pre_g; const float* mix_post_g; const float* w_in; const float* sg_ln_g; const float* sg_ln_b; const float* sg_w; const float* sg_b;
    const float* gla_w_gup; const float* gla_b_gate; const float* gla_norm_g; const float* p_a; const float* p_b; const float* p_c; const float* w_out;
    const float* ffn_pre_g; const float* ffn_post_g; const float* ffn_w_up; const float* ffn_conv_w; const float* ffn_conv_b; const float* ffn_w_down;
    float* out; unsigned char* ws;
};
#include <cstddef>
__device__ __forceinline__ const void* karg_(int byte_off) { const char __attribute__((address_space(4)))* ka = (const char __attribute__((address_space(4)))*)__builtin_amdgcn_kernarg_segment_ptr(); return *(const void* const volatile __attribute__((address_space(4)))*)(ka + byte_off); }
#define PP(field) ((decltype(Params::field))karg_((int)offsetof(Params, field)))

namespace pg8 {
constexpr int BM = 256, BK = 64, HALF = 128, HTB = HALF * BK * 2, NXCD = 8, WGM = 8;
__device__ __forceinline__ int lds_byte(int r, int c) { const int st = (r >> 4) * 2 + (c >> 5), rr = r & 15, cc = c & 31, ob = rr * 64 + cc * 2; return st * 1024 + (ob ^ (((ob >> 9) & 1) << 5)); }
__device__ __forceinline__ void stage_rc(int b, int& R, int& C) { const int st = b / 1024, sb = b % 1024, swz = sb ^ (((sb >> 9) & 1) << 5); R = (st >> 1) * 16 + swz / 64; C = (st & 1) * 32 + (swz % 64) / 2; }
__device__ __forceinline__ int perm32(int rho) { const int n = rho >> 4, i = rho & 15; return 8 * (i >> 2) + 4 * n + (i & 3); }

struct Unit { int pm, pn; };
struct Gemm { const bf16_t* A; const bf16_t* Bt; int K, lda, ldb, adiv; size_t astride; };

struct StaticOrder {
    int nM, nN, nwg, G, c;
    __device__ __forceinline__ void init(int M, int N, int G_, int c_) { nM = M / BM; nN = N / BM; nwg = nM * nN; G = G_; c = c_; }
    __device__ __forceinline__ bool next(int i, Unit& u) const {
        const long L = (long)i * G + c; if (L >= nwg) return false;
        int wgid = (int)L; { const int q = nwg / NXCD, r = nwg % NXCD, xcd = wgid % NXCD, off = wgid / NXCD; wgid = (xcd < r ? xcd * (q + 1) : r * (q + 1) + (xcd - r) * q) + off; }
        const int nig = WGM * nN, gid = wgid / nig, fm = gid * WGM, gsz = (nM - fm) < WGM ? (nM - fm) : WGM;
        u.pm = fm + ((wgid % nig) % gsz); u.pn = (wgid % nig) / gsz; return true;
    }
};
struct MergeOrder {
    StaticOrder base;
    __device__ __forceinline__ bool next(int i, Unit& u) const { const int br = i % 3; Unit t; if (!base.next(i / 3, t)) return false; u.pm = t.pm; u.pn = t.pn + 4 * br; return true; }
};

template <class Epi, class Sched>
__device__ __forceinline__ void gemm_phase(LAS unsigned char* lds, const Gemm g, const Sched& S, const Epi& E, int wave_) {
    const int tid = vlaunder(wave_ * 64 + lane_id_()), wid = wave_, lane = tid & 63, wr = wid >> 2, wc = wid & 3, fr = lane & 15, fq = lane >> 4;
    const int K = g.K, nt = K / BK;
    unsigned voffA[2], voffB[2];
#pragma unroll
    for (int i = 0; i < 2; ++i) { int R, C; stage_rc(tid * 16 + i * 8192, R, C); const int Rb = Epi::PERM ? ((R & ~31) + perm32(R & 31)) : R;
        voffA[i] = (unsigned)(R * g.lda + C) * 2u; voffB[i] = (unsigned)(Rb * g.ldb + C) * 2u; }
    const size_t kstep = (size_t)(BK * 2);
    const size_t hstepA = (size_t)HALF * g.lda * 2, hstepB = (size_t)HALF * g.ldb * 2;
    const size_t tstepA = 2 * hstepA, tstepB = 2 * hstepB;
    const unsigned ldsw = (unsigned)wid * 1024u;
    const int aoff = lds_byte(wr * 64 + fr, fq * 8), boff = lds_byte(wc * 32 + fr, fq * 8);
#define PG8_SA(b, h) (((b) * 2 + (h)) * HTB)
#define PG8_SB(b, h) ((4 + (b) * 2 + (h)) * HTB)
#define PG8_STAGE(bufoff, gbase, voff) do { _Pragma("unroll") for (int _i = 0; _i < 2; ++_i) \
        __builtin_amdgcn_global_load_lds((const unsigned*)((const char*)(gbase) + (voff)[_i]), (LAS unsigned*)(lds + (bufoff) + ldsw + _i * 8192), 16, 0, 0); } while (0)
#define PG8_LDA(dst, b, h) do { _Pragma("unroll") for (int m = 0; m < 4; ++m) _Pragma("unroll") for (int k = 0; k < 2; ++k) dst[m][k] = *(const LAS bf16x8*)(lds + PG8_SA(b, h) + aoff + m * 2048 + k * 1024); } while (0)
#define PG8_LDB(dst, b, h) do { _Pragma("unroll") for (int n = 0; n < 2; ++n) _Pragma("unroll") for (int k = 0; k < 2; ++k) dst[n][k] = *(const LAS bf16x8*)(lds + PG8_SB(b, h) + boff + n * 2048 + k * 1024); } while (0)
#define PG8_MMA(ai, bj, At, Bt) do { __builtin_amdgcn_s_setprio(1); _Pragma("unroll") for (int m = 0; m < 4; ++m) _Pragma("unroll") for (int n = 0; n < 2; ++n) _Pragma("unroll") for (int k = 0; k < 2; ++k) \
        acc[ai][bj][m][n] = __builtin_amdgcn_mfma_f32_16x16x32_bf16(Bt[n][k], At[m][k], acc[ai][bj][m][n], 0, 0, 0); __builtin_amdgcn_s_setprio(0); } while (0)
#define PG8_WAIT_V(n) asm volatile("s_waitcnt vmcnt(" #n ")" ::: "memory")
#define PG8_WAIT_L(n) asm volatile("s_waitcnt lgkmcnt(" #n ")" ::: "memory")
#define PG8_BAR __builtin_amdgcn_s_barrier()
#define PG8_SCHED __builtin_amdgcn_sched_barrier(0)
    Unit cur, nxt; int ui = 0;
    (void)S.next(0, cur);
    f32x4 acc[2][2][4][2];
#pragma unroll
    for (int a = 0; a < 2; ++a)
#pragma unroll
        for (int b = 0; b < 2; ++b)
#pragma unroll
            for (int m = 0; m < 4; ++m)
#pragma unroll
                for (int n = 0; n < 2; ++n) acc[a][b][m][n] = (f32x4){0.f, 0.f, 0.f, 0.f};
    bf16x8 At[4][2], B0[2][2], B1[2][2];
    const char* cA = (const char*)g.A + (size_t)cur.pm * tstepA + (g.adiv ? (size_t)(cur.pn / g.adiv) * g.astride : 0);
    const char* cB = (const char*)g.Bt + (size_t)cur.pn * tstepB;
    PG8_STAGE(PG8_SB(0, 0), cB, voffB); PG8_STAGE(PG8_SB(0, 1), cB + hstepB, voffB); PG8_STAGE(PG8_SA(0, 0), cA, voffA); PG8_STAGE(PG8_SA(0, 1), cA + hstepA, voffA);
    if (wr == 1) PG8_BAR;
    PG8_WAIT_V(2); PG8_BAR;
    PG8_STAGE(PG8_SB(1, 0), cB + kstep, voffB); PG8_STAGE(PG8_SA(1, 0), cA + kstep, voffA); PG8_STAGE(PG8_SB(1, 1), cB + hstepB + kstep, voffB);
    PG8_WAIT_V(6); PG8_BAR;
    for (;;) {
        const bool has_next = S.next(ui + 1, nxt);
        const char* nA = has_next ? (const char*)g.A + (size_t)nxt.pm * tstepA + (g.adiv ? (size_t)(nxt.pn / g.adiv) * g.astride : 0) : cA;
        const char* nB = has_next ? (const char*)g.Bt + (size_t)nxt.pn * tstepB : cB;
        for (int t = 0; t < nt; t += 2) {
            const bool last = (t == nt - 2);
            const char* a1 = cA + (size_t)(t + 1) * kstep;
            const char* a2 = last ? nA : cA + (size_t)(t + 2) * kstep; const char* b2 = last ? nB : cB + (size_t)(t + 2) * kstep;
            const char* a3 = a2 + kstep; const char* b3 = b2 + kstep;
            PG8_LDB(B0, 0, 0); PG8_LDB(B1, 0, 1); PG8_SCHED; PG8_LDA(At, 0, 0); PG8_STAGE(PG8_SA(1, 1), a1 + hstepA, voffA);
            PG8_WAIT_V(8); PG8_WAIT_L(0); PG8_BAR; PG8_MMA(0, 0, At, B0); PG8_MMA(0, 1, At, B1); PG8_BAR; PG8_SCHED;
            PG8_LDA(At, 0, 1); PG8_STAGE(PG8_SB(0, 0), b2, voffB); PG8_STAGE(PG8_SB(0, 1), b2 + hstepB, voffB); PG8_STAGE(PG8_SA(0, 0), a2, voffA);
            PG8_WAIT_V(8); PG8_WAIT_L(0); PG8_BAR; PG8_MMA(1, 0, At, B0); PG8_MMA(1, 1, At, B1); PG8_BAR; PG8_SCHED;
            PG8_LDB(B0, 1, 0); PG8_LDB(B1, 1, 1); PG8_SCHED; PG8_LDA(At, 1, 0); PG8_STAGE(PG8_SA(0, 1), a2 + hstepA, voffA);
            PG8_WAIT_V(8); PG8_WAIT_L(0); PG8_BAR; PG8_MMA(0, 0, At, B0); PG8_MMA(0, 1, At, B1); PG8_BAR; PG8_SCHED;
            PG8_LDA(At, 1, 1); PG8_STAGE(PG8_SB(1, 0), b3, voffB); PG8_STAGE(PG8_SB(1, 1), b3 + hstepB, voffB); PG8_STAGE(PG8_SA(1, 0), a3, voffA);
            PG8_WAIT_V(8); PG8_WAIT_L(0); PG8_BAR; PG8_MMA(1, 0, At, B0); PG8_MMA(1, 1, At, B1); PG8_BAR; PG8_SCHED;
        }
        if (wr == 0) PG8_BAR;
        E(acc, cur, wr, wc, fr, fq, lds);
        if (!has_next) break;
#pragma unroll
        for (int a = 0; a < 2; ++a)
#pragma unroll
            for (int b = 0; b < 2; ++b)
#pragma unroll
                for (int m = 0; m < 4; ++m)
#pragma unroll
                    for (int n = 0; n < 2; ++n) acc[a][b][m][n] = (f32x4){0.f, 0.f, 0.f, 0.f};
        cur = nxt; cA = nA; cB = nB; ++ui;
        if (wr == 1) PG8_BAR;
    }
    PG8_WAIT_V(0);
    PG8_BAR;
#undef PG8_SA
#undef PG8_SB
#undef PG8_STAGE
#undef PG8_LDA
#undef PG8_LDB
#undef PG8_MMA
#undef PG8_WAIT_V
#undef PG8_WAIT_L
#undef PG8_BAR
#undef PG8_SCHED
}

typedef const f32x4 (&AccRef)[2][2][4][2];

struct EpiG1 {
    static constexpr bool PERM = true;
    unsigned char* ws;
    __device__ __forceinline__ void operator()(f32x4 (&acc)[2][2][4][2], const Unit& u, int wr, int wc, int fr, int fq, LAS unsigned char*) const {
        const int pn = u.pn;
        const int row0 = u.pm * BM + wr * 64 + fr;
        if (pn == 16) {
            if (wc == 0 && fq < 2) { float* G = (float*)(ws + WS_GDOWN);
#pragma unroll
                for (int ai = 0; ai < 2; ++ai)
#pragma unroll
                    for (int m = 0; m < 4; ++m)
#pragma unroll
                        for (int n = 0; n < 2; ++n) *(f32x4*)(G + (size_t)(row0 + ai * HALF + m * 16) * 16 + 8 * fq + 4 * n) = acc[ai][0][m][n]; }
            return;
        }
        size_t off; int ldc = 512, colt, act = 0;
        if (pn < 2) { off = WS_QA; colt = pn * 256; }
        else if (pn < 4) { off = WS_KA; colt = (pn - 2) * 256; }
        else if (pn < 6) { off = WS_VA; colt = (pn - 4) * 256; }
        else if (pn < 8) { off = WS_U; colt = (pn - 6) * 256; act = 1; }
        else if (pn < 10) { off = WS_SV; colt = (pn - 8) * 256; act = 1; }
        else if (pn == 10) { off = WS_GQ; colt = 0; ldc = 256; }
        else if (pn == 11) { off = WS_GK; colt = 0; ldc = 256; }
        else if (pn < 14) { off = WS_GV; colt = (pn - 12) * 256; }
        else { off = WS_GR; colt = (pn - 14) * 256; act = 2; }
        bf16_t* base = (bf16_t*)(ws + off);
        const int col0 = colt + wc * 32 + 8 * fq;
#pragma unroll
        for (int ai = 0; ai < 2; ++ai)
#pragma unroll
            for (int m = 0; m < 4; ++m) { bf16_t* rowp = base + (size_t)(row0 + ai * HALF + m * 16) * ldc + col0;
#pragma unroll
                for (int bj = 0; bj < 2; ++bj) { f32x4 v0 = acc[ai][bj][m][0], v1 = acc[ai][bj][m][1];
                    if (act == 1) {
#pragma unroll
                        for (int e = 0; e < 4; ++e) { v0[e] = gelu_tanh_f(v0[e]); v1[e] = gelu_tanh_f(v1[e]); }
                    } else if (act == 2) {
#pragma unroll
                        for (int e = 0; e < 4; ++e) { v0[e] = v0[e] * sigmoid_f(v0[e]); v1[e] = v1[e] * sigmoid_f(v1[e]); }
                    }
                    u32x4 w; w.x = cvt_pk_bf16(v0[0], v0[1]); w.y = cvt_pk_bf16(v0[2], v0[3]); w.z = cvt_pk_bf16(v1[0], v1[1]); w.w = cvt_pk_bf16(v1[2], v1[3]);
                    *(u32x4*)(rowp + bj * HALF) = w; } }
    }
};
struct EpiGates {
    static constexpr bool PERM = true;
    bf16_t* O;
    __device__ __forceinline__ void operator()(f32x4 (&acc)[2][2][4][2], const Unit& u, int wr, int wc, int fr, int fq, LAS unsigned char*) const {
        const int row0 = u.pm * BM + wr * 64 + fr, col0 = u.pn * BM + wc * 32 + 8 * fq;
#pragma unroll
        for (int ai = 0; ai < 2; ++ai)
#pragma unroll
            for (int m = 0; m < 4; ++m) { bf16_t* rowp = O + (size_t)(row0 + ai * HALF + m * 16) * 3072 + col0;
#pragma unroll
                for (int bj = 0; bj < 2; ++bj) { f32x4 v0 = acc[ai][bj][m][0], v1 = acc[ai][bj][m][1];
#pragma unroll
                    for (int e = 0; e < 4; ++e) { v0[e] = sigmoid_f(v0[e]); v1[e] = sigmoid_f(v1[e]); }
                    u32x4 w; w.x = cvt_pk_bf16(v0[0], v0[1]); w.y = cvt_pk_bf16(v0[2], v0[3]); w.z = cvt_pk_bf16(v1[0], v1[1]); w.w = cvt_pk_bf16(v1[2], v1[3]);
                    *(u32x4*)(rowp + bj * HALF) = w; } }
    }
};
struct EpiMerge {
    static constexpr bool PERM = true;
    const bf16_t* gates; bf16_t* O;
    __device__ __forceinline__ void operator()(f32x4 (&acc)[2][2][4][2], const Unit& u, int wr, int wc, int fr, int fq, LAS unsigned char*) const {
        const int br = u.pn >> 2, ct = u.pn & 3;
        const int row0 = u.pm * BM + wr * 64 + fr, col0 = ct * BM + wc * 32 + 8 * fq;
#pragma unroll
        for (int ai = 0; ai < 2; ++ai)
#pragma unroll
            for (int m = 0; m < 4; ++m) { const size_t row = (size_t)(row0 + ai * HALF + m * 16);
#pragma unroll
                for (int bj = 0; bj < 2; ++bj) { f32x4 v0 = acc[ai][bj][m][0], v1 = acc[ai][bj][m][1];
                    const u32x4 gw = *(const u32x4*)(gates + row * 3072 + br * 1024 + col0 + bj * HALF);
                    v0[0] *= bflo(gw.x); v0[1] *= bfhi(gw.x); v0[2] *= bflo(gw.y); v0[3] *= bfhi(gw.y);
                    v1[0] *= bflo(gw.z); v1[1] *= bfhi(gw.z); v1[2] *= bflo(gw.w); v1[3] *= bfhi(gw.w);
                    bf16_t* op = O + row * 1024 + col0 + bj * HALF;
                    if (br > 0) { const u32x4 pw = *(const u32x4*)op;
                        v0[0] += bflo(pw.x); v0[1] += bfhi(pw.x); v0[2] += bflo(pw.y); v0[3] += bfhi(pw.y);
                        v1[0] += bflo(pw.z); v1[1] += bfhi(pw.z); v1[2] += bflo(pw.w); v1[3] += bfhi(pw.w); }
                    u32x4 w; w.x = cvt_pk_bf16(v0[0], v0[1]); w.y = cvt_pk_bf16(v0[2], v0[3]); w.z = cvt_pk_bf16(v1[0], v1[1]); w.w = cvt_pk_bf16(v1[2], v1[3]);
                    *(u32x4*)op = w; } }
    }
};
struct EpiF32 {
    static constexpr bool PERM = true;
    bf16_t* O;
    __device__ __forceinline__ void operator()(f32x4 (&acc)[2][2][4][2], const Unit& u, int wr, int wc, int fr, int fq, LAS unsigned char*) const {
        const int row0 = u.pm * BM + wr * 64 + fr, col0 = u.pn * BM + wc * 32 + 8 * fq;
#pragma unroll
        for (int ai = 0; ai < 2; ++ai)
#pragma unroll
            for (int m = 0; m < 4; ++m) { bf16_t* rowp = O + (size_t)(row0 + ai * HALF + m * 16) * 1024 + col0;
#pragma unroll
                for (int bj = 0; bj < 2; ++bj) { const f32x4 v0 = acc[ai][bj][m][0], v1 = acc[ai][bj][m][1];
                    u32x4 w; w.x = cvt_pk_bf16(v0[0], v0[1]); w.y = cvt_pk_bf16(v0[2], v0[3]); w.z = cvt_pk_bf16(v1[0], v1[1]); w.w = cvt_pk_bf16(v1[2], v1[3]);
                    *(u32x4*)(rowp + bj * HALF) = w; } }
    }
};
struct EpiConv {
    static constexpr bool PERM = true;
    const float* cw; const float* cb; bf16_t* act; float* head; float* tail;
    __device__ __forceinline__ void operator()(f32x4 (&acc)[2][2][4][2], const Unit& u, int wr, int wc, int fr, int fq, LAS unsigned char* lds) const {
        LAS float* XT = (LAS float*)(lds + XT_OFF);
        const int ccol = wc * 32 + 8 * fq;
        if (fr >= 14) {
#pragma unroll
            for (int ai = 0; ai < 2; ++ai)
#pragma unroll
                for (int bj = 0; bj < 2; ++bj)
#pragma unroll
                    for (int n = 0; n < 2; ++n) *(LAS f32x4*)(XT + ((ai * 2 + wr) * 2 + (fr - 14)) * 256 + bj * HALF + ccol + 4 * n) = acc[ai][bj][3][n];
            if (wr == 1) {
#pragma unroll
                for (int bj = 0; bj < 2; ++bj)
#pragma unroll
                    for (int n = 0; n < 2; ++n) *(f32x4*)(tail + ((size_t)u.pm * 2 + (fr - 14)) * DFF2 + u.pn * BM + bj * HALF + ccol + 4 * n) = acc[1][bj][3][n];
            }
        }
        if (fr < 2 && wr == 0) {
#pragma unroll
            for (int bj = 0; bj < 2; ++bj)
#pragma unroll
                for (int n = 0; n < 2; ++n) *(f32x4*)(head + ((size_t)u.pm * 2 + fr) * DFF2 + u.pn * BM + bj * HALF + ccol + 4 * n) = acc[0][bj][0][n];
        }
        asm volatile("s_waitcnt lgkmcnt(0)" ::: "memory"); __builtin_amdgcn_s_barrier(); asm volatile("" ::: "memory");
#pragma unroll
        for (int n = 0; n < 2; ++n) {
            const int ch = u.pn * HALF + ccol + 4 * n;
            const f32x4 wa0 = *(const f32x4*)(cw + ch), wa1 = *(const f32x4*)(cw + DFF2 + ch), wa2 = *(const f32x4*)(cw + 2 * DFF2 + ch), ba = *(const f32x4*)(cb + ch);
            const f32x4 wu0 = *(const f32x4*)(cw + DFF + ch), wu1 = *(const f32x4*)(cw + DFF2 + DFF + ch), wu2 = *(const f32x4*)(cw + 2 * DFF2 + DFF + ch), bu = *(const f32x4*)(cb + DFF + ch);
#pragma unroll
            for (int ai = 1; ai >= 0; --ai)
#pragma unroll
                for (int m = 3; m >= 0; --m) {
                    f32x4 pa, pu;
                    if (m > 0) { pa = acc[ai][0][m - 1][n]; pu = acc[ai][1][m - 1][n]; }
                    else {
                        const int slot = ai * 2 + wr - 1;
                        if (slot >= 0) { pa = *(const LAS f32x4*)(XT + (slot * 2 + (fr & 1)) * 256 + ccol + 4 * n); pu = *(const LAS f32x4*)(XT + (slot * 2 + (fr & 1)) * 256 + HALF + ccol + 4 * n); }
                        else { pa = (f32x4){0.f, 0.f, 0.f, 0.f}; pu = pa; }
                    }
                    f32x4 xa = acc[ai][0][m][n], xu = acc[ai][1][m][n];
                    asm volatile("" : "+v"(xa), "+v"(xu), "+v"(pa), "+v"(pu));
                    f32x4 res;
#pragma unroll
                    for (int e = 0; e < 4; ++e) {
                        const float a1 = dpp_shr1(xa[e]) + dpp_shl15(pa[e]), a2 = dpp_shr2(xa[e]) + dpp_shl14(pa[e]);
                        const float u1 = dpp_shr1(xu[e]) + dpp_shl15(pu[e]), u2 = dpp_shr2(xu[e]) + dpp_shl14(pu[e]);
                        const float ca = ba[e] + wa0[e] * a2 + wa1[e] * a1 + wa2[e] * xa[e];
                        const float cu = bu[e] + wu0[e] * u2 + wu1[e] * u1 + wu2[e] * xu[e];
                        res[e] = gelu_tanh_f(ca) * cu;
                    }
                    asm volatile("" : "+v"(res));
                    acc[ai][0][m][n] = res;
                }
        }
        const int row0 = u.pm * BM + wr * 64 + fr;
#pragma unroll
        for (int ai = 0; ai < 2; ++ai)
#pragma unroll
            for (int m = 0; m < 4; ++m) { const f32x4 v0 = acc[ai][0][m][0], v1 = acc[ai][0][m][1];
                u32x4 w; w.x = cvt_pk_bf16(v0[0], v0[1]); w.y = cvt_pk_bf16(v0[2], v0[3]); w.z = cvt_pk_bf16(v1[0], v1[1]); w.w = cvt_pk_bf16(v1[2], v1[3]);
                *(u32x4*)(act + (size_t)(row0 + ai * HALF + m * 16) * DFF + u.pn * HALF + ccol) = w; }
    }
};
template <class Epi, class Sched>
__device__ __forceinline__ void gemm_merge_phase(LAS unsigned char* lds, const Gemm g, const Sched& S, const Epi& E, int wave_) {
    const int tid = vlaunder(wave_ * 64 + lane_id_()), wid = wave_, lane = tid & 63, wr = wid >> 2, wc = wid & 3, fr = lane & 15, fq = lane >> 4;
    const int K = g.K, nt = K / BK;
    unsigned voffA[2], voffB[2];
#pragma unroll
    for (int i = 0; i < 2; ++i) { int R, C; stage_rc(tid * 16 + i * 8192, R, C); const int Rb = Epi::PERM ? ((R & ~31) + perm32(R & 31)) : R;
        voffA[i] = (unsigned)(R * g.lda + C) * 2u; voffB[i] = (unsigned)(Rb * g.ldb + C) * 2u; }
    const size_t kstep = (size_t)(BK * 2);
    const size_t hstepA = (size_t)HALF * g.lda * 2, hstepB = (size_t)HALF * g.ldb * 2;
    const size_t tstepA = 2 * hstepA, tstepB = 2 * hstepB;
    const unsigned ldsw = (unsigned)wid * 1024u;
    const int aoff = lds_byte(wr * 64 + fr, fq * 8), boff = lds_byte(wc * 32 + fr, fq * 8);
#define PG8_SA(b, h) (((b) * 2 + (h)) * HTB)
#define PG8_SB(b, h) ((4 + (b) * 2 + (h)) * HTB)
#define PG8_STAGE(bufoff, gbase, voff) do { _Pragma("unroll") for (int _i = 0; _i < 2; ++_i) \
        __builtin_amdgcn_global_load_lds((const unsigned*)((const char*)(gbase) + (voff)[_i]), (LAS unsigned*)(lds + (bufoff) + ldsw + _i * 8192), 16, 0, 0); } while (0)
#define PG8_LDA(dst, b, h) do { _Pragma("unroll") for (int m = 0; m < 4; ++m) _Pragma("unroll") for (int k = 0; k < 2; ++k) dst[m][k] = *(const LAS bf16x8*)(lds + PG8_SA(b, h) + aoff + m * 2048 + k * 1024); } while (0)
#define PG8_LDB(dst, b, h) do { _Pragma("unroll") for (int n = 0; n < 2; ++n) _Pragma("unroll") for (int k = 0; k < 2; ++k) dst[n][k] = *(const LAS bf16x8*)(lds + PG8_SB(b, h) + boff + n * 2048 + k * 1024); } while (0)
#define PG8_MMA(ai, bj, At, Bt) do { __builtin_amdgcn_s_setprio(1); _Pragma("unroll") for (int m = 0; m < 4; ++m) _Pragma("unroll") for (int n = 0; n < 2; ++n) _Pragma("unroll") for (int k = 0; k < 2; ++k) \
        acc[ai][bj][m][n] = __builtin_amdgcn_mfma_f32_16x16x32_bf16(Bt[n][k], At[m][k], acc[ai][bj][m][n], 0, 0, 0); __builtin_amdgcn_s_setprio(0); } while (0)
#define PG8_WAIT_V(n) asm volatile("s_waitcnt vmcnt(" #n ")" ::: "memory")
#define PG8_WAIT_L(n) asm volatile("s_waitcnt lgkmcnt(" #n ")" ::: "memory")
#define PG8_BAR __builtin_amdgcn_s_barrier()
#define PG8_SCHED __builtin_amdgcn_sched_barrier(0)
    Unit cur, nxt; int ui = 0;
    (void)S.next(0, cur);
    f32x4 acc[2][2][4][2];
#pragma unroll
    for (int a = 0; a < 2; ++a)
#pragma unroll
        for (int b = 0; b < 2; ++b)
#pragma unroll
            for (int m = 0; m < 4; ++m)
#pragma unroll
                for (int n = 0; n < 2; ++n) acc[a][b][m][n] = (f32x4){0.f, 0.f, 0.f, 0.f};
    bf16x8 At[4][2], B0[2][2], B1[2][2];
#define PG8_AT(base, t) ((base) + (size_t)((t) >> 3) * g.astride + (size_t)((t) & 7) * kstep)
    const char* cA = (const char*)g.A + (size_t)cur.pm * tstepA;
    const char* cB = (const char*)g.Bt + (size_t)cur.pn * tstepB;
    PG8_STAGE(PG8_SB(0, 0), cB, voffB); PG8_STAGE(PG8_SB(0, 1), cB + hstepB, voffB); PG8_STAGE(PG8_SA(0, 0), cA, voffA); PG8_STAGE(PG8_SA(0, 1), cA + hstepA, voffA);
    if (wr == 1) PG8_BAR;
    PG8_WAIT_V(2); PG8_BAR;
    PG8_STAGE(PG8_SB(1, 0), cB + kstep, voffB); PG8_STAGE(PG8_SA(1, 0), cA + kstep, voffA); PG8_STAGE(PG8_SB(1, 1), cB + hstepB + kstep, voffB);
    PG8_WAIT_V(6); PG8_BAR;
    for (;;) {
        const bool has_next = S.next(ui + 1, nxt);
        const char* nA = has_next ? (const char*)g.A + (size_t)nxt.pm * tstepA : cA;
        const char* nB = has_next ? (const char*)g.Bt + (size_t)nxt.pn * tstepB : cB;
#define PG8_KBODY(t) { \
            const bool last = ((t) == nt - 2); \
            const char* a1 = PG8_AT(cA, t + 1); \
            const char* a2 = last ? nA : PG8_AT(cA, t + 2); const char* b2 = last ? nB : cB + (size_t)(t + 2) * kstep; \
            const char* a3 = last ? nA + kstep : PG8_AT(cA, t + 3); const char* b3 = b2 + kstep; \
            PG8_LDB(B0, 0, 0); PG8_LDB(B1, 0, 1); PG8_SCHED; PG8_LDA(At, 0, 0); PG8_STAGE(PG8_SA(1, 1), a1 + hstepA, voffA); \
            PG8_WAIT_V(8); PG8_WAIT_L(0); PG8_BAR; PG8_MMA(0, 0, At, B0); PG8_MMA(0, 1, At, B1); PG8_BAR; PG8_SCHED; \
            PG8_LDA(At, 0, 1); PG8_STAGE(PG8_SB(0, 0), b2, voffB); PG8_STAGE(PG8_SB(0, 1), b2 + hstepB, voffB); PG8_STAGE(PG8_SA(0, 0), a2, voffA); \
            PG8_WAIT_V(8); PG8_WAIT_L(0); PG8_BAR; PG8_MMA(1, 0, At, B0); PG8_MMA(1, 1, At, B1); PG8_BAR; PG8_SCHED; \
            PG8_LDB(B0, 1, 0); PG8_LDB(B1, 1, 1); PG8_SCHED; PG8_LDA(At, 1, 0); PG8_STAGE(PG8_SA(0, 1), a2 + hstepA, voffA); \
            PG8_WAIT_V(8); PG8_WAIT_L(0); PG8_BAR; PG8_MMA(0, 0, At, B0); PG8_MMA(0, 1, At, B1); PG8_BAR; PG8_SCHED; \
            PG8_LDA(At, 1, 1); PG8_STAGE(PG8_SB(1, 0), b3, voffB); PG8_STAGE(PG8_SB(1, 1), b3 + hstepB, voffB); PG8_STAGE(PG8_SA(1, 0), a3, voffA); \
            PG8_WAIT_V(8); PG8_WAIT_L(0); PG8_BAR; PG8_MMA(1, 0, At, B0); PG8_MMA(1, 1, At, B1); PG8_BAR; PG8_SCHED; \
        }
        for (int t = 0; t < 8; t += 2) PG8_KBODY(t)
        E.hook(acc, cur, 0, wr, wc, fr, fq);
        for (int t = 8; t < 16; t += 2) PG8_KBODY(t)
        E.hook(acc, cur, 1, wr, wc, fr, fq);
        for (int t = 16; t < 24; t += 2) PG8_KBODY(t)
#undef PG8_KBODY
        if (wr == 0) PG8_BAR;
        E(acc, cur, wr, wc, fr, fq, lds);
        if (!has_next) break;
#pragma unroll
        for (int a = 0; a < 2; ++a)
#pragma unroll
            for (int b = 0; b < 2; ++b)
#pragma unroll
                for (int m = 0; m < 4; ++m)
#pragma unroll
                    for (int n = 0; n < 2; ++n) acc[a][b][m][n] = (f32x4){0.f, 0.f, 0.f, 0.f};
        cur = nxt; cA = nA; cB = nB; ++ui;
        if (wr == 1) PG8_BAR;
    }
    PG8_WAIT_V(0);
    PG8_BAR;
#undef PG8_AT
#undef PG8_SA
#undef PG8_SB
#undef PG8_STAGE
#undef PG8_LDA
#undef PG8_LDB
#undef PG8_MMA
#undef PG8_WAIT_V
#undef PG8_WAIT_L
#undef PG8_BAR
#undef PG8_SCHED
}

struct EpiMerge3 {
    static constexpr bool PERM = true;
    const bf16_t* gates; bf16_t* O;
    static __device__ __forceinline__ float cl(float g) { return fmaxf(g, 1e-30f); }
    __device__ __forceinline__ void hook(f32x4 (&acc)[2][2][4][2], const Unit& u, int seam, int wr, int wc, int fr, int fq) const {
        const int row0 = vlaunder(u.pm * BM + wr * 64 + fr), col0 = vlaunder(u.pn * BM + wc * 32 + 8 * fq);
#pragma unroll
        for (int ai = 0; ai < 2; ++ai) {
            u32x4 ga[4][2], gb[4][2];
#pragma unroll
            for (int m = 0; m < 4; ++m)
#pragma unroll
                for (int bj = 0; bj < 2; ++bj) { const bf16_t* gp = gates + (size_t)(row0 + ai * HALF + m * 16) * 3072 + seam * 1024 + col0 + bj * HALF; ga[m][bj] = *(const u32x4*)gp; gb[m][bj] = *(const u32x4*)(gp + 1024); }
#pragma unroll
            for (int m = 0; m < 4; ++m)
#pragma unroll
                for (int bj = 0; bj < 2; ++bj) { const u32x4 a = ga[m][bj], b = gb[m][bj];
                    acc[ai][bj][m][0][0] *= cl(bflo(a.x)) * rcpf_(cl(bflo(b.x))); acc[ai][bj][m][0][1] *= cl(bfhi(a.x)) * rcpf_(cl(bfhi(b.x)));
                    acc[ai][bj][m][0][2] *= cl(bflo(a.y)) * rcpf_(cl(bflo(b.y))); acc[ai][bj][m][0][3] *= cl(bfhi(a.y)) * rcpf_(cl(bfhi(b.y)));
                    acc[ai][bj][m][1][0] *= cl(bflo(a.z)) * rcpf_(cl(bflo(b.z))); acc[ai][bj][m][1][1] *= cl(bfhi(a.z)) * rcpf_(cl(bfhi(b.z)));
                    acc[ai][bj][m][1][2] *= cl(bflo(a.w)) * rcpf_(cl(bflo(b.w))); acc[ai][bj][m][1][3] *= cl(bfhi(a.w)) * rcpf_(cl(bfhi(b.w))); }
            asm volatile("" ::: "memory");
        }
    }
    __device__ __forceinline__ void operator()(f32x4 (&acc)[2][2][4][2], const Unit& u, int wr, int wc, int fr, int fq, LAS unsigned char*) const {
        const int row0 = vlaunder(u.pm * BM + wr * 64 + fr), col0 = vlaunder(u.pn * BM + wc * 32 + 8 * fq);
#pragma unroll
        for (int ai = 0; ai < 2; ++ai) {
            u32x4 gc[4][2];
#pragma unroll
            for (int m = 0; m < 4; ++m)
#pragma unroll
                for (int bj = 0; bj < 2; ++bj) gc[m][bj] = *(const u32x4*)(gates + (size_t)(row0 + ai * HALF + m * 16) * 3072 + 2048 + col0 + bj * HALF);
#pragma unroll
            for (int m = 0; m < 4; ++m)
#pragma unroll
                for (int bj = 0; bj < 2; ++bj) { const u32x4 c = gc[m][bj]; const f32x4 v0 = acc[ai][bj][m][0], v1 = acc[ai][bj][m][1];
                    u32x4 w; w.x = cvt_pk_bf16(v0[0] * cl(bflo(c.x)), v0[1] * cl(bfhi(c.x))); w.y = cvt_pk_bf16(v0[2] * cl(bflo(c.y)), v0[3] * cl(bfhi(c.y)));
                    w.z = cvt_pk_bf16(v1[0] * cl(bflo(c.z)), v1[1] * cl(bfhi(c.z))); w.w = cvt_pk_bf16(v1[2] * cl(bflo(c.w)), v1[3] * cl(bfhi(c.w)));
                    *(u32x4*)(O + (size_t)(row0 + ai * HALF + m * 16) * 1024 + col0 + bj * HALF) = w; }
            asm volatile("" ::: "memory");
        }
    }
};
}

__device__ __forceinline__ void transpose_item(const float* W, int ldsrc, int k0, int nsrc0, bf16_t* WT, int K, int ndst0, LAS float* scr, int lane) {
    float wv[32];
#pragma unroll
    for (int i = 0; i < 32; ++i) wv[i] = W[(size_t)(k0 + 2 * i + (lane >> 5)) * ldsrc + nsrc0 + (lane & 31)];
#pragma unroll
    for (int i = 0; i < 32; ++i) scr[(2 * i + (lane >> 5)) * 33 + (lane & 31)] = wv[i];
    LDS_WAIT(); asm volatile("" ::: "memory");
    const int c = lane & 7;
#pragma unroll
    for (int j = 0; j < 4; ++j) { const int n = (lane >> 3) + 8 * j; const LAS float* s = scr + (8 * c) * 33 + n;
        u32x4 o; o.x = cvt_pk_bf16(s[0 * 33], s[1 * 33]); o.y = cvt_pk_bf16(s[2 * 33], s[3 * 33]); o.z = cvt_pk_bf16(s[4 * 33], s[5 * 33]); o.w = cvt_pk_bf16(s[6 * 33], s[7 * 33]);
        *(u32x4*)(WT + (size_t)(ndst0 + n) * K + k0 + 8 * c) = o; }
    LDS_WAIT(); asm volatile("" ::: "memory");
}
__device__ __forceinline__ void convert_weights(const Params& p, int l, LAS unsigned char* lds, int gw, int ngw, int wave, int lane) {
    lane = vlaunder(lane_id_());
    LAS float* scr = (LAS float*)(lds + wave * 16384);
    unsigned char* ws = launder(PP(ws));
    bf16_t* Win = (bf16_t*)(ws + WS_WIN); bf16_t* WP = (bf16_t*)(ws + WS_WP); bf16_t* WO = (bf16_t*)(ws + WS_WOUT); bf16_t* WU = (bf16_t*)(ws + WS_WUP); bf16_t* WD = (bf16_t*)(ws + WS_WDN);
    const float* w_in = launder(PP(w_in)) + (size_t)l * DM * INW;
    constexpr int I0 = 16 * 128, I1 = 16 * 96, I2 = 8 * 32, I5 = 16 * 32, I6 = 16 * 176, I7 = 44 * 32;
    constexpr int NITEMS = I0 + I1 + 3 * I2 + I5 + I6 + I7;
    for (int it = gw; it < NITEMS; it += ngw) {
        int r = it;
        if (r < I0) { const int kb = r / 128, nb = r % 128; transpose_item(w_in, INW, 64 * kb, 32 * nb, Win, 1024, 32 * nb, scr, lane); continue; } r -= I0;
        if (r < I1) { const int kb = r / 96, nb = r % 96; transpose_item(w_in, INW, 64 * kb, 4112 + 32 * nb, Win, 1024, 4352 + 32 * nb, scr, lane); continue; } r -= I1;
        if (r < 3 * I2) { const int br = r / I2, q = r % I2, kb = q / 32, nb = q % 32;
            const float* src = launder(br == 0 ? PP(p_a) : (br == 1 ? PP(p_b) : PP(p_c))) + (size_t)l * 512 * 1024;
            transpose_item(src, 1024, 64 * kb, 32 * nb, WP + 512 * br, 1536, 32 * nb, scr, lane); continue; } r -= 3 * I2;
        if (r < I5) { const int kb = r / 32, nb = r % 32; transpose_item(launder(PP(w_out)) + (size_t)l * 1024 * 1024, 1024, 64 * kb, 32 * nb, WO, 1024, 32 * nb, scr, lane); continue; } r -= I5;
        if (r < I6) { const int kb = r / 176, nb = r % 176, j = nb >> 3, half = (nb >> 2) & 1, q = nb & 3;
            transpose_item(launder(PP(ffn_w_up)) + (size_t)l * 1024 * DFF2, DFF2, 64 * kb, DFF * half + 128 * j + 32 * q, WU, 1024, 256 * j + 128 * half + 32 * q, scr, lane); continue; } r -= I6;
        { const int kb = r / 32, nb = r % 32; transpose_item(launder(PP(ffn_w_down)) + (size_t)l * DFF * 1024, 1024, 64 * kb, 32 * nb, WD, DFF, 32 * nb, scr, lane); }
    }
    for (int idx = gw * 64 + lane; idx < 256 * 1024; idx += ngw * 64) { const int n = idx >> 10, k = idx & 1023;
        const float v = (n < 16) ? w_in[(size_t)k * INW + 4096 + n] : 0.f; Win[(size_t)(4096 + n) * 1024 + k] = f2bf(v); }
}

template <bool HAS_Y, bool HAS_OUT, bool HAS_XN>
__device__ __forceinline__ void row_phase(const float* hin, const bf16_t* y, const float* gpost, float* hout, const float* gpre, bf16_t* xn, int gw, int ngw, int lane) {
    hin = launder(hin); y = launder(y); hout = launder(hout); xn = launder(xn); gpost = launder(gpost); gpre = launder(gpre); lane = vlaunder(lane_id_());
    for (int m0 = gw; m0 < MTOK; m0 += 2 * ngw) {
        f32x4 v[2][4]; u32x2 yw[2][4];
#pragma unroll
        for (int rr_ = 0; rr_ < 2; ++rr_) { const int m = m0 + rr_ * ngw; const f32x4* hr = (const f32x4*)(hin + (size_t)m * DM) + lane;
#pragma unroll
            for (int j = 0; j < 4; ++j) v[rr_][j] = hr[64 * j];
            if (HAS_Y) { const u32x2* yr = (const u32x2*)(y + (size_t)m * DM) + lane;
#pragma unroll
                for (int j = 0; j < 4; ++j) yw[rr_][j] = yr[64 * j]; } }
#pragma unroll
        for (int rr_ = 0; rr_ < 2; ++rr_) {
            const int m = m0 + rr_ * ngw;
            if (HAS_Y) {
                f32x4 yv[4]; float s = 0.f;
#pragma unroll
                for (int j = 0; j < 4; ++j) { yv[j] = (f32x4){bflo(yw[rr_][j].x), bfhi(yw[rr_][j].x), bflo(yw[rr_][j].y), bfhi(yw[rr_][j].y)}; s += (yv[j].x * yv[j].x + yv[j].y * yv[j].y) + (yv[j].z * yv[j].z + yv[j].w * yv[j].w); }
                const float r = __builtin_amdgcn_rsqf(wave_sum(s) * (1.f / DM) + EPS);
#pragma unroll
                for (int j = 0; j < 4; ++j) { const f32x4 gp = *((const f32x4*)gpost + lane + 64 * j); v[rr_][j] += yv[j] * r * gp; }
            }
            if (HAS_OUT) { f32x4* ho = (f32x4*)(hout + (size_t)m * DM) + lane;
#pragma unroll
                for (int j = 0; j < 4; ++j) ho[64 * j] = v[rr_][j]; }
            if (HAS_XN) {
                float s = 0.f;
#pragma unroll
                for (int j = 0; j < 4; ++j) s += (v[rr_][j].x * v[rr_][j].x + v[rr_][j].y * v[rr_][j].y) + (v[rr_][j].z * v[rr_][j].z + v[rr_][j].w * v[rr_][j].w);
                const float r = __builtin_amdgcn_rsqf(wave_sum(s) * (1.f / DM) + EPS);
                u32x2* xo = (u32x2*)(xn + (size_t)m * DM) + lane;
#pragma unroll
                for (int j = 0; j < 4; ++j) { const f32x4 g = *((const f32x4*)gpre + lane + 64 * j); const f32x4 o = v[rr_][j] * r * g; u32x2 w; w.x = cvt_pk_bf16(o.x, o.y); w.y = cvt_pk_bf16(o.z, o.w); xo[64 * j] = w; }
            }
        }
    }
}

__device__ __forceinline__ void sb_phase(LAS unsigned char* lds, unsigned char* ws, int tid, int wave, int lane, size_t dst_off = WS_QA) {
    ws = launder(ws); tid = vlaunder(wave * 64 + lane_id_()); lane = tid & 63;
    bf16_t* QA = (bf16_t*)(ws + WS_QA); bf16_t* YA = (bf16_t*)(ws + dst_off); const bf16_t* KA = (const bf16_t*)(ws + WS_KA); const bf16_t* VA = (const bf16_t*)(ws + WS_VA);
    LAS bf16_t* sK = (LAS bf16_t*)lds;
    LAS bf16_t* sVt = (LAS bf16_t*)(lds + 9216);
    const int r = lane & 15, g = lane >> 4;
    for (int u = blockIdx.x; u < BATCH * 8 * 32; u += gridDim.x) {
        const int b = u >> 8, h = (u >> 5) & 7, qb = u & 31;
        const int tq0 = qb * 128 + wave * 16, t = tq0 + r;
        const size_t rowbase = (size_t)b * SEQ;
        bf16x8 qf[2];
#pragma unroll
        for (int ks = 0; ks < 2; ++ks) qf[ks] = *(const bf16x8*)(QA + (rowbase + t) * 512 + h * 64 + 32 * ks + 8 * g);
        f32x4 o[4];
#pragma unroll
        for (int i = 0; i < 4; ++i) o[i] = (f32x4){0.f, 0.f, 0.f, 0.f};
        float carry = 0.f;
        const int skey = tid >> 3, sch = tid & 7;
        u32x4 kv, vv;
        { const size_t goff = (rowbase + (qb * 2 + 1) * 64 + skey) * 512 + h * 64 + 8 * sch; kv = *(const u32x4*)(KA + goff); vv = *(const u32x4*)(VA + goff); }
        for (int kt = qb * 2 + 1; kt >= 0; --kt) {
            {
                const int key = skey, ch = sch;
                *(LAS u32x4*)(sK + key * 72 + 8 * ch) = kv;
                LAS bf16_t* vd = sVt + (8 * ch) * 68 + key;
                vd[0 * 68] = (bf16_t)(vv.x & 0xffff); vd[1 * 68] = (bf16_t)(vv.x >> 16); vd[2 * 68] = (bf16_t)(vv.y & 0xffff); vd[3 * 68] = (bf16_t)(vv.y >> 16);
                vd[4 * 68] = (bf16_t)(vv.z & 0xffff); vd[5 * 68] = (bf16_t)(vv.z >> 16); vd[6 * 68] = (bf16_t)(vv.w & 0xffff); vd[7 * 68] = (bf16_t)(vv.w >> 16);
            }
            __syncthreads();
            if (kt > 0) { const size_t goff = (rowbase + (kt - 1) * 64 + skey) * 512 + h * 64 + 8 * sch; kv = *(const u32x4*)(KA + goff); vv = *(const u32x4*)(VA + goff); }
            const bool wdone = __all(carry < SB_THR);
            const bool active = (kt * 64) < (tq0 + 15) && !wdone;
            if (active) {
                f32x4 s[4];
#pragma unroll
                for (int kb = 0; kb < 4; ++kb) { s[kb] = (f32x4){0.f, 0.f, 0.f, 0.f};
#pragma unroll
                    for (int ks = 0; ks < 2; ++ks) { const bf16x8 a = *(const LAS bf16x8*)(sK + (16 * kb + r) * 72 + 32 * ks + 8 * g); s[kb] = mfma16(a, qf[ks], s[kb]); } }
                f32x4 w[4];
                const float zs = 0.125f * 1.4426950409f;
                if (kt * 64 + 63 < tq0) {
#pragma unroll
                    for (int kb = 3; kb >= 0; --kb) {
                        float l[4], ls[4];
#pragma unroll
                        for (int j = 0; j < 4; ++j) { const float z = s[kb][j] * zs; const float lsz = logsig2_f(z); ls[j] = lsz; l[j] = lsz - z; }
                        const float sg = (l[0] + l[1]) + (l[2] + l[3]);
                        const float a_ = __shfl_xor(sg, 16); const float b_ = sg + a_; const float c_ = __shfl_xor(b_, 32);
                        const float suf = ((g & 1) == 0 ? a_ : 0.f) + ((g & 2) == 0 ? c_ : 0.f);
                        const float t3 = carry + suf, t2 = t3 + l[3], t1 = t2 + l[2], t0 = t1 + l[1];
                        w[kb][0] = __builtin_amdgcn_exp2f(ls[0] + t0); w[kb][1] = __builtin_amdgcn_exp2f(ls[1] + t1);
                        w[kb][2] = __builtin_amdgcn_exp2f(ls[2] + t2); w[kb][3] = __builtin_amdgcn_exp2f(ls[3] + t3);
                        carry += b_ + c_;
                    }
                } else {
#pragma unroll
                    for (int kb = 3; kb >= 0; --kb) {
                        float l[4], ls[4]; bool mk[4];
#pragma unroll
                        for (int j = 0; j < 4; ++j) { const int key = kt * 64 + 16 * kb + 4 * g + j; const float z = s[kb][j] * zs; mk[j] = key < t;
                            const float lsz = logsig2_f(z); ls[j] = lsz; l[j] = mk[j] ? (lsz - z) : 0.f; }
                        const float sg = (l[0] + l[1]) + (l[2] + l[3]);
                        const float a_ = __shfl_xor(sg, 16); const float b_ = sg + a_; const float c_ = __shfl_xor(b_, 32);
                        const float suf = ((g & 1) == 0 ? a_ : 0.f) + ((g & 2) == 0 ? c_ : 0.f);
                        const float t3 = carry + suf, t2 = t3 + l[3], t1 = t2 + l[2], t0 = t1 + l[1];
                        w[kb][0] = mk[0] ? __builtin_amdgcn_exp2f(ls[0] + t0) : 0.f; w[kb][1] = mk[1] ? __builtin_amdgcn_exp2f(ls[1] + t1) : 0.f;
                        w[kb][2] = mk[2] ? __builtin_amdgcn_exp2f(ls[2] + t2) : 0.f; w[kb][3] = mk[3] ? __builtin_amdgcn_exp2f(ls[3] + t3) : 0.f;
                        carry += b_ + c_;
                    }
                }
#pragma unroll
                for (int sI = 0; sI < 2; ++sI) {
                    const bf16x8 pb = pack8(w[2 * sI], w[2 * sI + 1]);
#pragma unroll
                    for (int dvb = 0; dvb < 4; ++dvb) {
                        const LAS bf16_t* vp = sVt + (16 * dvb + r) * 68 + 32 * sI + 4 * g;
                        const u32x2 lo = *(const LAS u32x2*)vp, hi = *(const LAS u32x2*)(vp + 16);
                        u32x4 av; av.x = lo.x; av.y = lo.y; av.z = hi.x; av.w = hi.y;
                        o[dvb] = mfma16(__builtin_bit_cast(bf16x8, av), pb, o[dvb]);
                    }
                }
            }
            const int done = __all(carry < SB_THR) ? 1 : 0;
            if (__syncthreads_and(done)) break;
        }
#pragma unroll
        for (int dvb = 0; dvb < 4; ++dvb) { u32x2 w2; w2.x = cvt_pk_bf16(o[dvb][0], o[dvb][1]); w2.y = cvt_pk_bf16(o[dvb][2], o[dvb][3]);
            *(u32x2*)(YA + (rowbase + t) * 512 + h * 64 + 16 * dvb + 4 * g) = w2; }
        __syncthreads();
    }
}

__device__ __forceinline__ void sg_phase(LAS unsigned char* lds, const Params& p, int l, int tid, int wave, int lane) {
    unsigned char* ws = launder(PP(ws)); tid = vlaunder(wave * 64 + lane_id_()); lane = tid & 63;
    bf16_t* U = (bf16_t*)(ws + WS_U); const bf16_t* SV = (const bf16_t*)(ws + WS_SV);
    LAS bf16_t* sVn = (LAS bf16_t*)(lds + wave * (64 * 136 * 2));
    LAS float* sSt = (LAS float*)(lds + 8 * 64 * 136 * 2);
    const int r = lane & 15, gq = lane >> 4;
    const float* lng = launder(PP(sg_ln_g)) + l * 512; const float* lnb = launder(PP(sg_ln_b)) + l * 512;
    const float* W = launder(PP(sg_w)) + ((size_t)(l * 8 + wave)) * 128 * 128;
    const float* Bs = launder(PP(sg_b)) + (l * 8 + wave) * 128;
    for (int u = blockIdx.x; u < BATCH * 32; u += gridDim.x) {
        const size_t row0 = (size_t)u * 128;
        {
            const int tok = wave * 16 + (lane >> 2);
            const u32x4* sp = (const u32x4*)(SV + (row0 + tok) * 512 + (lane & 3) * 128);
            u32x4 vv[16];
#pragma unroll
            for (int c = 0; c < 16; ++c) vv[c] = sp[c];
            float s = 0.f;
#pragma unroll
            for (int c = 0; c < 16; ++c) s += ((bflo(vv[c].x) + bfhi(vv[c].x)) + (bflo(vv[c].y) + bfhi(vv[c].y))) + ((bflo(vv[c].z) + bfhi(vv[c].z)) + (bflo(vv[c].w) + bfhi(vv[c].w)));
            s += __shfl_xor(s, 1); s += __shfl_xor(s, 2);
            const float mu = s * (1.f / 512.f);
            float q = 0.f;
#pragma unroll
            for (int c = 0; c < 16; ++c) { const float x[8] = {bflo(vv[c].x), bfhi(vv[c].x), bflo(vv[c].y), bfhi(vv[c].y), bflo(vv[c].z), bfhi(vv[c].z), bflo(vv[c].w), bfhi(vv[c].w)};
#pragma unroll
                for (int e = 0; e < 8; ++e) { const float d = x[e] - mu; q += d * d; } }
            q += __shfl_xor(q, 1); q += __shfl_xor(q, 2);
            const float rs = __builtin_amdgcn_rsqf(q * (1.f / 512.f) + EPS);
            if ((lane & 3) == 0) { sSt[tok * 2] = mu; sSt[tok * 2 + 1] = rs; }
        }
        __syncthreads();
#pragma unroll
        for (int i = 0; i < 2; ++i) {
            const int s = lane + 64 * i; const float mu = sSt[s * 2], rs = sSt[s * 2 + 1];
#pragma unroll
            for (int c = 0; c < 8; ++c) {
                const u32x4 vv = *(const u32x4*)(SV + (row0 + s) * 512 + wave * 64 + 8 * c);
                const float x[8] = {bflo(vv.x), bfhi(vv.x), bflo(vv.y), bfhi(vv.y), bflo(vv.z), bfhi(vv.z), bflo(vv.w), bfhi(vv.w)};
                const f32x4 g0 = *(const f32x4*)(lng + wave * 64 + 8 * c), g1 = *(const f32x4*)(lng + wave * 64 + 8 * c + 4);
                const f32x4 b0 = *(const f32x4*)(lnb + wave * 64 + 8 * c), b1 = *(const f32x4*)(lnb + wave * 64 + 8 * c + 4);
#pragma unroll
                for (int e = 0; e < 8; ++e) { const float gg = e < 4 ? g0[e & 3] : g1[e & 3], bb = e < 4 ? b0[e & 3] : b1[e & 3];
                    sVn[(8 * c + e) * 136 + s] = f2bf((x[e] - mu) * rs * gg + bb); }
            }
        }
        __syncthreads();
        {
            f32x4 acc[8][4];
#pragma unroll
            for (int tb = 0; tb < 8; ++tb)
#pragma unroll
                for (int i = 0; i < 4; ++i) acc[tb][i] = (f32x4){0.f, 0.f, 0.f, 0.f};
#pragma unroll
            for (int ks = 0; ks < 4; ++ks) {
                const int s0 = 32 * ks + 8 * gq;
                bf16x8 bb[4];
#pragma unroll
                for (int db = 0; db < 4; ++db) bb[db] = *(const LAS bf16x8*)(sVn + (16 * db + r) * 136 + s0);
#pragma unroll
                for (int tb = 2 * ks; tb < 8; ++tb) {
                    const int t = 16 * tb + r;
                    f32x4 w0 = *(const f32x4*)(W + t * 128 + s0), w1 = *(const f32x4*)(W + t * 128 + s0 + 4);
#pragma unroll
                    for (int e = 0; e < 4; ++e) { if (s0 + e > t) w0[e] = 0.f; if (s0 + 4 + e > t) w1[e] = 0.f; }
                    const bf16x8 a = pack8(w0, w1);
#pragma unroll
                    for (int db = 0; db < 4; ++db) acc[tb][db] = mfma16(a, bb[db], acc[tb][db]);
                }
            }
#pragma unroll
            for (int tb = 0; tb < 8; ++tb) {
                bf16_t uu[4][4];
#pragma unroll
                for (int j = 0; j < 4; ++j)
#pragma unroll
                    for (int db = 0; db < 4; ++db) uu[j][db] = U[(row0 + 16 * tb + 4 * gq + j) * 512 + wave * 64 + 16 * db + r];
#pragma unroll
                for (int j = 0; j < 4; ++j) { const int tt = 16 * tb + 4 * gq + j; const float bsv = Bs[tt];
#pragma unroll
                    for (int db = 0; db < 4; ++db) U[(row0 + tt) * 512 + wave * 64 + 16 * db + r] = f2bf(bf2f(uu[j][db]) * (acc[tb][db][j] + bsv)); }
            }
        }
        __syncthreads();
    }
}

template <bool PASS_C>
__device__ __forceinline__ void gla_phase(LAS unsigned char* lds, const Params& p, int l, int tid, int wave, int lane) {
    unsigned char* ws = launder(PP(ws)); tid = vlaunder(wave * 64 + lane_id_()); lane = tid & 63;
    const bf16_t* GQ = (const bf16_t*)(ws + WS_GQ); const bf16_t* GK = (const bf16_t*)(ws + WS_GK); const bf16_t* GV = (const bf16_t*)(ws + WS_GV);
    bf16_t* GR = (bf16_t*)(ws + WS_GR); const float* GD = (const float*)(ws + WS_GDOWN); float* UPD = (float*)(ws + WS_UPD); float* DEC = (float*)(ws + WS_DEC);
    LAS float* sCum = (LAS float*)lds;
    LAS float* sTot = (LAS float*)(lds + 16384);
    LAS bf16_t* sQD = (LAS bf16_t*)(lds + 18432);
    LAS bf16_t* sKI = (LAS bf16_t*)(lds + 27648);
    LAS bf16_t* sKEt = (LAS bf16_t*)(lds + 36864);
    LAS bf16_t* sVt = (LAS bf16_t*)(lds + 46080);
    LAS bf16_t* sAT = (LAS bf16_t*)(lds + 64512);
    LAS bf16_t* sSt = (LAS bf16_t*)(lds + 73728);
    LAS float* sSS = (LAS float*)(lds + 92160);
    const int r = lane & 15, gq = lane >> 4;
    const float* wgup = launder(PP(gla_w_gup)) + l * 16 * 256; const float* bgate = launder(PP(gla_b_gate)) + l * 256; const float* ng = launder(PP(gla_norm_g)) + l * 128;
    for (int u = blockIdx.x; u < BATCH * 4 * 64; u += gridDim.x) {
        const int b = u >> 8, h = (u >> 6) & 3, n = u & 63;
        const size_t r0 = (size_t)b * SEQ + n * 64;
        const int t_ = tid >> 3, k8 = (tid & 7) * 8;
        const u32x4 kw = *(const u32x4*)(GK + (r0 + t_) * 256 + h * 64 + k8);
        const u32x4 gv0 = *(const u32x4*)(GV + (r0 + (tid >> 3)) * 512 + h * 128 + 16 * (tid & 7)), gv1 = *(const u32x4*)(GV + (r0 + (tid >> 3)) * 512 + h * 128 + 16 * (tid & 7) + 8);
        u32x4 qw = (u32x4){0u, 0u, 0u, 0u}; f32x4 st0 = (f32x4){0.f, 0.f, 0.f, 0.f}, st1 = st0, st2 = st0, st3 = st0; bf16_t gg[4][4];
        if (PASS_C) {
            qw = *(const u32x4*)(GQ + (r0 + t_) * 256 + h * 64 + k8);
            const f32x4* sp = (const f32x4*)(UPD + ((size_t)u * 128 + (tid >> 2)) * 64 + (tid & 3) * 16); st0 = sp[0]; st1 = sp[1]; st2 = sp[2]; st3 = sp[3];
#pragma unroll
            for (int j = 0; j < 4; ++j)
#pragma unroll
                for (int i = 0; i < 4; ++i) gg[j][i] = GR[(r0 + 16 * (wave & 3) + 4 * gq + j) * 512 + h * 128 + 16 * (4 * (wave >> 2) + i) + r];
        }
        {
            const f32x4* gdp = (const f32x4*)(GD + (r0 + t_) * 16);
            const f32x4 g0 = gdp[0], g1 = gdp[1], g2 = gdp[2], g3 = gdp[3];
            const float gd[16] = {g0[0], g0[1], g0[2], g0[3], g1[0], g1[1], g1[2], g1[3], g2[0], g2[1], g2[2], g2[3], g3[0], g3[1], g3[2], g3[3]};
            f32x4 a0 = *(const f32x4*)(bgate + h * 64 + k8), a1 = *(const f32x4*)(bgate + h * 64 + k8 + 4);
#pragma unroll
            for (int rr = 0; rr < 16; ++rr) { const f32x4 w0 = *(const f32x4*)(wgup + rr * 256 + h * 64 + k8), w1 = *(const f32x4*)(wgup + rr * 256 + h * 64 + k8 + 4); a0 += w0 * gd[rr]; a1 += w1 * gd[rr]; }
            f32x4 o0, o1;
#pragma unroll
            for (int e = 0; e < 4; ++e) { o0[e] = logsig_f(a0[e]) * 0.0625f; o1[e] = logsig_f(a1[e]) * 0.0625f; }
            *(LAS f32x4*)(sCum + t_ * 64 + k8) = o0; *(LAS f32x4*)(sCum + t_ * 64 + k8 + 4) = o1;
        }
        __syncthreads();
        {
            const int k = tid & 63, seg = tid >> 6; float run = 0.f;
#pragma unroll
            for (int i = 0; i < 8; ++i) { run += sCum[(8 * seg + i) * 64 + k]; sCum[(8 * seg + i) * 64 + k] = run; }
            sTot[seg * 64 + k] = run;
            __syncthreads();
            float pre = 0.f;
#pragma unroll
            for (int s = 0; s < 7; ++s) pre += (s < seg) ? sTot[s * 64 + k] : 0.f;
#pragma unroll
            for (int i = 0; i < 8; ++i) sCum[(8 * seg + i) * 64 + k] += pre;
        }
        __syncthreads();
        {
            const f32x4 c0 = *(const LAS f32x4*)(sCum + t_ * 64 + k8), c1 = *(const LAS f32x4*)(sCum + t_ * 64 + k8 + 4);
            const f32x4 e0 = *(const LAS f32x4*)(sCum + 63 * 64 + k8), e1 = *(const LAS f32x4*)(sCum + 63 * 64 + k8 + 4);
            const float kk[8] = {bflo(kw.x), bfhi(kw.x), bflo(kw.y), bfhi(kw.y), bflo(kw.z), bfhi(kw.z), bflo(kw.w), bfhi(kw.w)};
            const float cm[8] = {c0[0], c0[1], c0[2], c0[3], c1[0], c1[1], c1[2], c1[3]};
            const float ce[8] = {e0[0], e0[1], e0[2], e0[3], e1[0], e1[1], e1[2], e1[3]};
            if (PASS_C) {
                const float qq[8] = {bflo(qw.x), bfhi(qw.x), bflo(qw.y), bfhi(qw.y), bflo(qw.z), bfhi(qw.z), bflo(qw.w), bfhi(qw.w)};
                f32x4 qa, qb, ka, kb;
#pragma unroll
                for (int e = 0; e < 4; ++e) { qa[e] = qq[e] * 0.125f * __expf(cm[e]); qb[e] = qq[e + 4] * 0.125f * __expf(cm[e + 4]); ka[e] = kk[e] * __expf(-cm[e]); kb[e] = kk[e + 4] * __expf(-cm[e + 4]); }
                *(LAS bf16x8*)(sQD + t_ * 72 + k8) = pack8(qa, qb); *(LAS bf16x8*)(sKI + t_ * 72 + k8) = pack8(ka, kb);
                const int dv = tid >> 2, kq = (tid & 3) * 16;
                *(LAS bf16x8*)(sSt + dv * 72 + kq) = pack8(st0, st1); *(LAS bf16x8*)(sSt + dv * 72 + kq + 8) = pack8(st2, st3);
            } else {
#pragma unroll
                for (int e = 0; e < 8; ++e) sKEt[(k8 + e) * 72 + t_] = f2bf(kk[e] * __expf(ce[e] - cm[e]));
                if (t_ == 63) {
#pragma unroll
                    for (int e = 0; e < 8; ++e) DEC[(size_t)u * 64 + k8 + e] = __expf(ce[e]);
                }
            }
            const int s = tid >> 3, c = tid & 7;
            const u32x4 v0 = gv0, v1 = gv1;
            LAS bf16_t* vd = sVt + (16 * c) * 72 + s;
            vd[0 * 72] = (bf16_t)(v0.x & 0xffff); vd[1 * 72] = (bf16_t)(v0.x >> 16); vd[2 * 72] = (bf16_t)(v0.y & 0xffff); vd[3 * 72] = (bf16_t)(v0.y >> 16);
            vd[4 * 72] = (bf16_t)(v0.z & 0xffff); vd[5 * 72] = (bf16_t)(v0.z >> 16); vd[6 * 72] = (bf16_t)(v0.w & 0xffff); vd[7 * 72] = (bf16_t)(v0.w >> 16);
            vd[8 * 72] = (bf16_t)(v1.x & 0xffff); vd[9 * 72] = (bf16_t)(v1.x >> 16); vd[10 * 72] = (bf16_t)(v1.y & 0xffff); vd[11 * 72] = (bf16_t)(v1.y >> 16);
            vd[12 * 72] = (bf16_t)(v1.z & 0xffff); vd[13 * 72] = (bf16_t)(v1.z >> 16); vd[14 * 72] = (bf16_t)(v1.w & 0xffff); vd[15 * 72] = (bf16_t)(v1.w >> 16);
        }
        __syncthreads();
        if (!PASS_C) {
#pragma unroll
            for (int kb = 0; kb < 4; ++kb) { f32x4 acc = (f32x4){0.f, 0.f, 0.f, 0.f};
#pragma unroll
                for (int ks = 0; ks < 2; ++ks) { const bf16x8 a = *(const LAS bf16x8*)(sKEt + (16 * kb + r) * 72 + 32 * ks + 8 * gq); const bf16x8 bb = *(const LAS bf16x8*)(sVt + (16 * wave + r) * 72 + 32 * ks + 8 * gq); acc = mfma16(a, bb, acc); }
                *(f32x4*)(UPD + ((size_t)u * 128 + 16 * wave + r) * 64 + 16 * kb + 4 * gq) = acc; }
        } else {
            {
                const int tb = wave >> 1;
#pragma unroll
                for (int i = 0; i < 2; ++i) { const int sb = 2 * (wave & 1) + i;
                    f32x4 acc = (f32x4){0.f, 0.f, 0.f, 0.f};
                    if (sb <= tb) {
#pragma unroll
                        for (int ks = 0; ks < 2; ++ks) { const bf16x8 a = *(const LAS bf16x8*)(sQD + (16 * tb + r) * 72 + 32 * ks + 8 * gq); const bf16x8 bb = *(const LAS bf16x8*)(sKI + (16 * sb + r) * 72 + 32 * ks + 8 * gq); acc = mfma16(a, bb, acc); }
                    }
#pragma unroll
                    for (int j = 0; j < 4; ++j) { const int tt = 16 * tb + 4 * gq + j, ss = 16 * sb + r; sAT[tt * 72 + ss] = f2bf((sb <= tb && ss <= tt) ? acc[j] : 0.f); } }
            }
            __syncthreads();
            const int tb = wave & 3, hv = wave >> 2;
            f32x4 acc[4];
#pragma unroll
            for (int i = 0; i < 4; ++i) { acc[i] = (f32x4){0.f, 0.f, 0.f, 0.f}; const int dvb = 4 * hv + i;
#pragma unroll
                for (int ks = 0; ks < 2; ++ks) {
                    const bf16x8 a1 = *(const LAS bf16x8*)(sAT + (16 * tb + r) * 72 + 32 * ks + 8 * gq); const bf16x8 b1 = *(const LAS bf16x8*)(sVt + (16 * dvb + r) * 72 + 32 * ks + 8 * gq); acc[i] = mfma16(a1, b1, acc[i]);
                    const bf16x8 a2 = *(const LAS bf16x8*)(sQD + (16 * tb + r) * 72 + 32 * ks + 8 * gq); const bf16x8 b2 = *(const LAS bf16x8*)(sSt + (16 * dvb + r) * 72 + 32 * ks + 8 * gq); acc[i] = mfma16(a2, b2, acc[i]);
                } }
            float ss[4];
#pragma unroll
            for (int j = 0; j < 4; ++j) { float q = 0.f;
#pragma unroll
                for (int i = 0; i < 4; ++i) q += acc[i][j] * acc[i][j];
                q += __shfl_xor(q, 1); q += __shfl_xor(q, 2); q += __shfl_xor(q, 4); q += __shfl_xor(q, 8); ss[j] = q; }
            if (r == 0) {
#pragma unroll
                for (int j = 0; j < 4; ++j) sSS[hv * 64 + 16 * tb + 4 * gq + j] = ss[j];
            }
            __syncthreads();
#pragma unroll
            for (int j = 0; j < 4; ++j) { const int tt = 16 * tb + 4 * gq + j; const float rs = __builtin_amdgcn_rsqf((sSS[tt] + sSS[64 + tt]) * (1.f / 128.f) + EPS);
#pragma unroll
                for (int i = 0; i < 4; ++i) { const int dv = 16 * (4 * hv + i) + r; GR[(r0 + tt) * 512 + h * 128 + dv] = f2bf(acc[i][j] * rs * ng[dv] * bf2f(gg[j][i])); } }
        }
        __syncthreads();
    }
}
__device__ __forceinline__ void gla_scan(unsigned char* ws, int wave, int ngt) {
    ws = launder(ws); const int gtid = blockIdx.x * 512 + vlaunder(wave * 64 + lane_id_());
    float* UPD = (float*)(ws + WS_UPD); const float* DEC = (const float*)(ws + WS_DEC);
    for (int e = gtid; e < 32 * 8192; e += ngt) {
        const int bh = e >> 13, rem = e & 8191, dk = rem & 63; float S = 0.f;
#pragma unroll 1
        for (int n0 = 0; n0 < 64; n0 += 16) {
            float uv[16], dv[16];
#pragma unroll
            for (int i = 0; i < 16; ++i) { uv[i] = UPD[((size_t)(bh * 64 + n0 + i)) * 8192 + rem]; dv[i] = DEC[(bh * 64 + n0 + i) * 64 + dk]; }
#pragma unroll
            for (int i = 0; i < 16; ++i) { UPD[((size_t)(bh * 64 + n0 + i)) * 8192 + rem] = S; S = dv[i] * S + uv[i]; }
        }
    }
}
__device__ __forceinline__ void conv_fix(const Params& p, int l, int wave, int ngt) {
    unsigned char* ws = launder(PP(ws)); const int gtid = blockIdx.x * 512 + vlaunder(wave * 64 + lane_id_());
    const float* head = (const float*)(ws + WS_HEAD); const float* tail = (const float*)(ws + WS_TAIL); bf16_t* act = (bf16_t*)(ws + WS_ACT);
    const float* cw = launder(PP(ffn_conv_w)) + (size_t)l * 3 * DFF2; const float* cb = launder(PP(ffn_conv_b)) + (size_t)l * DFF2;
    for (int e = gtid; e < 128 * DFF; e += ngt) {
        const int pm = e / DFF, c = e % DFF, j = c >> 7, cc = c & 127; const int pa = 256 * j + cc, pu = pa + 128;
        const bool first = (pm & 15) == 0;
        const float ta0 = first ? 0.f : tail[((size_t)(pm - 1) * 2 + 0) * DFF2 + pa], ta1 = first ? 0.f : tail[((size_t)(pm - 1) * 2 + 1) * DFF2 + pa];
        const float tu0 = first ? 0.f : tail[((size_t)(pm - 1) * 2 + 0) * DFF2 + pu], tu1 = first ? 0.f : tail[((size_t)(pm - 1) * 2 + 1) * DFF2 + pu];
        const float ha0 = head[((size_t)pm * 2 + 0) * DFF2 + pa], ha1 = head[((size_t)pm * 2 + 1) * DFF2 + pa];
        const float hu0 = head[((size_t)pm * 2 + 0) * DFF2 + pu], hu1 = head[((size_t)pm * 2 + 1) * DFF2 + pu];
        const float wa0 = cw[c], wa1 = cw[DFF2 + c], wa2 = cw[2 * DFF2 + c], ba = cb[c];
        const float wu0 = cw[DFF + c], wu1 = cw[DFF2 + DFF + c], wu2 = cw[2 * DFF2 + DFF + c], bu = cb[DFF + c];
        const float ca0 = ba + wa0 * ta0 + wa1 * ta1 + wa2 * ha0, cu0 = bu + wu0 * tu0 + wu1 * tu1 + wu2 * hu0;
        const float ca1 = ba + wa0 * ta1 + wa1 * ha0 + wa2 * ha1, cu1 = bu + wu0 * tu1 + wu1 * hu0 + wu2 * hu1;
        act[((size_t)pm * 256 + 0) * DFF + c] = f2bf(gelu_tanh_f(ca0) * cu0);
        act[((size_t)pm * 256 + 1) * DFF + c] = f2bf(gelu_tanh_f(ca1) * cu1);
    }
}

#define XB_TMO      128
#define XB_XCNT(j)  (256  + 64 * (j))
#define XB_XSUB(j)  (1280 + 64 * (j))
#define XB_XGEN(j)  (2304 + 64 * (j))
#define XB_TOP      3328
#define XB_TOPGEN   3392
#define XCD_BAR_WORDS 3456
#define XB_SPIN_CAP (1u << 18)

__device__ __forceinline__ unsigned xb_ld(unsigned* p)              { return __hip_atomic_load(p, __ATOMIC_RELAXED, __HIP_MEMORY_SCOPE_AGENT); }
__device__ __forceinline__ unsigned xb_add(unsigned* p, unsigned v) { return __hip_atomic_fetch_add(p, v, __ATOMIC_RELAXED, __HIP_MEMORY_SCOPE_AGENT); }
__device__ __forceinline__ unsigned xb_xcc_id() { return (unsigned)__builtin_amdgcn_s_getreg((3 << 11) | 20) & 0xFu; }
#define XB_SPIN(cond, bar) do { unsigned _sp = 0; while (cond) { __builtin_amdgcn_s_sleep(1); \
    if ((++_sp & 255u) == 0u) { if (xb_ld(&(bar)[XB_TMO])) break; if (_sp > XB_SPIN_CAP) { atomicAdd(&(bar)[XB_TMO], 1u); break; } } } } while (0)

struct XcdBarrier {
    unsigned* bar; unsigned x;
    volatile LAS unsigned* st;
};

__device__ __forceinline__ XcdBarrier xcd_barrier_post(unsigned* bar, volatile LAS unsigned* st, int wave_) {
    XcdBarrier b; b.bar = bar; b.x = xb_xcc_id(); b.st = st;
    if (wave_ == 0 && lane_id_() == 0) (void)xb_add(&bar[XB_XCNT(b.x)], 1u);
    return b;
}
__device__ __forceinline__ void xcd_barrier_complete(unsigned* bar, unsigned x, unsigned& nloc, unsigned& nx) {
    const unsigned G = gridDim.x * gridDim.y * gridDim.z;
    unsigned sum, cnt, mine, sp = 0u;
    for (;;) {
        sum = 0u; cnt = 0u; mine = 0u;
#pragma unroll
        for (unsigned j = 0; j < 16; ++j) { const unsigned c = xb_ld(&bar[XB_XCNT(j)]); sum += c; cnt += (c > 0u) ? 1u : 0u; mine = (j == x) ? c : mine; }
        if (sum == G) break;
        __builtin_amdgcn_s_sleep(1);
        if ((++sp & 255u) == 0u) { if (xb_ld(&bar[XB_TMO])) break; if (sp > XB_SPIN_CAP) { atomicAdd(&bar[XB_TMO], 1u); break; } }
    }
    nloc = mine > 0u ? mine : 1u; nx = cnt > 0u ? cnt : 1u;
}

__device__ __forceinline__ void xcd_barrier(const XcdBarrier& b, int wave_) {
    asm volatile("s_waitcnt vmcnt(0)" ::: "memory");
    __syncthreads();
    if (wave_ == 0 && lane_id_() == 0) {
        unsigned* bar = b.bar;
        __builtin_amdgcn_s_waitcnt(0);
        unsigned nloc = b.st[0], nx = b.st[1];
        if (nloc == 0u) { xcd_barrier_complete(bar, b.x, nloc, nx); b.st[0] = nloc; b.st[1] = nx; }
        const unsigned old = xb_add(&bar[XB_XSUB(b.x)], 1u);
        const unsigned gen = old / nloc;
        if (old + 1u == (gen + 1u) * nloc) {
            __builtin_amdgcn_fence(__ATOMIC_RELEASE, "agent");
            asm volatile("s_waitcnt vmcnt(0)" ::: "memory");
            const unsigned og = xb_add(&bar[XB_TOP], 1u);
            const unsigned tg = og / nx;
            if (og + 1u == (tg + 1u) * nx) xb_add(&bar[XB_TOPGEN], 1u);
            else XB_SPIN(xb_ld(&bar[XB_TOPGEN]) == tg, bar);
            __builtin_amdgcn_fence(__ATOMIC_ACQUIRE, "agent");
            xb_add(&bar[XB_XGEN(b.x)], 1u);
            asm volatile("s_waitcnt vmcnt(0)" ::: "memory");
        } else {
            XB_SPIN(xb_ld(&bar[XB_XGEN(b.x)]) == gen, bar);
            __builtin_amdgcn_fence(__ATOMIC_ACQUIRE, "agent");
            asm volatile("s_waitcnt vmcnt(0)" ::: "memory");
        }
    }
    __syncthreads();
}
#define CG_SYNC() do { asm volatile("s_waitcnt vmcnt(0) lgkmcnt(0)" ::: "memory"); grid.sync(); } while (0)
#define GRID_SYNC() do { for (int rs_ = 0; rs_ < REP_SYNC; ++rs_) { xcd_barrier(xbar, wave); } } while (0)
#define TSTAMP(k) do { if (TS_PHASE >= 0) { const unsigned long long now_ = __builtin_amdgcn_s_memrealtime(); if ((k) == TS_PHASE) tsel += now_ - tprev; tprev = now_; } } while (0)
#ifndef DBG_STOP
#define DBG_STOP 0
#endif
#ifndef REP_GEMM
#define REP_GEMM 1
#endif
#ifndef REP_SYNC
#define REP_SYNC 1
#endif
#ifndef PROBE
#define PROBE 0
#endif
#ifndef TS_PHASE
#define TS_PHASE -1
#endif
#ifndef G2_STAGGER
#define G2_STAGGER 800
#endif
__device__ __forceinline__ void dbg_dump(float* out, const bf16_t* a, const bf16_t* b, const bf16_t* c, int lda) {
    for (size_t e = (size_t)blockIdx.x * 512 + threadIdx.x; e < (size_t)MTOK * DM; e += (size_t)gridDim.x * 512) {
        const size_t m = e >> 10; const int col = (lda == 3072) ? (int)(e & 1023) + 1024 * (int)(m % 3) : (int)(e & 1023) % lda; float v = bf2f(a[m * lda + col]); if (b) v += bf2f(b[m * lda + col]); if (c) v += bf2f(c[m * lda + col]); out[e] = v; }
}
__global__ void __launch_bounds__(512, 2) mega_fwd(Params p) {
    extern __shared__ __attribute__((aligned(16))) unsigned char lds_raw[];
    LAS unsigned char* lds = (LAS unsigned char*)lds_raw;
    cg::grid_group grid = cg::this_grid();
    const int tid = 0, lane = 0, wave = __builtin_amdgcn_readfirstlane((int)threadIdx.x >> 6);
    const int G = gridDim.x, gw = blockIdx.x * 8 + wave, ngw = G * 8, ngt = G * 512;
    unsigned char* ws = PP(ws);
    bf16_t* XN = (bf16_t*)(ws + WS_XN);
    volatile LAS unsigned* misc = (volatile LAS unsigned*)(lds + MISC_OFF);
    if (wave == 0 && lane_id_() < 4) misc[lane_id_()] = 0u;
    __syncthreads();
    const XcdBarrier xbar = xcd_barrier_post((unsigned*)(ws + WS_BAR), misc, wave);

    unsigned long long tprev = (TS_PHASE >= 0) ? __builtin_amdgcn_s_memrealtime() : 0ull, tsel = 0ull;
    convert_weights(p, 0, lds, gw, ngw, wave, lane);
    if (PROBE & 1) convert_weights(p, 0, lds, gw, ngw, wave, lane);
    row_phase<false, false, true>(PP(x), nullptr, nullptr, nullptr, PP(mix_pre_g), XN, gw, ngw, lane);
    CG_SYNC();
    TSTAMP(0);
    if (DBG_STOP == 8) {
        {
            unsigned char* ws = launder(PP(ws)); bf16_t* XN = (bf16_t*)(ws + WS_XN);
            pg8::Gemm g{XN, (const bf16_t*)(ws + WS_WIN) + (size_t)4352 * 1024, 1024, 1024, 1024, 0, 0}; pg8::StaticOrder S; S.init(MTOK, 3072, G, (int)blockIdx.x);
            pg8::EpiGates E{(bf16_t*)(ws + WS_GATES)}; pg8::gemm_phase(lds, g, S, E, wave);
        }
        GRID_SYNC();
        TSTAMP(1);
        dbg_dump(PP(out), (const bf16_t*)(ws + WS_GATES), nullptr, nullptr, 3072); return;
    }
#pragma unroll 1
    for (int l = 0; l < 2; ++l) {
        {
            unsigned char* ws = launder(PP(ws)); bf16_t* XN = (bf16_t*)(ws + WS_XN);
            pg8::Gemm g{XN, (const bf16_t*)(ws + WS_WIN), 1024, 1024, 1024, 0, 0}; pg8::StaticOrder S; S.init(MTOK, 4352, G, (int)blockIdx.x);
            pg8::EpiG1 E{ws}; for (int rep_ = 0; rep_ < REP_GEMM; ++rep_) pg8::gemm_phase(lds, g, S, E, wave);
        }
        GRID_SYNC();
        TSTAMP(2);
        if (DBG_STOP == 1) { dbg_dump(PP(out), (const bf16_t*)(ws + WS_KA), (const bf16_t*)(ws + WS_SV), (const bf16_t*)(ws + WS_GV), 512); return; }
        if (PROBE & 16) sb_phase(lds, ws, tid, wave, lane, 428 * MiB);
        sb_phase(lds, ws, tid, wave, lane);
        TSTAMP(15);
        sg_phase(lds, p, l, tid, wave, lane);
        TSTAMP(16);
        gla_phase<false>(lds, p, l, tid, wave, lane);
        if (PROBE & 4) gla_phase<false>(lds, p, l, tid, wave, lane);
        GRID_SYNC();
        TSTAMP(3);
        gla_scan(ws, wave, ngt);
        GRID_SYNC();
        TSTAMP(4);
        gla_phase<true>(lds, p, l, tid, wave, lane);
        GRID_SYNC();
        TSTAMP(5);
        if (DBG_STOP == 2) { dbg_dump(PP(out), (const bf16_t*)(ws + WS_QA), (const bf16_t*)(ws + WS_U), (const bf16_t*)(ws + WS_GR), 512); return; }
        {
            unsigned char* ws = launder(PP(ws)); bf16_t* XN = (bf16_t*)(ws + WS_XN);
            pg8::Gemm g{XN, (const bf16_t*)(ws + WS_WIN) + (size_t)4352 * 1024, 1024, 1024, 1024, 0, 0}; pg8::StaticOrder S; S.init(MTOK, 3072, G, (int)blockIdx.x);
            pg8::EpiGates E{(bf16_t*)(ws + WS_GATES)}; for (int rep_ = 0; rep_ < REP_GEMM; ++rep_) pg8::gemm_phase(lds, g, S, E, wave);
        }
        GRID_SYNC();
        TSTAMP(6);
        if (DBG_STOP == 7) { dbg_dump(PP(out), (const bf16_t*)(ws + WS_GATES), nullptr, nullptr, 3072); return; }
        {
            unsigned char* ws = launder(PP(ws)); bf16_t* XN = (bf16_t*)(ws + WS_XN);
            pg8::Gemm g{(const bf16_t*)(ws + WS_QA), (const bf16_t*)(ws + WS_WP), 1536, 512, 1536, 0, (size_t)(32 * MiB)}; pg8::StaticOrder S; S.init(MTOK, 1024, G, (int)blockIdx.x);
            pg8::EpiMerge3 E{(const bf16_t*)(ws + WS_GATES), XN};
            pg8::gemm_merge_phase(lds, g, S, E, wave);
        }
        GRID_SYNC();
        TSTAMP(7);
        if (DBG_STOP == 3) { dbg_dump(PP(out), (const bf16_t*)(ws + WS_XN), nullptr, nullptr, 1024); return; }
        {
            unsigned char* ws = launder(PP(ws)); bf16_t* XN = (bf16_t*)(ws + WS_XN);
            pg8::Gemm g{XN, (const bf16_t*)(ws + WS_WOUT), 1024, 1024, 1024, 0, 0}; pg8::StaticOrder S; S.init(MTOK, 1024, G, (int)blockIdx.x);
            pg8::EpiF32 E{(bf16_t*)(ws + WS_Y32)}; for (int rep_ = 0; rep_ < REP_GEMM; ++rep_) pg8::gemm_phase(lds, g, S, E, wave);
        }
        GRID_SYNC();
        TSTAMP(8);
        row_phase<true, true, true>(l == 0 ? PP(x) : (const float*)PP(out), (const bf16_t*)(ws + WS_Y32), PP(mix_post_g) + l * DM, PP(out), PP(ffn_pre_g) + l * DM, XN, gw, ngw, lane);
        GRID_SYNC();
        TSTAMP(9);
        if (DBG_STOP == 4) return;
        {
            unsigned char* ws = launder(PP(ws)); bf16_t* XN = (bf16_t*)(ws + WS_XN);
            pg8::Gemm g{XN, (const bf16_t*)(ws + WS_WUP), 1024, 1024, 1024, 0, 0}; pg8::StaticOrder S; S.init(MTOK, DFF2, G, (int)blockIdx.x);
            pg8::EpiConv E{launder(PP(ffn_conv_w)) + (size_t)l * 3 * DFF2, launder(PP(ffn_conv_b)) + (size_t)l * DFF2, (bf16_t*)(ws + WS_ACT), (float*)(ws + WS_HEAD), (float*)(ws + WS_TAIL)};
            for (int rep_ = 0; rep_ < REP_GEMM; ++rep_) pg8::gemm_phase(lds, g, S, E, wave);
        }
        GRID_SYNC();
        TSTAMP(10);
        conv_fix(p, l, wave, ngt);
        GRID_SYNC();
        TSTAMP(11);
        if (DBG_STOP == 5) { dbg_dump(PP(out), (const bf16_t*)(ws + WS_ACT), nullptr, nullptr, 1024); return; }
        {
            unsigned char* ws = launder(PP(ws));
            pg8::Gemm g{(const bf16_t*)(ws + WS_ACT), (const bf16_t*)(ws + WS_WDN), DFF, DFF, DFF, 0, 0}; pg8::StaticOrder S; S.init(MTOK, 1024, G, (int)blockIdx.x);
            pg8::EpiF32 E{(bf16_t*)(ws + WS_Y32B)}; for (int rep_ = 0; rep_ < REP_GEMM; ++rep_) pg8::gemm_phase(lds, g, S, E, wave);
        }
        GRID_SYNC();
        TSTAMP(12);
        if (l == 0) {
            row_phase<true, true, true>(PP(out), (const bf16_t*)(ws + WS_Y32B), PP(ffn_post_g), PP(out), PP(mix_pre_g) + DM, XN, gw, ngw, lane);
            convert_weights(p, 1, lds, gw, ngw, wave, lane);
            if (PROBE & 1) convert_weights(p, 1, lds, gw, ngw, wave, lane);
            GRID_SYNC();
            TSTAMP(13);
            if (DBG_STOP == 6) return;
        } else {
            row_phase<true, true, false>(PP(out), (const bf16_t*)(ws + WS_Y32B), PP(ffn_post_g) + DM, PP(out), nullptr, nullptr, gw, ngw, lane);
        }
    }
    if (TS_PHASE >= 0) { TSTAMP(14); if (blockIdx.x == 0 && wave == 0 && lane_id_() == 0) { const unsigned long long t0_ = __builtin_amdgcn_s_memrealtime(); while (__builtin_amdgcn_s_memrealtime() - t0_ < tsel) __builtin_amdgcn_s_sleep(8); } }
}

extern "C" void kernel_launch(void* const* d_in, const int* in_sizes, int n_in, void* d_out, int out_size, void* d_ws, size_t ws_size, hipStream_t stream) {
    static int grid = 0;
    if (grid == 0) {
        if (n_in != 21 || out_size != MTOK * DM || ws_size < WS_END) { fprintf(stderr, "kernel_launch: unexpected shapes (n_in %d, out %d, ws %zu)\n", n_in, out_size, ws_size); grid = -1; return; }
        int dev = 0, cus = 0, per_cu = 0;
        hipGetDevice(&dev); hipDeviceGetAttribute(&cus, hipDeviceAttributeMultiprocessorCount, dev);
        if (hipFuncSetAttribute((const void*)mega_fwd, hipFuncAttributeMaxDynamicSharedMemorySize, LDS_BYTES) != hipSuccess) { fprintf(stderr, "kernel_launch: hipFuncSetAttribute failed\n"); grid = -1; return; }
        if (hipOccupancyMaxActiveBlocksPerMultiprocessor(&per_cu, (const void*)mega_fwd, 512, LDS_BYTES) != hipSuccess || per_cu < 1) { fprintf(stderr, "kernel_launch: occupancy query says %d blocks/CU\n", per_cu); per_cu = 1; }
        (void)hipGetLastError();
        if (cus > 512) cus = 512;
        grid = cus;
    }
    if (grid < 0) return;
    Params p{};
    const float** f = (const float**)&p;
    for (int i = 0; i < 21; ++i) f[i] = (const float*)d_in[i];
    p.out = (float*)d_out; p.ws = (unsigned char*)d_ws;
    (void)hipMemsetAsync(d_ws, 0, 65536, stream);
    void* args[] = {&p};
    hipError_t e = hipLaunchCooperativeKernel((const void*)mega_fwd, dim3(grid), dim3(512), args, LDS_BYTES, stream);
    if (e != hipSuccess) fprintf(stderr, "cooperative launch failed: %s (grid %d)\n", hipGetErrorString(e), grid);
}
```

```cpp
#include <hip/hip_runtime.h>
#include <hip/hip_cooperative_groups.h>
#include <cstdio>
#include <cstdint>
namespace cg = cooperative_groups;

#define LAS __attribute__((address_space(3)))
typedef unsigned short bf16_t;
typedef short bf16x8 __attribute__((ext_vector_type(8)));
typedef float f32x4 __attribute__((ext_vector_type(4)));
typedef unsigned u32x4 __attribute__((ext_vector_type(4)));
typedef unsigned u32x2 __attribute__((ext_vector_type(2)));

constexpr int BATCH = 8, SEQ = 4096, DM = 1024, MTOK = BATCH * SEQ;
constexpr int INW = 7184, DFF = 2816, DFF2 = 5632;
constexpr float EPS = 1e-6f;
constexpr float SB_THR = -106.0f * 1.4426950409f;

constexpr size_t MiB = 1u << 20;
constexpr size_t WS_GDOWN = 1 * MiB;
constexpr size_t WS_DEC = 3 * MiB;
constexpr size_t WS_WIN = 4 * MiB;
constexpr size_t WS_WP = 19 * MiB;
constexpr size_t WS_WOUT = 22 * MiB;
constexpr size_t WS_WUP = 24 * MiB;
constexpr size_t WS_WDN = 35 * MiB;
constexpr size_t WS_XN = 41 * MiB;
constexpr size_t WS_QA = 105 * MiB, WS_U = 137 * MiB, WS_GR = 169 * MiB;
constexpr size_t WS_KA = 201 * MiB, WS_VA = 233 * MiB, WS_SV = 265 * MiB, WS_GV = 297 * MiB;
constexpr size_t WS_GQ = 329 * MiB, WS_GK = 345 * MiB;
constexpr size_t WS_UPD = 361 * MiB;
constexpr size_t WS_GATES = 201 * MiB;
constexpr size_t WS_Y32 = 105 * MiB;
constexpr size_t WS_ACT = 105 * MiB;
constexpr size_t WS_HEAD = 282 * MiB;
constexpr size_t WS_TAIL = 288 * MiB;
constexpr size_t WS_Y32B = 300 * MiB;
constexpr size_t WS_HB = 428 * MiB;
constexpr size_t WS_END = 492 * MiB;

constexpr int LDS_BYTES = 147456;
constexpr int MISC_OFF = 147456 - 64;
constexpr size_t WS_BAR = 0;
constexpr int XT_OFF = 131072;

typedef float f32x2_t __attribute__((ext_vector_type(2)));
typedef __bf16 bf16x2_t __attribute__((ext_vector_type(2)));
__device__ __forceinline__ unsigned cvt_pk_bf16(float lo, float hi) { const f32x2_t v = {lo, hi}; const bf16x2_t b = __builtin_convertvector(v, bf16x2_t); return __builtin_bit_cast(unsigned, b); }
__device__ __forceinline__ float bf2f(unsigned short h) { return __uint_as_float(((unsigned)h) << 16); }
__device__ __forceinline__ float bflo(unsigned w) { return __uint_as_float(w << 16); }
__device__ __forceinline__ float bfhi(unsigned w) { return __uint_as_float(w & 0xffff0000u); }
__device__ __forceinline__ unsigned short f2bf(float f) { return (unsigned short)(cvt_pk_bf16(f, 0.f) & 0xffffu); }
__device__ __forceinline__ bf16x8 pack8(f32x4 a, f32x4 b) {
    u32x4 w; w.x = cvt_pk_bf16(a[0], a[1]); w.y = cvt_pk_bf16(a[2], a[3]); w.z = cvt_pk_bf16(b[0], b[1]); w.w = cvt_pk_bf16(b[2], b[3]);
    return __builtin_bit_cast(bf16x8, w);
}
__device__ __forceinline__ float rcpf_(float x) { return __builtin_amdgcn_rcpf(x); }
__device__ __forceinline__ float gelu_tanh_f(float x) { const float u = 0.7978845608f * (x + 0.044715f * x * x * x); return x * rcpf_(1.f + __expf(-2.f * u)); }
__device__ __forceinline__ float sigmoid_f(float x) { return rcpf_(1.f + __expf(-x)); }
__device__ __forceinline__ float logsig_f(float x) { return fminf(x, 0.f) - __logf(1.f + __expf(-fabsf(x))); }
__device__ __forceinline__ float logsig2_f(float x2) { return fminf(x2, 0.f) - __builtin_amdgcn_logf(1.f + __builtin_amdgcn_exp2f(-fabsf(x2))); }
__device__ __forceinline__ f32x4 mfma16(bf16x8 a, bf16x8 b, f32x4 c) { return __builtin_amdgcn_mfma_f32_16x16x32_bf16(a, b, c, 0, 0, 0); }
__device__ __forceinline__ float wave_sum(float v) {
#pragma unroll
    for (int o = 1; o < 64; o <<= 1) v += __shfl_xor(v, o);
    return v;
}
#define LDS_WAIT() asm volatile("s_waitcnt lgkmcnt(0)" ::: "memory")
template <class T> __device__ __forceinline__ T* launder(T* p) {
    const unsigned long long v = (unsigned long long)p; unsigned lo = __builtin_amdgcn_readfirstlane((unsigned)v), hi = __builtin_amdgcn_readfirstlane((unsigned)(v >> 32));
    asm volatile("" : "+s"(lo), "+s"(hi)); return (T*)(((unsigned long long)hi << 32) | lo); }
__device__ __forceinline__ int lane_id_() { int l = (int)__builtin_amdgcn_mbcnt_hi(~0u, __builtin_amdgcn_mbcnt_lo(~0u, 0u)); asm volatile("" : "+v"(l)); return l; }
__device__ __forceinline__ int vlaunder(int x) { asm volatile("" : "+v"(x)); return x; }
__device__ __forceinline__ float dpp_shr1(float v) { return __builtin_bit_cast(float, __builtin_amdgcn_update_dpp(0, __builtin_bit_cast(int, v), 0x111, 0xf, 0xf, true)); }
__device__ __forceinline__ float dpp_shr2(float v) { return __builtin_bit_cast(float, __builtin_amdgcn_update_dpp(0, __builtin_bit_cast(int, v), 0x112, 0xf, 0xf, true)); }
__device__ __forceinline__ float dpp_shl14(float v) { return __builtin_bit_cast(float, __builtin_amdgcn_update_dpp(0, __builtin_bit_cast(int, v), 0x10E, 0xf, 0xf, true)); }
__device__ __forceinline__ float dpp_shl15(float v) { return __builtin_bit_cast(float, __builtin_amdgcn_update_dpp(0, __builtin_bit_cast(int, v), 0x10F, 0xf, 0xf, true)); }

struct Params {
    const float* x; const float* mix_pre_g; const float* mix_post_g; const float* w_in; const float* sg_ln_g; const float* sg_ln_b; const float* sg_w; const float* sg_b;
    const float* gla_w_gup; const float* gla_b_gate; const float* gla_norm_g; const float* p_a; const float* p_b; const float* p_c; const float* w_out;
    const float* ffn_pre_g; const float* ffn_post_g; const float* ffn_w_up; const float* ffn_conv_w; const float* ffn_conv_b; const float* ffn_w_down;
    float* out; unsigned char* ws;
};
#include <cstddef>
__device__ __forceinline__ const void* karg_(int byte_off) { const char __attribute__((address_space(4)))* ka = (const char __attribute__((address_space(4)))*)__builtin_amdgcn_kernarg_segment_ptr(); return *(const void* const volatile __attribute__((address_space(4)))*)(ka + byte_off); }
#define PP(field) ((decltype(Params::field))karg_((int)offsetof(Params, field)))

namespace pg8 {
constexpr int BM = 256, BK = 64, HALF = 128, HTB = HALF * BK * 2, NXCD = 8, WGM = 8;
__device__ __forceinline__ int lds_byte(int r, int c) { const int st = (r >> 4) * 2 + (c >> 5), rr = r & 15, cc = c & 31, ob = rr * 64 + cc * 2; return st * 1024 + (ob ^ (((ob >> 9) & 1) << 5)); }
__device__ __forceinline__ void stage_rc(int b, int& R, int& C) { const int st = b / 1024, sb = b % 1024, swz = sb ^ (((sb >> 9) & 1) << 5); R = (st >> 1) * 16 + swz / 64; C = (st & 1) * 32 + (swz % 64) / 2; }
__device__ __forceinline__ int perm32(int rho) { const int n = rho >> 4, i = rho & 15; return 8 * (i >> 2) + 4 * n + (i & 3); }

struct Unit { int pm, pn; };
struct Gemm { const bf16_t* A; const bf16_t* Bt; int K, lda, ldb, adiv; size_t astride; };

struct StaticOrder {
    int nM, nN, nwg, G, c;
    __device__ __forceinline__ void init(int M, int N, int G_, int c_) { nM = M / BM; nN = N / BM; nwg = nM * nN; G = G_; c = c_; }
    __device__ __forceinline__ bool next(int i, Unit& u) const {
        const long L = (long)i * G + c; if (L >= nwg) return false;
        int wgid = (int)L; { const int q = nwg / NXCD, r = nwg % NXCD, xcd = wgid % NXCD, off = wgid / NXCD; wgid = (xcd < r ? xcd * (q + 1) : r * (q + 1) + (xcd - r) * q) + off; }
        const int nig = WGM * nN, gid = wgid / nig, fm = gid * WGM, gsz = (nM - fm) < WGM ? (nM - fm) : WGM;
        u.pm = fm + ((wgid % nig) % gsz); u.pn = (wgid % nig) / gsz; return true;
    }
};
struct MergeOrder {
    StaticOrder base;
    __device__ __forceinline__ bool next(int i, Unit& u) const { const int br = i % 3; Unit t; if (!base.next(i / 3, t)) return false; u.pm = t.pm; u.pn = t.pn + 4 * br; return true; }
};

template <class Epi, class Sched>
__device__ __forceinline__ void gemm_phase(LAS unsigned char* lds, const Gemm g, const Sched& S, const Epi& E, int wave_) {
    const int tid = vlaunder(wave_ * 64 + lane_id_()), wid = wave_, lane = tid & 63, wr = wid >> 2, wc = wid & 3, fr = lane & 15, fq = lane >> 4;
    const int K = g.K, nt = K / BK;
    unsigned voffA[2], voffB[2];
#pragma unroll
    for (int i = 0; i < 2; ++i) { int R, C; stage_rc(tid * 16 + i * 8192, R, C); const int Rb = Epi::PERM ? ((R & ~31) + perm32(R & 31)) : R;
        voffA[i] = (unsigned)(R * g.lda + C) * 2u; voffB[i] = (unsigned)(Rb * g.ldb + C) * 2u; }
    const size_t kstep = (size_t)(BK * 2);
    const size_t hstepA = (size_t)HALF * g.lda * 2, hstepB = (size_t)HALF * g.ldb * 2;
    const size_t tstepA = 2 * hstepA, tstepB = 2 * hstepB;
    const unsigned ldsw = (unsigned)wid * 1024u;
    const int aoff = lds_byte(wr * 64 + fr, fq * 8), boff = lds_byte(wc * 32 + fr, fq * 8);
#define PG8_SA(b, h) (((b) * 2 + (h)) * HTB)
#define PG8_SB(b, h) ((4 + (b) * 2 + (h)) * HTB)
#define PG8_STAGE(bufoff, gbase, voff) do { _Pragma("unroll") for (int _i = 0; _i < 2; ++_i) \
        __builtin_amdgcn_global_load_lds((const unsigned*)((const char*)(gbase) + (voff)[_i]), (LAS unsigned*)(lds + (bufoff) + ldsw + _i * 8192), 16, 0, 0); } while (0)
#define PG8_LDA(dst, b, h) do { _Pragma("unroll") for (int m = 0; m < 4; ++m) _Pragma("unroll") for (int k = 0; k < 2; ++k) dst[m][k] = *(const LAS bf16x8*)(lds + PG8_SA(b, h) + aoff + m * 2048 + k * 1024); } while (0)
#define PG8_LDB(dst, b, h) do { _Pragma("unroll") for (int n = 0; n < 2; ++n) _Pragma("unroll") for (int k = 0; k < 2; ++k) dst[n][k] = *(const LAS bf16x8*)(lds + PG8_SB(b, h) + boff + n * 2048 + k * 1024); } while (0)
#define PG8_MMA(ai, bj, At, Bt) do { __builtin_amdgcn_s_setprio(1); _Pragma("unroll") for (int m = 0; m < 4; ++m) _Pragma("unroll") for (int n = 0; n < 2; ++n) _Pragma("unroll") for (int k = 0; k < 2; ++k) \
        acc[ai][bj][m][n] = __builtin_amdgcn_mfma_f32_16x16x32_bf16(Bt[n][k], At[m][k], acc[ai][bj][m][n], 0, 0, 0); __builtin_amdgcn_s_setprio(0); } while (0)
#define PG8_WAIT_V(n) asm volatile("s_waitcnt vmcnt(" #n ")" ::: "memory")
#define PG8_WAIT_L(n) asm volatile("s_waitcnt lgkmcnt(" #n ")" ::: "memory")
#define PG8_BAR __builtin_amdgcn_s_barrier()
#define PG8_SCHED __builtin_amdgcn_sched_barrier(0)
    Unit cur, nxt; int ui = 0;
    (void)S.next(0, cur);
    f32x4 acc[2][2][4][2];
#pragma unroll
    for (int a = 0; a < 2; ++a)
#pragma unroll
        for (int b = 0; b < 2; ++b)
#pragma unroll
            for (int m = 0; m < 4; ++m)
#pragma unroll
                for (int n = 0; n < 2; ++n) acc[a][b][m][n] = (f32x4){0.f, 0.f, 0.f, 0.f};
    bf16x8 At[4][2], B0[2][2], B1[2][2];
    const char* cA = (const char*)g.A + (size_t)cur.pm * tstepA + (g.adiv ? (size_t)(cur.pn / g.adiv) * g.astride : 0);
    const char* cB = (const char*)g.Bt + (size_t)cur.pn * tstepB;
    PG8_STAGE(PG8_SB(0, 0), cB, voffB); PG8_STAGE(PG8_SB(0, 1), cB + hstepB, voffB); PG8_STAGE(PG8_SA(0, 0), cA, voffA); PG8_STAGE(PG8_SA(0, 1), cA + hstepA, voffA);
    if (wr == 1) PG8_BAR;
    PG8_WAIT_V(2); PG8_BAR;
    PG8_STAGE(PG8_SB(1, 0), cB + kstep, voffB); PG8_STAGE(PG8_SA(1, 0), cA + kstep, voffA); PG8_STAGE(PG8_SB(1, 1), cB + hstepB + kstep, voffB);
    PG8_WAIT_V(6); PG8_BAR;
    for (;;) {
        const bool has_next = S.next(ui + 1, nxt);
        const char* nA = has_next ? (const char*)g.A + (size_t)nxt.pm * tstepA + (g.adiv ? (size_t)(nxt.pn / g.adiv) * g.astride : 0) : cA;
        const char* nB = has_next ? (const char*)g.Bt + (size_t)nxt.pn * tstepB : cB;
        for (int t = 0; t < nt; t += 2) {
            const bool last = (t == nt - 2);
            const char* a1 = cA + (size_t)(t + 1) * kstep;
            const char* a2 = last ? nA : cA + (size_t)(t + 2) * kstep; const char* b2 = last ? nB : cB + (size_t)(t + 2) * kstep;
            const char* a3 = a2 + kstep; const char* b3 = b2 + kstep;
            PG8_LDB(B0, 0, 0); PG8_LDB(B1, 0, 1); PG8_SCHED; PG8_LDA(At, 0, 0); PG8_STAGE(PG8_SA(1, 1), a1 + hstepA, voffA);
            PG8_WAIT_V(8); PG8_WAIT_L(0); PG8_BAR; PG8_MMA(0, 0, At, B0); PG8_MMA(0, 1, At, B1); PG8_BAR; PG8_SCHED;
            PG8_LDA(At, 0, 1); PG8_STAGE(PG8_SB(0, 0), b2, voffB); PG8_STAGE(PG8_SB(0, 1), b2 + hstepB, voffB); PG8_STAGE(PG8_SA(0, 0), a2, voffA);
            PG8_WAIT_V(8); PG8_WAIT_L(0); PG8_BAR; PG8_MMA(1, 0, At, B0); PG8_MMA(1, 1, At, B1); PG8_BAR; PG8_SCHED;
            PG8_LDB(B0, 1, 0); PG8_LDB(B1, 1, 1); PG8_SCHED; PG8_LDA(At, 1, 0); PG8_STAGE(PG8_SA(0, 1), a2 + hstepA, voffA);
            PG8_WAIT_V(8); PG8_WAIT_L(0); PG8_BAR; PG8_MMA(0, 0, At, B0); PG8_MMA(0, 1, At, B1); PG8_BAR; PG8_SCHED;
            PG8_LDA(At, 1, 1); PG8_STAGE(PG8_SB(1, 0), b3, voffB); PG8_STAGE(PG8_SB(1, 1), b3 + hstepB, voffB); PG8_STAGE(PG8_SA(1, 0), a3, voffA);
            PG8_WAIT_V(8); PG8_WAIT_L(0); PG8_BAR; PG8_MMA(1, 0, At, B0); PG8_MMA(1, 1, At, B1); PG8_BAR; PG8_SCHED;
        }
        if (wr == 0) PG8_BAR;
        E(acc, cur, wr, wc, fr, fq, lds);
        if (!has_next) break;
#pragma unroll
        for (int a = 0; a < 2; ++a)
#pragma unroll
            for (int b = 0; b < 2; ++b)
#pragma unroll
                for (int m = 0; m < 4; ++m)
#pragma unroll
                    for (int n = 0; n < 2; ++n) acc[a][b][m][n] = (f32x4){0.f, 0.f, 0.f, 0.f};
        cur = nxt; cA = nA; cB = nB; ++ui;
        if (wr == 1) PG8_BAR;
    }
    PG8_WAIT_V(0);
    PG8_BAR;
#undef PG8_SA
#undef PG8_SB
#undef PG8_STAGE
#undef PG8_LDA
#undef PG8_LDB
#undef PG8_MMA
#undef PG8_WAIT_V
#undef PG8_WAIT_L
#undef PG8_BAR
#undef PG8_SCHED
}

typedef const f32x4 (&AccRef)[2][2][4][2];

struct EpiG1 {
    static constexpr bool PERM = true;
    unsigned char* ws;
    __device__ __forceinline__ void operator()(f32x4 (&acc)[2][2][4][2], const Unit& u, int wr, int wc, int fr, int fq, LAS unsigned char*) const {
        const int pn = u.pn;
        const int row0 = u.pm * BM + wr * 64 + fr;
        if (pn == 16) {
            if (wc == 0 && fq < 2) { float* G = (float*)(ws + WS_GDOWN);
#pragma unroll
                for (int ai = 0; ai < 2; ++ai)
#pragma unroll
                    for (int m = 0; m < 4; ++m)
#pragma unroll
                        for (int n = 0; n < 2; ++n) *(f32x4*)(G + (size_t)(row0 + ai * HALF + m * 16) * 16 + 8 * fq + 4 * n) = acc[ai][0][m][n]; }
            return;
        }
        size_t off; int ldc = 512, colt, act = 0;
        if (pn < 2) { off = WS_QA; colt = pn * 256; }
        else if (pn < 4) { off = WS_KA; colt = (pn - 2) * 256; }
        else if (pn < 6) { off = WS_VA; colt = (pn - 4) * 256; }
        else if (pn < 8) { off = WS_U; colt = (pn - 6) * 256; act = 1; }
        else if (pn < 10) { off = WS_SV; colt = (pn - 8) * 256; act = 1; }
        else if (pn == 10) { off = WS_GQ; colt = 0; ldc = 256; }
        else if (pn == 11) { off = WS_GK; colt = 0; ldc = 256; }
        else if (pn < 14) { off = WS_GV; colt = (pn - 12) * 256; }
        else { off = WS_GR; colt = (pn - 14) * 256; act = 2; }
        bf16_t* base = (bf16_t*)(ws + off);
        const int col0 = colt + wc * 32 + 8 * fq;
#pragma unroll
        for (int ai = 0; ai < 2; ++ai)
#pragma unroll
            for (int m = 0; m < 4; ++m) { bf16_t* rowp = base + (size_t)(row0 + ai * HALF + m * 16) * ldc + col0;
#pragma unroll
                for (int bj = 0; bj < 2; ++bj) { f32x4 v0 = acc[ai][bj][m][0], v1 = acc[ai][bj][m][1];
                    if (act == 1) {
#pragma unroll
                        for (int e = 0; e < 4; ++e) { v0[e] = gelu_tanh_f(v0[e]); v1[e] = gelu_tanh_f(v1[e]); }
                    } else if (act == 2) {
#pragma unroll
                        for (int e = 0; e < 4; ++e) { v0[e] = v0[e] * sigmoid_f(v0[e]); v1[e] = v1[e] * sigmoid_f(v1[e]); }
                    }
                    u32x4 w; w.x = cvt_pk_bf16(v0[0], v0[1]); w.y = cvt_pk_bf16(v0[2], v0[3]); w.z = cvt_pk_bf16(v1[0], v1[1]); w.w = cvt_pk_bf16(v1[2], v1[3]);
                    *(u32x4*)(rowp + bj * HALF) = w; } }
    }
};
struct EpiGates {
    static constexpr bool PERM = true;
    bf16_t* O;
    __device__ __forceinline__ void operator()(f32x4 (&acc)[2][2][4][2], const Unit& u, int wr, int wc, int fr, int fq, LAS unsigned char*) const {
        const int row0 = u.pm * BM + wr * 64 + fr, col0 = u.pn * BM + wc * 32 + 8 * fq;
#pragma unroll
        for (int ai = 0; ai < 2; ++ai)
#pragma unroll
            for (int m = 0; m < 4; ++m) { bf16_t* rowp = O + (size_t)(row0 + ai * HALF + m * 16) * 3072 + col0;
#pragma unroll
                for (int bj = 0; bj < 2; ++bj) { f32x4 v0 = acc[ai][bj][m][0], v1 = acc[ai][bj][m][1];
#pragma unroll
                    for (int e = 0; e < 4; ++e) { v0[e] = sigmoid_f(v0[e]); v1[e] = sigmoid_f(v1[e]); }
                    u32x4 w; w.x = cvt_pk_bf16(v0[0], v0[1]); w.y = cvt_pk_bf16(v0[2], v0[3]); w.z = cvt_pk_bf16(v1[0], v1[1]); w.w = cvt_pk_bf16(v1[2], v1[3]);
                    *(u32x4*)(rowp + bj * HALF) = w; } }
    }
};
struct EpiMerge {
    static constexpr bool PERM = true;
    const bf16_t* gates; bf16_t* O;
    __device__ __forceinline__ void operator()(f32x4 (&acc)[2][2][4][2], const Unit& u, int wr, int wc, int fr, int fq, LAS unsigned char*) const {
        const int br = u.pn >> 2, ct = u.pn & 3;
        const int row0 = u.pm * BM + wr * 64 + fr, col0 = ct * BM + wc * 32 + 8 * fq;
#pragma unroll
        for (int ai = 0; ai < 2; ++ai)
#pragma unroll
            for (int m = 0; m < 4; ++m) { const size_t row = (size_t)(row0 + ai * HALF + m * 16);
#pragma unroll
                for (int bj = 0; bj < 2; ++bj) { f32x4 v0 = acc[ai][bj][m][0], v1 = acc[ai][bj][m][1];
                    const u32x4 gw = *(const u32x4*)(gates + row * 3072 + br * 1024 + col0 + bj * HALF);
                    v0[0] *= bflo(gw.x); v0[1] *= bfhi(gw.x); v0[2] *= bflo(gw.y); v0[3] *= bfhi(gw.y);
                    v1[0] *= bflo(gw.z); v1[1] *= bfhi(gw.z); v1[2] *= bflo(gw.w); v1[3] *= bfhi(gw.w);
                    bf16_t* op = O + row * 1024 + col0 + bj * HALF;
                    if (br > 0) { const u32x4 pw = *(const u32x4*)op;
                        v0[0] += bflo(pw.x); v0[1] += bfhi(pw.x); v0[2] += bflo(pw.y); v0[3] += bfhi(pw.y);
                        v1[0] += bflo(pw.z); v1[1] += bfhi(pw.z); v1[2] += bflo(pw.w); v1[3] += bfhi(pw.w); }
                    u32x4 w; w.x = cvt_pk_bf16(v0[0], v0[1]); w.y = cvt_pk_bf16(v0[2], v0[3]); w.z = cvt_pk_bf16(v1[0], v1[1]); w.w = cvt_pk_bf16(v1[2], v1[3]);
                    *(u32x4*)op = w; } }
    }
};
struct EpiF32 {
    static constexpr bool PERM = true;
    bf16_t* O;
    __device__ __forceinline__ void operator()(f32x4 (&acc)[2][2][4][2], const Unit& u, int wr, int wc, int fr, int fq, LAS unsigned char*) const {
        const int row0 = u.pm * BM + wr * 64 + fr, col0 = u.pn * BM + wc * 32 + 8 * fq;
#pragma unroll
        for (int ai = 0; ai < 2; ++ai)
#pragma unroll
            for (int m = 0; m < 4; ++m) { bf16_t* rowp = O + (size_t)(row0 + ai * HALF + m * 16) * 1024 + col0;
#pragma unroll
                for (int bj = 0; bj < 2; ++bj) { const f32x4 v0 = acc[ai][bj][m][0], v1 = acc[ai][bj][m][1];
                    u32x4 w; w.x = cvt_pk_bf16(v0[0], v0[1]); w.y = cvt_pk_bf16(v0[2], v0[3]); w.z = cvt_pk_bf16(v1[0], v1[1]); w.w = cvt_pk_bf16(v1[2], v1[3]);
                    *(u32x4*)(rowp + bj * HALF) = w; } }
    }
};
struct EpiConv {
    static constexpr bool PERM = true;
    const float* cw; const float* cb; bf16_t* act; float* head; float* tail;
    __device__ __forceinline__ void operator()(f32x4 (&acc)[2][2][4][2], const Unit& u, int wr, int wc, int fr, int fq, LAS unsigned char* lds) const {
        LAS float* XT = (LAS float*)(lds + XT_OFF);
        const int ccol = wc * 32 + 8 * fq;
        if (fr >= 14) {
#pragma unroll
            for (int ai = 0; ai < 2; ++ai)
#pragma unroll
                for (int bj = 0; bj < 2; ++bj)
#pragma unroll
                    for (int n = 0; n < 2; ++n) *(LAS f32x4*)(XT + ((ai * 2 + wr) * 2 + (fr - 14)) * 256 + bj * HALF + ccol + 4 * n) = acc[ai][bj][3][n];
            if (wr == 1) {
#pragma unroll
                for (int bj = 0; bj < 2; ++bj)
#pragma unroll
                    for (int n = 0; n < 2; ++n) *(f32x4*)(tail + ((size_t)u.pm * 2 + (fr - 14)) * DFF2 + u.pn * BM + bj * HALF + ccol + 4 * n) = acc[1][bj][3][n];
            }
        }
        if (fr < 2 && wr == 0) {
#pragma unroll
            for (int bj = 0; bj < 2; ++bj)
#pragma unroll
                for (int n = 0; n < 2; ++n) *(f32x4*)(head + ((size_t)u.pm * 2 + fr) * DFF2 + u.pn * BM + bj * HALF + ccol + 4 * n) = acc[0][bj][0][n];
        }
        asm volatile("s_waitcnt lgkmcnt(0)" ::: "memory"); __builtin_amdgcn_s_barrier(); asm volatile("" ::: "memory");
#pragma unroll
        for (int n = 0; n < 2; ++n) {
            const int ch = u.pn * HALF + ccol + 4 * n;
            const f32x4 wa0 = *(const f32x4*)(cw + ch), wa1 = *(const f32x4*)(cw + DFF2 + ch), wa2 = *(const f32x4*)(cw + 2 * DFF2 + ch), ba = *(const f32x4*)(cb + ch);
            const f32x4 wu0 = *(const f32x4*)(cw + DFF + ch), wu1 = *(const f32x4*)(cw + DFF2 + DFF + ch), wu2 = *(const f32x4*)(cw + 2 * DFF2 + DFF + ch), bu = *(const f32x4*)(cb + DFF + ch);
#pragma unroll
            for (int ai = 1; ai >= 0; --ai)
#pragma unroll
                for (int m = 3; m >= 0; --m) {
                    f32x4 pa, pu;
                    if (m > 0) { pa = acc[ai][0][m - 1][n]; pu = acc[ai][1][m - 1][n]; }
                    else {
                        const int slot = ai * 2 + wr - 1;
                        if (slot >= 0) { pa = *(const LAS f32x4*)(XT + (slot * 2 + (fr & 1)) * 256 + ccol + 4 * n); pu = *(const LAS f32x4*)(XT + (slot * 2 + (fr & 1)) * 256 + HALF + ccol + 4 * n); }
                        else { pa = (f32x4){0.f, 0.f, 0.f, 0.f}; pu = pa; }
                    }
                    f32x4 xa = acc[ai][0][m][n], xu = acc[ai][1][m][n];
                    asm volatile("" : "+v"(xa), "+v"(xu), "+v"(pa), "+v"(pu));
                    f32x4 res;
#pragma unroll
                    for (int e = 0; e < 4; ++e) {
                        const float a1 = dpp_shr1(xa[e]) + dpp_shl15(pa[e]), a2 = dpp_shr2(xa[e]) + dpp_shl14(pa[e]);
                        const float u1 = dpp_shr1(xu[e]) + dpp_shl15(pu[e]), u2 = dpp_shr2(xu[e]) + dpp_shl14(pu[e]);
                        const float ca = ba[e] + wa0[e] * a2 + wa1[e] * a1 + wa2[e] * xa[e];
                        const float cu = bu[e] + wu0[e] * u2 + wu1[e] * u1 + wu2[e] * xu[e];
                        res[e] = gelu_tanh_f(ca) * cu;
                    }
                    asm volatile("" : "+v"(res));
                    acc[ai][0][m][n] = res;
                }
        }
        const int row0 = u.pm * BM + wr * 64 + fr;
#pragma unroll
        for (int ai = 0; ai < 2; ++ai)
#pragma unroll
            for (int m = 0; m < 4; ++m) { const f32x4 v0 = acc[ai][0][m][0], v1 = acc[ai][0][m][1];
                u32x4 w; w.x = cvt_pk_bf16(v0[0], v0[1]); w.y = cvt_pk_bf16(v0[2], v0[3]); w.z = cvt_pk_bf16(v1[0], v1[1]); w.w = cvt_pk_bf16(v1[2], v1[3]);
                *(u32x4*)(act + (size_t)(row0 + ai * HALF + m * 16) * DFF + u.pn * HALF + ccol) = w; }
    }
};
template <class Epi, class Sched>
__device__ __forceinline__ void gemm_merge_phase(LAS unsigned char* lds, const Gemm g, const Sched& S, const Epi& E, int wave_) {
    const int tid = vlaunder(wave_ * 64 + lane_id_()), wid = wave_, lane = tid & 63, wr = wid >> 2, wc = wid & 3, fr = lane & 15, fq = lane >> 4;
    const int K = g.K, nt = K / BK;
    unsigned voffA[2], voffB[2];
#pragma unroll
    for (int i = 0; i < 2; ++i) { int R, C; stage_rc(tid * 16 + i * 8192, R, C); const int Rb = Epi::PERM ? ((R & ~31) + perm32(R & 31)) : R;
        voffA[i] = (unsigned)(R * g.lda + C) * 2u; voffB[i] = (unsigned)(Rb * g.ldb + C) * 2u; }
    const size_t kstep = (size_t)(BK * 2);
    const size_t hstepA = (size_t)HALF * g.lda * 2, hstepB = (size_t)HALF * g.ldb * 2;
    const size_t tstepA = 2 * hstepA, tstepB = 2 * hstepB;
    const unsigned ldsw = (unsigned)wid * 1024u;
    const int aoff = lds_byte(wr * 64 + fr, fq * 8), boff = lds_byte(wc * 32 + fr, fq * 8);
#define PG8_SA(b, h) (((b) * 2 + (h)) * HTB)
#define PG8_SB(b, h) ((4 + (b) * 2 + (h)) * HTB)
#define PG8_STAGE(bufoff, gbase, voff) do { _Pragma("unroll") for (int _i = 0; _i < 2; ++_i) \
        __builtin_amdgcn_global_load_lds((const unsigned*)((const char*)(gbase) + (voff)[_i]), (LAS unsigned*)(lds + (bufoff) + ldsw + _i * 8192), 16, 0, 0); } while (0)
#define PG8_LDA(dst, b, h) do { _Pragma("unroll") for (int m = 0; m < 4; ++m) _Pragma("unroll") for (int k = 0; k < 2; ++k) dst[m][k] = *(const LAS bf16x8*)(lds + PG8_SA(b, h) + aoff + m * 2048 + k * 1024); } while (0)
#define PG8_LDB(dst, b, h) do { _Pragma("unroll") for (int n = 0; n < 2; ++n) _Pragma("unroll") for (int k = 0; k < 2; ++k) dst[n][k] = *(const LAS bf16x8*)(lds + PG8_SB(b, h) + boff + n * 2048 + k * 1024); } while (0)
#define PG8_MMA(ai, bj, At, Bt) do { __builtin_amdgcn_s_setprio(1); _Pragma("unroll") for (int m = 0; m < 4; ++m) _Pragma("unroll") for (int n = 0; n < 2; ++n) _Pragma("unroll") for (int k = 0; k < 2; ++k) \
        acc[ai][bj][m][n] = __builtin_amdgcn_mfma_f32_16x16x32_bf16(Bt[n][k], At[m][k], acc[ai][bj][m][n], 0, 0, 0); __builtin_amdgcn_s_setprio(0); } while (0)
#define PG8_WAIT_V(n) asm volatile("s_waitcnt vmcnt(" #n ")" ::: "memory")
#define PG8_WAIT_L(n) asm volatile("s_waitcnt lgkmcnt(" #n ")" ::: "memory")
#define PG8_BAR __builtin_amdgcn_s_barrier()
#define PG8_SCHED __builtin_amdgcn_sched_barrier(0)
    Unit cur, nxt; int ui = 0;
    (void)S.next(0, cur);
    f32x4 acc[2][2][4][2];
#pragma unroll
    for (int a = 0; a < 2; ++a)
#pragma unroll
        for (int b = 0; b < 2; ++b)
#pragma unroll
            for (int m = 0; m < 4; ++m)
#pragma unroll
                for (int n = 0; n < 2; ++n) acc[a][b][m][n] = (f32x4){0.f, 0.f, 0.f, 0.f};
    bf16x8 At[4][2], B0[2][2], B1[2][2];
#define PG8_AT(base, t) ((base) + (size_t)((t) >> 3) * g.astride + (size_t)((t) & 7) * kstep)
    const char* cA = (const char*)g.A + (size_t)cur.pm * tstepA;
    const char* cB = (const char*)g.Bt + (size_t)cur.pn * tstepB;
    PG8_STAGE(PG8_SB(0, 0), cB, voffB); PG8_STAGE(PG8_SB(0, 1), cB + hstepB, voffB); PG8_STAGE(PG8_SA(0, 0), cA, voffA); PG8_STAGE(PG8_SA(0, 1), cA + hstepA, voffA);
    if (wr == 1) PG8_BAR;
    PG8_WAIT_V(2); PG8_BAR;
    PG8_STAGE(PG8_SB(1, 0), cB + kstep, voffB); PG8_STAGE(PG8_SA(1, 0), cA + kstep, voffA); PG8_STAGE(PG8_SB(1, 1), cB + hstepB + kstep, voffB);
    PG8_WAIT_V(6); PG8_BAR;
    for (;;) {
        const bool has_next = S.next(ui + 1, nxt);
        const char* nA = has_next ? (const char*)g.A + (size_t)nxt.pm * tstepA : cA;
        const char* nB = has_next ? (const char*)g.Bt + (size_t)nxt.pn * tstepB : cB;
#define PG8_KBODY(t) { \
            const bool last = ((t) == nt - 2); \
            const char* a1 = PG8_AT(cA, t + 1); \
            const char* a2 = last ? nA : PG8_AT(cA, t + 2); const char* b2 = last ? nB : cB + (size_t)(t + 2) * kstep; \
            const char* a3 = last ? nA + kstep : PG8_AT(cA, t + 3); const char* b3 = b2 + kstep; \
            PG8_LDB(B0, 0, 0); PG8_LDB(B1, 0, 1); PG8_SCHED; PG8_LDA(At, 0, 0); PG8_STAGE(PG8_SA(1, 1), a1 + hstepA, voffA); \
            PG8_WAIT_V(8); PG8_WAIT_L(0); PG8_BAR; PG8_MMA(0, 0, At, B0); PG8_MMA(0, 1, At, B1); PG8_BAR; PG8_SCHED; \
            PG8_LDA(At, 0, 1); PG8_STAGE(PG8_SB(0, 0), b2, voffB); PG8_STAGE(PG8_SB(0, 1), b2 + hstepB, voffB); PG8_STAGE(PG8_SA(0, 0), a2, voffA); \
            PG8_WAIT_V(8); PG8_WAIT_L(0); PG8_BAR; PG8_MMA(1, 0, At, B0); PG8_MMA(1, 1, At, B1); PG8_BAR; PG8_SCHED; \
            PG8_LDB(B0, 1, 0); PG8_LDB(B1, 1, 1); PG8_SCHED; PG8_LDA(At, 1, 0); PG8_STAGE(PG8_SA(0, 1), a2 + hstepA, voffA); \
            PG8_WAIT_V(8); PG8_WAIT_L(0); PG8_BAR; PG8_MMA(0, 0, At, B0); PG8_MMA(0, 1, At, B1); PG8_BAR; PG8_SCHED; \
            PG8_LDA(At, 1, 1); PG8_STAGE(PG8_SB(1, 0), b3, voffB); PG8_STAGE(PG8_SB(1, 1), b3 + hstepB, voffB); PG8_STAGE(PG8_SA(1, 0), a3, voffA); \
            PG8_WAIT_V(8); PG8_WAIT_L(0); PG8_BAR; PG8_MMA(1, 0, At, B0); PG8_MMA(1, 1, At, B1); PG8_BAR; PG8_SCHED; \
        }
        for (int t = 0; t < 8; t += 2) PG8_KBODY(t)
        E.hook(acc, cur, 0, wr, wc, fr, fq);
        for (int t = 8; t < 16; t += 2) PG8_KBODY(t)
        E.hook(acc, cur, 1, wr, wc, fr, fq);
        for (int t = 16; t < 24; t += 2) PG8_KBODY(t)
#undef PG8_KBODY
        if (wr == 0) PG8_BAR;
        E(acc, cur, wr, wc, fr, fq, lds);
        if (!has_next) break;
#pragma unroll
        for (int a = 0; a < 2; ++a)
#pragma unroll
            for (int b = 0; b < 2; ++b)
#pragma unroll
                for (int m = 0; m < 4; ++m)
#pragma unroll
                    for (int n = 0; n < 2; ++n) acc[a][b][m][n] = (f32x4){0.f, 0.f, 0.f, 0.f};
        cur = nxt; cA = nA; cB = nB; ++ui;
        if (wr == 1) PG8_BAR;
    }
    PG8_WAIT_V(0);
    PG8_BAR;
#undef PG8_AT
#undef PG8_SA
#undef PG8_SB
#undef PG8_STAGE
#undef PG8_LDA
#undef PG8_LDB
#undef PG8_MMA
#undef PG8_WAIT_V
#undef PG8_WAIT_L
#undef PG8_BAR
#undef PG8_SCHED
}

struct EpiMerge3 {
    static constexpr bool PERM = true;
    const bf16_t* gates; bf16_t* O;
    static __device__ __forceinline__ float cl(float g) { return fmaxf(g, 1e-30f); }
    __device__ __forceinline__ void hook(f32x4 (&acc)[2][2][4][2], const Unit& u, int seam, int wr, int wc, int fr, int fq) const {
        const int row0 = vlaunder(u.pm * BM + wr * 64 + fr), col0 = vlaunder(u.pn * BM + wc * 32 + 8 * fq);
#pragma unroll
        for (int ai = 0; ai < 2; ++ai) {
            u32x4 ga[4][2], gb[4][2];
#pragma unroll
            for (int m = 0; m < 4; ++m)
#pragma unroll
                for (int bj = 0; bj < 2; ++bj) { const bf16_t* gp = gates + (size_t)(row0 + ai * HALF + m * 16) * 3072 + seam * 1024 + col0 + bj * HALF; ga[m][bj] = *(const u32x4*)gp; gb[m][bj] = *(const u32x4*)(gp + 1024); }
#pragma unroll
            for (int m = 0; m < 4; ++m)
#pragma unroll
                for (int bj = 0; bj < 2; ++bj) { const u32x4 a = ga[m][bj], b = gb[m][bj];
                    acc[ai][bj][m][0][0] *= cl(bflo(a.x)) * rcpf_(cl(bflo(b.x))); acc[ai][bj][m][0][1] *= cl(bfhi(a.x)) * rcpf_(cl(bfhi(b.x)));
                    acc[ai][bj][m][0][2] *= cl(bflo(a.y)) * rcpf_(cl(bflo(b.y))); acc[ai][bj][m][0][3] *= cl(bfhi(a.y)) * rcpf_(cl(bfhi(b.y)));
                    acc[ai][bj][m][1][0] *= cl(bflo(a.z)) * rcpf_(cl(bflo(b.z))); acc[ai][bj][m][1][1] *= cl(bfhi(a.z)) * rcpf_(cl(bfhi(b.z)));
                    acc[ai][bj][m][1][2] *= cl(bflo(a.w)) * rcpf_(cl(bflo(b.w))); acc[ai][bj][m][1][3] *= cl(bfhi(a.w)) * rcpf_(cl(bfhi(b.w))); }
            asm volatile("" ::: "memory");
        }
    }
    __device__ __forceinline__ void operator()(f32x4 (&acc)[2][2][4][2], const Unit& u, int wr, int wc, int fr, int fq, LAS unsigned char*) const {
        const int row0 = vlaunder(u.pm * BM + wr * 64 + fr), col0 = vlaunder(u.pn * BM + wc * 32 + 8 * fq);
#pragma unroll
        for (int ai = 0; ai < 2; ++ai) {
            u32x4 gc[4][2];
#pragma unroll
            for (int m = 0; m < 4; ++m)
#pragma unroll
                for (int bj = 0; bj < 2; ++bj) gc[m][bj] = *(const u32x4*)(gates + (size_t)(row0 + ai * HALF + m * 16) * 3072 + 2048 + col0 + bj * HALF);
#pragma unroll
            for (int m = 0; m < 4; ++m)
#pragma unroll
                for (int bj = 0; bj < 2; ++bj) { const u32x4 c = gc[m][bj]; const f32x4 v0 = acc[ai][bj][m][0], v1 = acc[ai][bj][m][1];
                    u32x4 w; w.x = cvt_pk_bf16(v0[0] * cl(bflo(c.x)), v0[1] * cl(bfhi(c.x))); w.y = cvt_pk_bf16(v0[2] * cl(bflo(c.y)), v0[3] * cl(bfhi(c.y)));
                    w.z = cvt_pk_bf16(v1[0] * cl(bflo(c.z)), v1[1] * cl(bfhi(c.z))); w.w = cvt_pk_bf16(v1[2] * cl(bflo(c.w)), v1[3] * cl(bfhi(c.w)));
                    *(u32x4*)(O + (size_t)(row0 + ai * HALF + m * 16) * 1024 + col0 + bj * HALF) = w; }
            asm volatile("" ::: "memory");
        }
    }
};
}

__device__ __forceinline__ void transpose_item(const float* W, int ldsrc, int k0, int nsrc0, bf16_t* WT, int K, int ndst0, LAS float* scr, int lane) {
    float wv[32];
#pragma unroll
    for (int i = 0; i < 32; ++i) wv[i] = W[(size_t)(k0 + 2 * i + (lane >> 5)) * ldsrc + nsrc0 + (lane & 31)];
#pragma unroll
    for (int i = 0; i < 32; ++i) scr[(2 * i + (lane >> 5)) * 33 + (lane & 31)] = wv[i];
    LDS_WAIT(); asm volatile("" ::: "memory");
    const int c = lane & 7;
#pragma unroll
    for (int j = 0; j < 4; ++j) { const int n = (lane >> 3) + 8 * j; const LAS float* s = scr + (8 * c) * 33 + n;
        u32x4 o; o.x = cvt_pk_bf16(s[0 * 33], s[1 * 33]); o.y = cvt_pk_bf16(s[2 * 33], s[3 * 33]); o.z = cvt_pk_bf16(s[4 * 33], s[5 * 33]); o.w = cvt_pk_bf16(s[6 * 33], s[7 * 33]);
        *(u32x4*)(WT + (size_t)(ndst0 + n) * K + k0 + 8 * c) = o; }
    LDS_WAIT(); asm volatile("" ::: "memory");
}
__device__ __forceinline__ void convert_weights(const Params& p, int l, LAS unsigned char* lds, int gw, int ngw, int wave, int lane) {
    lane = vlaunder(lane_id_());
    LAS float* scr = (LAS float*)(lds + wave * 16384);
    unsigned char* ws = launder(PP(ws));
    bf16_t* Win = (bf16_t*)(ws + WS_WIN); bf16_t* WP = (bf16_t*)(ws + WS_WP); bf16_t* WO = (bf16_t*)(ws + WS_WOUT); bf16_t* WU = (bf16_t*)(ws + WS_WUP); bf16_t* WD = (bf16_t*)(ws + WS_WDN);
    const float* w_in = launder(PP(w_in)) + (size_t)l * DM * INW;
    constexpr int I0 = 16 * 128, I1 = 16 * 96, I2 = 8 * 32, I5 = 16 * 32, I6 = 16 * 176, I7 = 44 * 32;
    constexpr int NITEMS = I0 + I1 + 3 * I2 + I5 + I6 + I7;
    for (int it = gw; it < NITEMS; it += ngw) {
        int r = it;
        if (r < I0) { const int kb = r / 128, nb = r % 128; transpose_item(w_in, INW, 64 * kb, 32 * nb, Win, 1024, 32 * nb, scr, lane); continue; } r -= I0;
        if (r < I1) { const int kb = r / 96, nb = r % 96; transpose_item(w_in, INW, 64 * kb, 4112 + 32 * nb, Win, 1024, 4352 + 32 * nb, scr, lane); continue; } r -= I1;
        if (r < 3 * I2) { const int br = r / I2, q = r % I2, kb = q / 32, nb = q % 32;
            const float* src = launder(br == 0 ? PP(p_a) : (br == 1 ? PP(p_b) : PP(p_c))) + (size_t)l * 512 * 1024;
            transpose_item(src, 1024, 64 * kb, 32 * nb, WP + 512 * br, 1536, 32 * nb, scr, lane); continue; } r -= 3 * I2;
        if (r < I5) { const int kb = r / 32, nb = r % 32; transpose_item(launder(PP(w_out)) + (size_t)l * 1024 * 1024, 1024, 64 * kb, 32 * nb, WO, 1024, 32 * nb, scr, lane); continue; } r -= I5;
        if (r < I6) { const int kb = r / 176, nb = r % 176, j = nb >> 3, half = (nb >> 2) & 1, q = nb & 3;
            transpose_item(launder(PP(ffn_w_up)) + (size_t)l * 1024 * DFF2, DFF2, 64 * kb, DFF * half + 128 * j + 32 * q, WU, 1024, 256 * j + 128 * half + 32 * q, scr, lane); continue; } r -= I6;
        { const int kb = r / 32, nb = r % 32; transpose_item(launder(PP(ffn_w_down)) + (size_t)l * DFF * 1024, 1024, 64 * kb, 32 * nb, WD, DFF, 32 * nb, scr, lane); }
    }
    for (int idx = gw * 64 + lane; idx < 256 * 1024; idx += ngw * 64) { const int n = idx >> 10, k = idx & 1023;
        const float v = (n < 16) ? w_in[(size_t)k * INW + 4096 + n] : 0.f; Win[(size_t)(4096 + n) * 1024 + k] = f2bf(v); }
}

template <bool HAS_Y, bool HAS_OUT, bool HAS_XN, bool HIN_BF, bool HOUT_BF>
__device__ __forceinline__ void row_phase(const void* hin_, const bf16_t* y, const float* gpost, void* hout_, const float* gpre, bf16_t* xn, int gw, int ngw, int lane) {
    hin_ = launder(hin_); y = launder(y); hout_ = launder(hout_); xn = launder(xn); gpost = launder(gpost); gpre = launder(gpre); lane = vlaunder(lane_id_());
    for (int m0 = gw; m0 < MTOK; m0 += 2 * ngw) {
        f32x4 v[2][4]; u32x2 hw[2][4]; u32x2 yw[2][4];
#pragma unroll
        for (int rr_ = 0; rr_ < 2; ++rr_) { const int m = m0 + rr_ * ngw;
            if (HIN_BF) { const u32x2* hr = (const u32x2*)((const bf16_t*)hin_ + (size_t)m * DM) + lane;
#pragma unroll
                for (int j = 0; j < 4; ++j) hw[rr_][j] = hr[64 * j]; }
            else { const f32x4* hr = (const f32x4*)((const float*)hin_ + (size_t)m * DM) + lane;
#pragma unroll
                for (int j = 0; j < 4; ++j) v[rr_][j] = hr[64 * j]; }
            if (HAS_Y) { const u32x2* yr = (const u32x2*)(y + (size_t)m * DM) + lane;
#pragma unroll
                for (int j = 0; j < 4; ++j) yw[rr_][j] = yr[64 * j]; } }
#pragma unroll
        for (int rr_ = 0; rr_ < 2; ++rr_) {
            const int m = m0 + rr_ * ngw;
            if (HIN_BF) {
#pragma unroll
                for (int j = 0; j < 4; ++j) v[rr_][j] = (f32x4){bflo(hw[rr_][j].x), bfhi(hw[rr_][j].x), bflo(hw[rr_][j].y), bfhi(hw[rr_][j].y)};
            }
            if (HAS_Y) {
                f32x4 yv[4]; float s = 0.f;
#pragma unroll
                for (int j = 0; j < 4; ++j) { yv[j] = (f32x4){bflo(yw[rr_][j].x), bfhi(yw[rr_][j].x), bflo(yw[rr_][j].y), bfhi(yw[rr_][j].y)}; s += (yv[j].x * yv[j].x + yv[j].y * yv[j].y) + (yv[j].z * yv[j].z + yv[j].w * yv[j].w); }
                const float r = __builtin_amdgcn_rsqf(wave_sum(s) * (1.f / DM) + EPS);
#pragma unroll
                for (int j = 0; j < 4; ++j) { const f32x4 gp = *((const f32x4*)gpost + lane + 64 * j); v[rr_][j] += yv[j] * r * gp; }
            }
            if (HAS_OUT) {
                if (HOUT_BF) { u32x2* ho = (u32x2*)((bf16_t*)hout_ + (size_t)m * DM) + lane;
#pragma unroll
                    for (int j = 0; j < 4; ++j) { u32x2 w; w.x = cvt_pk_bf16(v[rr_][j].x, v[rr_][j].y); w.y = cvt_pk_bf16(v[rr_][j].z, v[rr_][j].w); ho[64 * j] = w;
                        v[rr_][j] = (f32x4){bflo(w.x), bfhi(w.x), bflo(w.y), bfhi(w.y)}; }
                } else { f32x4* ho = (f32x4*)((float*)hout_ + (size_t)m * DM) + lane;
#pragma unroll
                    for (int j = 0; j < 4; ++j) ho[64 * j] = v[rr_][j]; }
            }
            if (HAS_XN) {
                float s = 0.f;
#pragma unroll
                for (int j = 0; j < 4; ++j) s += (v[rr_][j].x * v[rr_][j].x + v[rr_][j].y * v[rr_][j].y) + (v[rr_][j].z * v[rr_][j].z + v[rr_][j].w * v[rr_][j].w);
                const float r = __builtin_amdgcn_rsqf(wave_sum(s) * (1.f / DM) + EPS);
                u32x2* xo = (u32x2*)(xn + (size_t)m * DM) + lane;
#pragma unroll
                for (int j = 0; j < 4; ++j) { const f32x4 g = *((const f32x4*)gpre + lane + 64 * j); const f32x4 o = v[rr_][j] * r * g; u32x2 w; w.x = cvt_pk_bf16(o.x, o.y); w.y = cvt_pk_bf16(o.z, o.w); xo[64 * j] = w; }
            }
        }
    }
}

__device__ __forceinline__ void sb_phase(LAS unsigned char* lds, unsigned char* ws, int tid, int wave, int lane, size_t dst_off = WS_QA) {
    ws = launder(ws); tid = vlaunder(wave * 64 + lane_id_()); lane = tid & 63;
    bf16_t* QA = (bf16_t*)(ws + WS_QA); bf16_t* YA = (bf16_t*)(ws + dst_off); const bf16_t* KA = (const bf16_t*)(ws + WS_KA); const bf16_t* VA = (const bf16_t*)(ws + WS_VA);
    LAS bf16_t* sK = (LAS bf16_t*)lds;
    LAS bf16_t* sVt = (LAS bf16_t*)(lds + 9216);
    const int r = lane & 15, g = lane >> 4;
    for (int u = blockIdx.x; u < BATCH * 8 * 32; u += gridDim.x) {
        const int b = u >> 8, h = (u >> 5) & 7, qb = u & 31;
        const int tq0 = qb * 128 + wave * 16, t = tq0 + r;
        const size_t rowbase = (size_t)b * SEQ;
        bf16x8 qf[2];
#pragma unroll
        for (int ks = 0; ks < 2; ++ks) qf[ks] = *(const bf16x8*)(QA + (rowbase + t) * 512 + h * 64 + 32 * ks + 8 * g);
        f32x4 o[4];
#pragma unroll
        for (int i = 0; i < 4; ++i) o[i] = (f32x4){0.f, 0.f, 0.f, 0.f};
        float carry = 0.f;
        const int skey = tid >> 3, sch = tid & 7;
        u32x4 kv, vv;
        { const size_t goff = (rowbase + (qb * 2 + 1) * 64 + skey) * 512 + h * 64 + 8 * sch; kv = *(const u32x4*)(KA + goff); vv = *(const u32x4*)(VA + goff); }
        for (int kt = qb * 2 + 1; kt >= 0; --kt) {
            {
                const int key = skey, ch = sch;
                *(LAS u32x4*)(sK + key * 72 + 8 * ch) = kv;
                LAS bf16_t* vd = sVt + (8 * ch) * 68 + key;
                vd[0 * 68] = (bf16_t)(vv.x & 0xffff); vd[1 * 68] = (bf16_t)(vv.x >> 16); vd[2 * 68] = (bf16_t)(vv.y & 0xffff); vd[3 * 68] = (bf16_t)(vv.y >> 16);
                vd[4 * 68] = (bf16_t)(vv.z & 0xffff); vd[5 * 68] = (bf16_t)(vv.z >> 16); vd[6 * 68] = (bf16_t)(vv.w & 0xffff); vd[7 * 68] = (bf16_t)(vv.w >> 16);
            }
            __syncthreads();
            if (kt > 0) { const size_t goff = (rowbase + (kt - 1) * 64 + skey) * 512 + h * 64 + 8 * sch; kv = *(const u32x4*)(KA + goff); vv = *(const u32x4*)(VA + goff); }
            const bool wdone = __all(carry < SB_THR);
            const bool active = (kt * 64) < (tq0 + 15) && !wdone;
            if (active) {
                f32x4 s[4];
#pragma unroll
                for (int kb = 0; kb < 4; ++kb) { s[kb] = (f32x4){0.f, 0.f, 0.f, 0.f};
#pragma unroll
                    for (int ks = 0; ks < 2; ++ks) { const bf16x8 a = *(const LAS bf16x8*)(sK + (16 * kb + r) * 72 + 32 * ks + 8 * g); s[kb] = mfma16(a, qf[ks], s[kb]); } }
                f32x4 w[4];
                const float zs = 0.125f * 1.4426950409f;
                if (kt * 64 + 63 < tq0) {
#pragma unroll
                    for (int kb = 3; kb >= 0; --kb) {
                        float l[4], ls[4];
#pragma unroll
                        for (int j = 0; j < 4; ++j) { const float z = s[kb][j] * zs; const float lsz = logsig2_f(z); ls[j] = lsz; l[j] = lsz - z; }
                        const float sg = (l[0] + l[1]) + (l[2] + l[3]);
                        const float a_ = __shfl_xor(sg, 16); const float b_ = sg + a_; const float c_ = __shfl_xor(b_, 32);
                        const float suf = ((g & 1) == 0 ? a_ : 0.f) + ((g & 2) == 0 ? c_ : 0.f);
                        const float t3 = carry + suf, t2 = t3 + l[3], t1 = t2 + l[2], t0 = t1 + l[1];
                        w[kb][0] = __builtin_amdgcn_exp2f(ls[0] + t0); w[kb][1] = __builtin_amdgcn_exp2f(ls[1] + t1);
                        w[kb][2] = __builtin_amdgcn_exp2f(ls[2] + t2); w[kb][3] = __builtin_amdgcn_exp2f(ls[3] + t3);
                        carry += b_ + c_;
                    }
                } else {
#pragma unroll
                    for (int kb = 3; kb >= 0; --kb) {
                        float l[4], ls[4]; bool mk[4];
#pragma unroll
                        for (int j = 0; j < 4; ++j) { const int key = kt * 64 + 16 * kb + 4 * g + j; const float z = s[kb][j] * zs; mk[j] = key < t;
                            const float lsz = logsig2_f(z); ls[j] = lsz; l[j] = mk[j] ? (lsz - z) : 0.f; }
                        const float sg = (l[0] + l[1]) + (l[2] + l[3]);
                        const float a_ = __shfl_xor(sg, 16); const float b_ = sg + a_; const float c_ = __shfl_xor(b_, 32);
                        const float suf = ((g & 1) == 0 ? a_ : 0.f) + ((g & 2) == 0 ? c_ : 0.f);
                        const float t3 = carry + suf, t2 = t3 + l[3], t1 = t2 + l[2], t0 = t1 + l[1];
                        w[kb][0] = mk[0] ? __builtin_amdgcn_exp2f(ls[0] + t0) : 0.f; w[kb][1] = mk[1] ? __builtin_amdgcn_exp2f(ls[1] + t1) : 0.f;
                        w[kb][2] = mk[2] ? __builtin_amdgcn_exp2f(ls[2] + t2) : 0.f; w[kb][3] = mk[3] ? __builtin_amdgcn_exp2f(ls[3] + t3) : 0.f;
                        carry += b_ + c_;
                    }
                }
#pragma unroll
                for (int sI = 0; sI < 2; ++sI) {
                    const bf16x8 pb = pack8(w[2 * sI], w[2 * sI + 1]);
#pragma unroll
                    for (int dvb = 0; dvb < 4; ++dvb) {
                        const LAS bf16_t* vp = sVt + (16 * dvb + r) * 68 + 32 * sI + 4 * g;
                        const u32x2 lo = *(const LAS u32x2*)vp, hi = *(const LAS u32x2*)(vp + 16);
                        u32x4 av; av.x = lo.x; av.y = lo.y; av.z = hi.x; av.w = hi.y;
                        o[dvb] = mfma16(__builtin_bit_cast(bf16x8, av), pb, o[dvb]);
                    }
                }
            }
            const int done = __all(carry < SB_THR) ? 1 : 0;
            if (__syncthreads_and(done)) break;
        }
#pragma unroll
        for (int dvb = 0; dvb < 4; ++dvb) { u32x2 w2; w2.x = cvt_pk_bf16(o[dvb][0], o[dvb][1]); w2.y = cvt_pk_bf16(o[dvb][2], o[dvb][3]);
            *(u32x2*)(YA + (rowbase + t) * 512 + h * 64 + 16 * dvb + 4 * g) = w2; }
        __syncthreads();
    }
}

__device__ __forceinline__ void sg_phase(LAS unsigned char* lds, const Params& p, int l, int tid, int wave, int lane) {
    unsigned char* ws = launder(PP(ws)); tid = vlaunder(wave * 64 + lane_id_()); lane = tid & 63;
    bf16_t* U = (bf16_t*)(ws + WS_U); const bf16_t* SV = (const bf16_t*)(ws + WS_SV);
    LAS bf16_t* sVn = (LAS bf16_t*)(lds + wave * (64 * 136 * 2));
    LAS float* sSt = (LAS float*)(lds + 8 * 64 * 136 * 2);
    const int r = lane & 15, gq = lane >> 4;
    const float* lng = launder(PP(sg_ln_g)) + l * 512; const float* lnb = launder(PP(sg_ln_b)) + l * 512;
    const float* W = launder(PP(sg_w)) + ((size_t)(l * 8 + wave)) * 128 * 128;
    const float* Bs = launder(PP(sg_b)) + (l * 8 + wave) * 128;
    for (int u = blockIdx.x; u < BATCH * 32; u += gridDim.x) {
        const size_t row0 = (size_t)u * 128;
        {
            const int tok = wave * 16 + (lane >> 2);
            const u32x4* sp = (const u32x4*)(SV + (row0 + tok) * 512 + (lane & 3) * 128);
            u32x4 vv[16];
#pragma unroll
            for (int c = 0; c < 16; ++c) vv[c] = sp[c];
            float s = 0.f;
#pragma unroll
            for (int c = 0; c < 16; ++c) s += ((bflo(vv[c].x) + bfhi(vv[c].x)) + (bflo(vv[c].y) + bfhi(vv[c].y))) + ((bflo(vv[c].z) + bfhi(vv[c].z)) + (bflo(vv[c].w) + bfhi(vv[c].w)));
            s += __shfl_xor(s, 1); s += __shfl_xor(s, 2);
            const float mu = s * (1.f / 512.f);
            float q = 0.f;
#pragma unroll
            for (int c = 0; c < 16; ++c) { const float x[8] = {bflo(vv[c].x), bfhi(vv[c].x), bflo(vv[c].y), bfhi(vv[c].y), bflo(vv[c].z), bfhi(vv[c].z), bflo(vv[c].w), bfhi(vv[c].w)};
#pragma unroll
                for (int e = 0; e < 8; ++e) { const float d = x[e] - mu; q += d * d; } }
            q += __shfl_xor(q, 1); q += __shfl_xor(q, 2);
            const float rs = __builtin_amdgcn_rsqf(q * (1.f / 512.f) + EPS);
            if ((lane & 3) == 0) { sSt[tok * 2] = mu; sSt[tok * 2 + 1] = rs; }
        }
        __syncthreads();
#pragma unroll
        for (int i = 0; i < 2; ++i) {
            const int s = lane + 64 * i; const float mu = sSt[s * 2], rs = sSt[s * 2 + 1];
#pragma unroll
            for (int c = 0; c < 8; ++c) {
                const u32x4 vv = *(const u32x4*)(SV + (row0 + s) * 512 + wave * 64 + 8 * c);
                const float x[8] = {bflo(vv.x), bfhi(vv.x), bflo(vv.y), bfhi(vv.y), bflo(vv.z), bfhi(vv.z), bflo(vv.w), bfhi(vv.w)};
                const f32x4 g0 = *(const f32x4*)(lng + wave * 64 + 8 * c), g1 = *(const f32x4*)(lng + wave * 64 + 8 * c + 4);
                const f32x4 b0 = *(const f32x4*)(lnb + wave * 64 + 8 * c), b1 = *(const f32x4*)(lnb + wave * 64 + 8 * c + 4);
#pragma unroll
                for (int e = 0; e < 8; ++e) { const float gg = e < 4 ? g0[e & 3] : g1[e & 3], bb = e < 4 ? b0[e & 3] : b1[e & 3];
                    sVn[(8 * c + e) * 136 + s] = f2bf((x[e] - mu) * rs * gg + bb); }
            }
        }
        __syncthreads();
        {
            f32x4 acc[8][4];
#pragma unroll
            for (int tb = 0; tb < 8; ++tb)
#pragma unroll
                for (int i = 0; i < 4; ++i) acc[tb][i] = (f32x4){0.f, 0.f, 0.f, 0.f};
#pragma unroll
            for (int ks = 0; ks < 4; ++ks) {
                const int s0 = 32 * ks + 8 * gq;
                bf16x8 bb[4];
#pragma unroll
                for (int db = 0; db < 4; ++db) bb[db] = *(const LAS bf16x8*)(sVn + (16 * db + r) * 136 + s0);
#pragma unroll
                for (int tb = 2 * ks; tb < 8; ++tb) {
                    const int t = 16 * tb + r;
                    f32x4 w0 = *(const f32x4*)(W + t * 128 + s0), w1 = *(const f32x4*)(W + t * 128 + s0 + 4);
#pragma unroll
                    for (int e = 0; e < 4; ++e) { if (s0 + e > t) w0[e] = 0.f; if (s0 + 4 + e > t) w1[e] = 0.f; }
                    const bf16x8 a = pack8(w0, w1);
#pragma unroll
                    for (int db = 0; db < 4; ++db) acc[tb][db] = mfma16(a, bb[db], acc[tb][db]);
                }
            }
#pragma unroll
            for (int tb = 0; tb < 8; ++tb) {
                bf16_t uu[4][4];
#pragma unroll
                for (int j = 0; j < 4; ++j)
#pragma unroll
                    for (int db = 0; db < 4; ++db) uu[j][db] = U[(row0 + 16 * tb + 4 * gq + j) * 512 + wave * 64 + 16 * db + r];
#pragma unroll
                for (int j = 0; j < 4; ++j) { const int tt = 16 * tb + 4 * gq + j; const float bsv = Bs[tt];
#pragma unroll
                    for (int db = 0; db < 4; ++db) U[(row0 + tt) * 512 + wave * 64 + 16 * db + r] = f2bf(bf2f(uu[j][db]) * (acc[tb][db][j] + bsv)); }
            }
        }
        __syncthreads();
    }
}

template <bool PASS_C>
__device__ __forceinline__ void gla_phase(LAS unsigned char* lds, const Params& p, int l, int tid, int wave, int lane) {
    unsigned char* ws = launder(PP(ws)); tid = vlaunder(wave * 64 + lane_id_()); lane = tid & 63;
    const bf16_t* GQ = (const bf16_t*)(ws + WS_GQ); const bf16_t* GK = (const bf16_t*)(ws + WS_GK); const bf16_t* GV = (const bf16_t*)(ws + WS_GV);
    bf16_t* GR = (bf16_t*)(ws + WS_GR); const float* GD = (const float*)(ws + WS_GDOWN); float* UPD = (float*)(ws + WS_UPD); float* DEC = (float*)(ws + WS_DEC);
    LAS float* sCum = (LAS float*)lds;
    LAS float* sTot = (LAS float*)(lds + 16384);
    LAS bf16_t* sQD = (LAS bf16_t*)(lds + 18432);
    LAS bf16_t* sKI = (LAS bf16_t*)(lds + 27648);
    LAS bf16_t* sKEt = (LAS bf16_t*)(lds + 36864);
    LAS bf16_t* sVt = (LAS bf16_t*)(lds + 46080);
    LAS bf16_t* sAT = (LAS bf16_t*)(lds + 64512);
    LAS bf16_t* sSt = (LAS bf16_t*)(lds + 73728);
    LAS float* sSS = (LAS float*)(lds + 92160);
    const int r = lane & 15, gq = lane >> 4;
    const float* wgup = launder(PP(gla_w_gup)) + l * 16 * 256; const float* bgate = launder(PP(gla_b_gate)) + l * 256; const float* ng = launder(PP(gla_norm_g)) + l * 128;
    for (int u = blockIdx.x; u < BATCH * 4 * 64; u += gridDim.x) {
        const int b = u >> 8, h = (u >> 6) & 3, n = u & 63;
        const size_t r0 = (size_t)b * SEQ + n * 64;
        const int t_ = tid >> 3, k8 = (tid & 7) * 8;
        const u32x4 kw = *(const u32x4*)(GK + (r0 + t_) * 256 + h * 64 + k8);
        const u32x4 gv0 = *(const u32x4*)(GV + (r0 + (tid >> 3)) * 512 + h * 128 + 16 * (tid & 7)), gv1 = *(const u32x4*)(GV + (r0 + (tid >> 3)) * 512 + h * 128 + 16 * (tid & 7) + 8);
        u32x4 qw = (u32x4){0u, 0u, 0u, 0u}; f32x4 st0 = (f32x4){0.f, 0.f, 0.f, 0.f}, st1 = st0, st2 = st0, st3 = st0; bf16_t gg[4][4];
        if (PASS_C) {
            qw = *(const u32x4*)(GQ + (r0 + t_) * 256 + h * 64 + k8);
            const f32x4* sp = (const f32x4*)(UPD + ((size_t)u * 128 + (tid >> 2)) * 64 + (tid & 3) * 16); st0 = sp[0]; st1 = sp[1]; st2 = sp[2]; st3 = sp[3];
#pragma unroll
            for (int j = 0; j < 4; ++j)
#pragma unroll
                for (int i = 0; i < 4; ++i) gg[j][i] = GR[(r0 + 16 * (wave & 3) + 4 * gq + j) * 512 + h * 128 + 16 * (4 * (wave >> 2) + i) + r];
        }
        {
            const f32x4* gdp = (const f32x4*)(GD + (r0 + t_) * 16);
            const f32x4 g0 = gdp[0], g1 = gdp[1], g2 = gdp[2], g3 = gdp[3];
            const float gd[16] = {g0[0], g0[1], g0[2], g0[3], g1[0], g1[1], g1[2], g1[3], g2[0], g2[1], g2[2], g2[3], g3[0], g3[1], g3[2], g3[3]};
            f32x4 a0 = *(const f32x4*)(bgate + h * 64 + k8), a1 = *(const f32x4*)(bgate + h * 64 + k8 + 4);
#pragma unroll
            for (int rr = 0; rr < 16; ++rr) { const f32x4 w0 = *(const f32x4*)(wgup + rr * 256 + h * 64 + k8), w1 = *(const f32x4*)(wgup + rr * 256 + h * 64 + k8 + 4); a0 += w0 * gd[rr]; a1 += w1 * gd[rr]; }
            f32x4 o0, o1;
#pragma unroll
            for (int e = 0; e < 4; ++e) { o0[e] = logsig_f(a0[e]) * 0.0625f; o1[e] = logsig_f(a1[e]) * 0.0625f; }
            *(LAS f32x4*)(sCum + t_ * 64 + k8) = o0; *(LAS f32x4*)(sCum + t_ * 64 + k8 + 4) = o1;
        }
        __syncthreads();
        {
            const int k = tid & 63, seg = tid >> 6; float run = 0.f;
#pragma unroll
            for (int i = 0; i < 8; ++i) { run += sCum[(8 * seg + i) * 64 + k]; sCum[(8 * seg + i) * 64 + k] = run; }
            sTot[seg * 64 + k] = run;
            __syncthreads();
            float pre = 0.f;
#pragma unroll
            for (int s = 0; s < 7; ++s) pre += (s < seg) ? sTot[s * 64 + k] : 0.f;
#pragma unroll
            for (int i = 0; i < 8; ++i) sCum[(8 * seg + i) * 64 + k] += pre;
        }
        __syncthreads();
        {
            const f32x4 c0 = *(const LAS f32x4*)(sCum + t_ * 64 + k8), c1 = *(const LAS f32x4*)(sCum + t_ * 64 + k8 + 4);
            const f32x4 e0 = *(const LAS f32x4*)(sCum + 63 * 64 + k8), e1 = *(const LAS f32x4*)(sCum + 63 * 64 + k8 + 4);
            const float kk[8] = {bflo(kw.x), bfhi(kw.x), bflo(kw.y), bfhi(kw.y), bflo(kw.z), bfhi(kw.z), bflo(kw.w), bfhi(kw.w)};
            const float cm[8] = {c0[0], c0[1], c0[2], c0[3], c1[0], c1[1], c1[2], c1[3]};
            const float ce[8] = {e0[0], e0[1], e0[2], e0[3], e1[0], e1[1], e1[2], e1[3]};
            if (PASS_C) {
                const float qq[8] = {bflo(qw.x), bfhi(qw.x), bflo(qw.y), bfhi(qw.y), bflo(qw.z), bfhi(qw.z), bflo(qw.w), bfhi(qw.w)};
                f32x4 qa, qb, ka, kb;
#pragma unroll
                for (int e = 0; e < 4; ++e) { qa[e] = qq[e] * 0.125f * __expf(cm[e]); qb[e] = qq[e + 4] * 0.125f * __expf(cm[e + 4]); ka[e] = kk[e] * __expf(-cm[e]); kb[e] = kk[e + 4] * __expf(-cm[e + 4]); }
                *(LAS bf16x8*)(sQD + t_ * 72 + k8) = pack8(qa, qb); *(LAS bf16x8*)(sKI + t_ * 72 + k8) = pack8(ka, kb);
                const int dv = tid >> 2, kq = (tid & 3) * 16;
                *(LAS bf16x8*)(sSt + dv * 72 + kq) = pack8(st0, st1); *(LAS bf16x8*)(sSt + dv * 72 + kq + 8) = pack8(st2, st3);
            } else {
#pragma unroll
                for (int e = 0; e < 8; ++e) sKEt[(k8 + e) * 72 + t_] = f2bf(kk[e] * __expf(ce[e] - cm[e]));
                if (t_ == 63) {
#pragma unroll
                    for (int e = 0; e < 8; ++e) DEC[(size_t)u * 64 + k8 + e] = __expf(ce[e]);
                }
            }
            const int s = tid >> 3, c = tid & 7;
            const u32x4 v0 = gv0, v1 = gv1;
            LAS bf16_t* vd = sVt + (16 * c) * 72 + s;
            vd[0 * 72] = (bf16_t)(v0.x & 0xffff); vd[1 * 72] = (bf16_t)(v0.x >> 16); vd[2 * 72] = (bf16_t)(v0.y & 0xffff); vd[3 * 72] = (bf16_t)(v0.y >> 16);
            vd[4 * 72] = (bf16_t)(v0.z & 0xffff); vd[5 * 72] = (bf16_t)(v0.z >> 16); vd[6 * 72] = (bf16_t)(v0.w & 0xffff); vd[7 * 72] = (bf16_t)(v0.w >> 16);
            vd[8 * 72] = (bf16_t)(v1.x & 0xffff); vd[9 * 72] = (bf16_t)(v1.x >> 16); vd[10 * 72] = (bf16_t)(v1.y & 0xffff); vd[11 * 72] = (bf16_t)(v1.y >> 16);
            vd[12 * 72] = (bf16_t)(v1.z & 0xffff); vd[13 * 72] = (bf16_t)(v1.z >> 16); vd[14 * 72] = (bf16_t)(v1.w & 0xffff); vd[15 * 72] = (bf16_t)(v1.w >> 16);
        }
        __syncthreads();
        if (!PASS_C) {
#pragma unroll
            for (int kb = 0; kb < 4; ++kb) { f32x4 acc = (f32x4){0.f, 0.f, 0.f, 0.f};
#pragma unroll
                for (int ks = 0; ks < 2; ++ks) { const bf16x8 a = *(const LAS bf16x8*)(sKEt + (16 * kb + r) * 72 + 32 * ks + 8 * gq); const bf16x8 bb = *(const LAS bf16x8*)(sVt + (16 * wave + r) * 72 + 32 * ks + 8 * gq); acc = mfma16(a, bb, acc); }
                *(f32x4*)(UPD + ((size_t)u * 128 + 16 * wave + r) * 64 + 16 * kb + 4 * gq) = acc; }
        } else {
            {
                const int tb = wave >> 1;
#pragma unroll
                for (int i = 0; i < 2; ++i) { const int sb = 2 * (wave & 1) + i;
                    f32x4 acc = (f32x4){0.f, 0.f, 0.f, 0.f};
                    if (sb <= tb) {
#pragma unroll
                        for (int ks = 0; ks < 2; ++ks) { const bf16x8 a = *(const LAS bf16x8*)(sQD + (16 * tb + r) * 72 + 32 * ks + 8 * gq); const bf16x8 bb = *(const LAS bf16x8*)(sKI + (16 * sb + r) * 72 + 32 * ks + 8 * gq); acc = mfma16(a, bb, acc); }
                    }
#pragma unroll
                    for (int j = 0; j < 4; ++j) { const int tt = 16 * tb + 4 * gq + j, ss = 16 * sb + r; sAT[tt * 72 + ss] = f2bf((sb <= tb && ss <= tt) ? acc[j] : 0.f); } }
            }
            __syncthreads();
            const int tb = wave & 3, hv = wave >> 2;
            f32x4 acc[4];
#pragma unroll
            for (int i = 0; i < 4; ++i) { acc[i] = (f32x4){0.f, 0.f, 0.f, 0.f}; const int dvb = 4 * hv + i;
#pragma unroll
                for (int ks = 0; ks < 2; ++ks) {
                    const bf16x8 a1 = *(const LAS bf16x8*)(sAT + (16 * tb + r) * 72 + 32 * ks + 8 * gq); const bf16x8 b1 = *(const LAS bf16x8*)(sVt + (16 * dvb + r) * 72 + 32 * ks + 8 * gq); acc[i] = mfma16(a1, b1, acc[i]);
                    const bf16x8 a2 = *(const LAS bf16x8*)(sQD + (16 * tb + r) * 72 + 32 * ks + 8 * gq); const bf16x8 b2 = *(const LAS bf16x8*)(sSt + (16 * dvb + r) * 72 + 32 * ks + 8 * gq); acc[i] = mfma16(a2, b2, acc[i]);
                } }
            float ss[4];
#pragma unroll
            for (int j = 0; j < 4; ++j) { float q = 0.f;
#pragma unroll
                for (int i = 0; i < 4; ++i) q += acc[i][j] * acc[i][j];
                q += __shfl_xor(q, 1); q += __shfl_xor(q, 2); q += __shfl_xor(q, 4); q += __shfl_xor(q, 8); ss[j] = q; }
            if (r == 0) {
#pragma unroll
                for (int j = 0; j < 4; ++j) sSS[hv * 64 + 16 * tb + 4 * gq + j] = ss[j];
            }
            __syncthreads();
#pragma unroll
            for (int j = 0; j < 4; ++j) { const int tt = 16 * tb + 4 * gq + j; const float rs = __builtin_amdgcn_rsqf((sSS[tt] + sSS[64 + tt]) * (1.f / 128.f) + EPS);
#pragma unroll
                for (int i = 0; i < 4; ++i) { const int dv = 16 * (4 * hv + i) + r; GR[(r0 + tt) * 512 + h * 128 + dv] = f2bf(acc[i][j] * rs * ng[dv] * bf2f(gg[j][i])); } }
        }
        __syncthreads();
    }
}
__device__ __forceinline__ void gla_scan(unsigned char* ws, int wave, int ngt) {
    ws = launder(ws); const int gtid = blockIdx.x * 512 + vlaunder(wave * 64 + lane_id_());
    float* UPD = (float*)(ws + WS_UPD); const float* DEC = (const float*)(ws + WS_DEC);
    for (int e = gtid; e < 32 * 8192; e += ngt) {
        const int bh = e >> 13, rem = e & 8191, dk = rem & 63; float S = 0.f;
#pragma unroll 1
        for (int n0 = 0; n0 < 64; n0 += 16) {
            float uv[16], dv[16];
#pragma unroll
            for (int i = 0; i < 16; ++i) { uv[i] = UPD[((size_t)(bh * 64 + n0 + i)) * 8192 + rem]; dv[i] = DEC[(bh * 64 + n0 + i) * 64 + dk]; }
#pragma unroll
            for (int i = 0; i < 16; ++i) { UPD[((size_t)(bh * 64 + n0 + i)) * 8192 + rem] = S; S = dv[i] * S + uv[i]; }
        }
    }
}
__device__ __forceinline__ void conv_fix(const Params& p, int l, int wave, int ngt) {
    unsigned char* ws = launder(PP(ws)); const int gtid = blockIdx.x * 512 + vlaunder(wave * 64 + lane_id_());
    const float* head = (const float*)(ws + WS_HEAD); const float* tail = (const float*)(ws + WS_TAIL); bf16_t* act = (bf16_t*)(ws + WS_ACT);
    const float* cw = launder(PP(ffn_conv_w)) + (size_t)l * 3 * DFF2; const float* cb = launder(PP(ffn_conv_b)) + (size_t)l * DFF2;
    for (int e = gtid; e < 128 * DFF; e += ngt) {
        const int pm = e / DFF, c = e % DFF, j = c >> 7, cc = c & 127; const int pa = 256 * j + cc, pu = pa + 128;
        const bool first = (pm & 15) == 0;
        const float ta0 = first ? 0.f : tail[((size_t)(pm - 1) * 2 + 0) * DFF2 + pa], ta1 = first ? 0.f : tail[((size_t)(pm - 1) * 2 + 1) * DFF2 + pa];
        const float tu0 = first ? 0.f : tail[((size_t)(pm - 1) * 2 + 0) * DFF2 + pu], tu1 = first ? 0.f : tail[((size_t)(pm - 1) * 2 + 1) * DFF2 + pu];
        const float ha0 = head[((size_t)pm * 2 + 0) * DFF2 + pa], ha1 = head[((size_t)pm * 2 + 1) * DFF2 + pa];
        const float hu0 = head[((size_t)pm * 2 + 0) * DFF2 + pu], hu1 = head[((size_t)pm * 2 + 1) * DFF2 + pu];
        const float wa0 = cw[c], wa1 = cw[DFF2 + c], wa2 = cw[2 * DFF2 + c], ba = cb[c];
        const float wu0 = cw[DFF + c], wu1 = cw[DFF2 + DFF + c], wu2 = cw[2 * DFF2 + DFF + c], bu = cb[DFF + c];
        const float ca0 = ba + wa0 * ta0 + wa1 * ta1 + wa2 * ha0, cu0 = bu + wu0 * tu0 + wu1 * tu1 + wu2 * hu0;
        const float ca1 = ba + wa0 * ta1 + wa1 * ha0 + wa2 * ha1, cu1 = bu + wu0 * tu1 + wu1 * hu0 + wu2 * hu1;
        act[((size_t)pm * 256 + 0) * DFF + c] = f2bf(gelu_tanh_f(ca0) * cu0);
        act[((size_t)pm * 256 + 1) * DFF + c] = f2bf(gelu_tanh_f(ca1) * cu1);
    }
}

#define XB_TMO      128
#define XB_XCNT(j)  (256  + 64 * (j))
#define XB_XSUB(j)  (1280 + 64 * (j))
#define XB_XGEN(j)  (2304 + 64 * (j))
#define XB_TOP      3328
#define XB_TOPGEN   3392
#define XCD_BAR_WORDS 3456
#define XB_SPIN_CAP (1u << 18)

__device__ __forceinline__ unsigned xb_ld(unsigned* p)              { return __hip_atomic_load(p, __ATOMIC_RELAXED, __HIP_MEMORY_SCOPE_AGENT); }
__device__ __forceinline__ unsigned xb_add(unsigned* p, unsigned v) { return __hip_atomic_fetch_add(p, v, __ATOMIC_RELAXED, __HIP_MEMORY_SCOPE_AGENT); }
__device__ __forceinline__ unsigned xb_xcc_id() { return (unsigned)__builtin_amdgcn_s_getreg((3 << 11) | 20) & 0xFu; }
#define XB_SPIN(cond, bar) do { unsigned _sp = 0; while (cond) { __builtin_amdgcn_s_sleep(1); \
    if ((++_sp & 255u) == 0u) { if (xb_ld(&(bar)[XB_TMO])) break; if (_sp > XB_SPIN_CAP) { atomicAdd(&(bar)[XB_TMO], 1u); break; } } } } while (0)

struct XcdBarrier {
    unsigned* bar; unsigned x;
    volatile LAS unsigned* st;
};

__device__ __forceinline__ XcdBarrier xcd_barrier_post(unsigned* bar, volatile LAS unsigned* st, int wave_) {
    XcdBarrier b; b.bar = bar; b.x = xb_xcc_id(); b.st = st;
    if (wave_ == 0 && lane_id_() == 0) (void)xb_add(&bar[XB_XCNT(b.x)], 1u);
    return b;
}
__device__ __forceinline__ void xcd_barrier_complete(unsigned* bar, unsigned x, unsigned& nloc, unsigned& nx) {
    const unsigned G = gridDim.x * gridDim.y * gridDim.z;
    unsigned sum, cnt, mine, sp = 0u;
    for (;;) {
        sum = 0u; cnt = 0u; mine = 0u;
#pragma unroll
        for (unsigned j = 0; j < 16; ++j) { const unsigned c = xb_ld(&bar[XB_XCNT(j)]); sum += c; cnt += (c > 0u) ? 1u : 0u; mine = (j == x) ? c : mine; }
        if (sum == G) break;
        __builtin_amdgcn_s_sleep(1);
        if ((++sp & 255u) == 0u) { if (xb_ld(&bar[XB_TMO])) break; if (sp > XB_SPIN_CAP) { atomicAdd(&bar[XB_TMO], 1u); break; } }
    }
    nloc = mine > 0u ? mine : 1u; nx = cnt > 0u ? cnt : 1u;
}

__device__ __forceinline__ void xcd_barrier(const XcdBarrier& b, int wave_) {
    asm volatile("s_waitcnt vmcnt(0)" ::: "memory");
    __syncthreads();
    if (wave_ == 0 && lane_id_() == 0) {
        unsigned* bar = b.bar;
        __builtin_amdgcn_s_waitcnt(0);
        unsigned nloc = b.st[0], nx = b.st[1];
        if (nloc == 0u) { xcd_barrier_complete(bar, b.x, nloc, nx); b.st[0] = nloc; b.st[1] = nx; }
        const unsigned old = xb_add(&bar[XB_XSUB(b.x)], 1u);
        const unsigned gen = old / nloc;
        if (old + 1u == (gen + 1u) * nloc) {
            __builtin_amdgcn_fence(__ATOMIC_RELEASE, "agent");
            asm volatile("s_waitcnt vmcnt(0)" ::: "memory");
            const unsigned og = xb_add(&bar[XB_TOP], 1u);
            const unsigned tg = og / nx;
            if (og + 1u == (tg + 1u) * nx) xb_add(&bar[XB_TOPGEN], 1u);
            else XB_SPIN(xb_ld(&bar[XB_TOPGEN]) == tg, bar);
            __builtin_amdgcn_fence(__ATOMIC_ACQUIRE, "agent");
            xb_add(&bar[XB_XGEN(b.x)], 1u);
            asm volatile("s_waitcnt vmcnt(0)" ::: "memory");
        } else {
            XB_SPIN(xb_ld(&bar[XB_XGEN(b.x)]) == gen, bar);
            __builtin_amdgcn_fence(__ATOMIC_ACQUIRE, "agent");
            asm volatile("s_waitcnt vmcnt(0)" ::: "memory");
        }
    }
    __syncthreads();
}
#define CG_SYNC() do { asm volatile("s_waitcnt vmcnt(0) lgkmcnt(0)" ::: "memory"); grid.sync(); } while (0)
#define GRID_SYNC() do { for (int rs_ = 0; rs_ < REP_SYNC; ++rs_) { xcd_barrier(xbar, wave); } } while (0)
#define TSTAMP(k) do { if (TS_PHASE >= 0) { const unsigned long long now_ = __builtin_amdgcn_s_memrealtime(); if ((k) == TS_PHASE) tsel += now_ - tprev; tprev = now_; } } while (0)
#ifndef DBG_STOP
#define DBG_STOP 0
#endif
#ifndef REP_GEMM
#define REP_GEMM 1
#endif
#ifndef REP_SYNC
#define REP_SYNC 1
#endif
#ifndef PROBE
#define PROBE 0
#endif
#ifndef TS_PHASE
#define TS_PHASE -1
#endif
#ifndef G2_STAGGER
#define G2_STAGGER 800
#endif
__device__ __forceinline__ void dbg_dump(float* out, const bf16_t* a, const bf16_t* b, const bf16_t* c, int lda) {
    for (size_t e = (size_t)blockIdx.x * 512 + threadIdx.x; e < (size_t)MTOK * DM; e += (size_t)gridDim.x * 512) {
        const size_t m = e >> 10; const int col = (lda == 3072) ? (int)(e & 1023) + 1024 * (int)(m % 3) : (int)(e & 1023) % lda; float v = bf2f(a[m * lda + col]); if (b) v += bf2f(b[m * lda + col]); if (c) v += bf2f(c[m * lda + col]); out[e] = v; }
}
__global__ void __launch_bounds__(512, 2) mega_fwd(Params p) {
    extern __shared__ __attribute__((aligned(16))) unsigned char lds_raw[];
    LAS unsigned char* lds = (LAS unsigned char*)lds_raw;
    cg::grid_group grid = cg::this_grid();
    const int tid = 0, lane = 0, wave = __builtin_amdgcn_readfirstlane((int)threadIdx.x >> 6);
    const int G = gridDim.x, gw = blockIdx.x * 8 + wave, ngw = G * 8, ngt = G * 512;
    unsigned char* ws = PP(ws);
    bf16_t* XN = (bf16_t*)(ws + WS_XN);
    volatile LAS unsigned* misc = (volatile LAS unsigned*)(lds + MISC_OFF);
    if (wave == 0 && lane_id_() < 4) misc[lane_id_()] = 0u;
    __syncthreads();
    const XcdBarrier xbar = xcd_barrier_post((unsigned*)(ws + WS_BAR), misc, wave);

    unsigned long long tprev = (TS_PHASE >= 0) ? __builtin_amdgcn_s_memrealtime() : 0ull, tsel = 0ull;
    convert_weights(p, 0, lds, gw, ngw, wave, lane);
    if (PROBE & 1) convert_weights(p, 0, lds, gw, ngw, wave, lane);
    row_phase<false, false, true, false, false>(PP(x), nullptr, nullptr, nullptr, PP(mix_pre_g), XN, gw, ngw, lane);
    CG_SYNC();
    TSTAMP(0);
    if (DBG_STOP == 8) {
        {
            unsigned char* ws = launder(PP(ws)); bf16_t* XN = (bf16_t*)(ws + WS_XN);
            pg8::Gemm g{XN, (const bf16_t*)(ws + WS_WIN) + (size_t)4352 * 1024, 1024, 1024, 1024, 0, 0}; pg8::StaticOrder S; S.init(MTOK, 3072, G, (int)blockIdx.x);
            pg8::EpiGates E{(bf16_t*)(ws + WS_GATES)}; pg8::gemm_phase(lds, g, S, E, wave);
        }
        GRID_SYNC();
        TSTAMP(1);
        dbg_dump(PP(out), (const bf16_t*)(ws + WS_GATES), nullptr, nullptr, 3072); return;
    }
#pragma unroll 1
    for (int l = 0; l < 2; ++l) {
        {
            unsigned char* ws = launder(PP(ws)); bf16_t* XN = (bf16_t*)(ws + WS_XN);
            pg8::Gemm g{XN, (const bf16_t*)(ws + WS_WIN), 1024, 1024, 1024, 0, 0}; pg8::StaticOrder S; S.init(MTOK, 4352, G, (int)blockIdx.x);
            pg8::EpiG1 E{ws}; for (int rep_ = 0; rep_ < REP_GEMM; ++rep_) pg8::gemm_phase(lds, g, S, E, wave);
        }
        GRID_SYNC();
        TSTAMP(2);
        if (DBG_STOP == 1) { dbg_dump(PP(out), (const bf16_t*)(ws + WS_KA), (const bf16_t*)(ws + WS_SV), (const bf16_t*)(ws + WS_GV), 512); return; }
        if (PROBE & 16) sb_phase(lds, ws, tid, wave, lane, 428 * MiB);
        sb_phase(lds, ws, tid, wave, lane);
        TSTAMP(15);
        sg_phase(lds, p, l, tid, wave, lane);
        TSTAMP(16);
        gla_phase<false>(lds, p, l, tid, wave, lane);
        if (PROBE & 4) gla_phase<false>(lds, p, l, tid, wave, lane);
        GRID_SYNC();
        TSTAMP(3);
        gla_scan(ws, wave, ngt);
        GRID_SYNC();
        TSTAMP(4);
        gla_phase<true>(lds, p, l, tid, wave, lane);
        GRID_SYNC();
        TSTAMP(5);
        if (DBG_STOP == 2) { dbg_dump(PP(out), (const bf16_t*)(ws + WS_QA), (const bf16_t*)(ws + WS_U), (const bf16_t*)(ws + WS_GR), 512); return; }
        {
            unsigned char* ws = launder(PP(ws)); bf16_t* XN = (bf16_t*)(ws + WS_XN);
            pg8::Gemm g{XN, (const bf16_t*)(ws + WS_WIN) + (size_t)4352 * 1024, 1024, 1024, 1024, 0, 0}; pg8::StaticOrder S; S.init(MTOK, 3072, G, (int)blockIdx.x);
            pg8::EpiGates E{(bf16_t*)(ws + WS_GATES)}; for (int rep_ = 0; rep_ < REP_GEMM; ++rep_) pg8::gemm_phase(lds, g, S, E, wave);
        }
        GRID_SYNC();
        TSTAMP(6);
        if (DBG_STOP == 7) { dbg_dump(PP(out), (const bf16_t*)(ws + WS_GATES), nullptr, nullptr, 3072); return; }
        {
            unsigned char* ws = launder(PP(ws)); bf16_t* XN = (bf16_t*)(ws + WS_XN);
            pg8::Gemm g{(const bf16_t*)(ws + WS_QA), (const bf16_t*)(ws + WS_WP), 1536, 512, 1536, 0, (size_t)(32 * MiB)}; pg8::StaticOrder S; S.init(MTOK, 1024, G, (int)blockIdx.x);
            pg8::EpiMerge3 E{(const bf16_t*)(ws + WS_GATES), XN};
            pg8::gemm_merge_phase(lds, g, S, E, wave);
        }
        GRID_SYNC();
        TSTAMP(7);
        if (DBG_STOP == 3) { dbg_dump(PP(out), (const bf16_t*)(ws + WS_XN), nullptr, nullptr, 1024); return; }
        {
            unsigned char* ws = launder(PP(ws)); bf16_t* XN = (bf16_t*)(ws + WS_XN);
            pg8::Gemm g{XN, (const bf16_t*)(ws + WS_WOUT), 1024, 1024, 1024, 0, 0}; pg8::StaticOrder S; S.init(MTOK, 1024, G, (int)blockIdx.x);
            pg8::EpiF32 E{(bf16_t*)(ws + WS_Y32)}; for (int rep_ = 0; rep_ < REP_GEMM; ++rep_) pg8::gemm_phase(lds, g, S, E, wave);
        }
        GRID_SYNC();
        TSTAMP(8);
        if (l == 0) row_phase<true, true, true, false, true>(PP(x), (const bf16_t*)(ws + WS_Y32), PP(mix_post_g), ws + WS_HB, PP(ffn_pre_g), XN, gw, ngw, lane);
        else row_phase<true, true, true, true, true>(ws + WS_HB, (const bf16_t*)(ws + WS_Y32), PP(mix_post_g) + DM, ws + WS_HB, PP(ffn_pre_g) + DM, XN, gw, ngw, lane);
        GRID_SYNC();
        TSTAMP(9);
        if (DBG_STOP == 4) return;
        {
            unsigned char* ws = launder(PP(ws)); bf16_t* XN = (bf16_t*)(ws + WS_XN);
            pg8::Gemm g{XN, (const bf16_t*)(ws + WS_WUP), 1024, 1024, 1024, 0, 0}; pg8::StaticOrder S; S.init(MTOK, DFF2, G, (int)blockIdx.x);
            pg8::EpiConv E{launder(PP(ffn_conv_w)) + (size_t)l * 3 * DFF2, launder(PP(ffn_conv_b)) + (size_t)l * DFF2, (bf16_t*)(ws + WS_ACT), (float*)(ws + WS_HEAD), (float*)(ws + WS_TAIL)};
            for (int rep_ = 0; rep_ < REP_GEMM; ++rep_) pg8::gemm_phase(lds, g, S, E, wave);
        }
        GRID_SYNC();
        TSTAMP(10);
        conv_fix(p, l, wave, ngt);
        GRID_SYNC();
        TSTAMP(11);
        if (DBG_STOP == 5) { dbg_dump(PP(out), (const bf16_t*)(ws + WS_ACT), nullptr, nullptr, 1024); return; }
        {
            unsigned char* ws = launder(PP(ws));
            pg8::Gemm g{(const bf16_t*)(ws + WS_ACT), (const bf16_t*)(ws + WS_WDN), DFF, DFF, DFF, 0, 0}; pg8::StaticOrder S; S.init(MTOK, 1024, G, (int)blockIdx.x);
            pg8::EpiF32 E{(bf16_t*)(ws + WS_Y32B)}; for (int rep_ = 0; rep_ < REP_GEMM; ++rep_) pg8::gemm_phase(lds, g, S, E, wave);
        }
        GRID_SYNC();
        TSTAMP(12);
        if (l == 0) {
            row_phase<true, true, true, true, true>(ws + WS_HB, (const bf16_t*)(ws + WS_Y32B), PP(ffn_post_g), ws + WS_HB, PP(mix_pre_g) + DM, XN, gw, ngw, lane);
            convert_weights(p, 1, lds, gw, ngw, wave, lane);
            if (PROBE & 1) convert_weights(p, 1, lds, gw, ngw, wave, lane);
            GRID_SYNC();
            TSTAMP(13);
            if (DBG_STOP == 6) return;
        } else {
            row_phase<true, true, false, true, false>(ws + WS_HB, (const bf16_t*)(ws + WS_Y32B), PP(ffn_post_g) + DM, PP(out), nullptr, nullptr, gw, ngw, lane);
        }
    }
    if (TS_PHASE >= 0) { TSTAMP(14); if (blockIdx.x == 0 && wave == 0 && lane_id_() == 0) { const unsigned long long t0_ = __builtin_amdgcn_s_memrealtime(); while (__builtin_amdgcn_s_memrealtime() - t0_ < tsel) __builtin_amdgcn_s_sleep(8); } }
}

extern "C" void kernel_launch(void* const* d_in, const int* in_sizes, int n_in, void* d_out, int out_size, void* d_ws, size_t ws_size, hipStream_t stream) {
    static int grid = 0;
    if (grid == 0) {
        if (n_in != 21 || out_size != MTOK * DM || ws_size < WS_END) { fprintf(stderr, "kernel_launch: unexpected shapes (n_in %d, out %d, ws %zu)\n", n_in, out_size, ws_size); grid = -1; return; }
        int dev = 0, cus = 0, per_cu = 0;
        hipGetDevice(&dev); hipDeviceGetAttribute(&cus, hipDeviceAttributeMultiprocessorCount, dev);
        if (hipFuncSetAttribute((const void*)mega_fwd, hipFuncAttributeMaxDynamicSharedMemorySize, LDS_BYTES) != hipSuccess) { fprintf(stderr, "kernel_launch: hipFuncSetAttribute failed\n"); grid = -1; return; }
        if (hipOccupancyMaxActiveBlocksPerMultiprocessor(&per_cu, (const void*)mega_fwd, 512, LDS_BYTES) != hipSuccess || per_cu < 1) { fprintf(stderr, "kernel_launch: occupancy query says %d blocks/CU\n", per_cu); per_cu = 1; }
        (void)hipGetLastError();
        if (cus > 512) cus = 512;
        grid = cus;
    }
    if (grid < 0) return;
    Params p{};
    const float** f = (const float**)&p;
    for (int i = 0; i < 21; ++i) f[i] = (const float*)d_in[i];
    p.out = (float*)d_out; p.ws = (unsigned char*)d_ws;
    (void)hipMemsetAsync(d_ws, 0, 65536, stream);
    void* args[] = {&p};
    hipError_t e = hipLaunchCooperativeKernel((const void*)mega_fwd, dim3(grid), dim3(512), args, LDS_BYTES, stream);
    if (e != hipSuccess) fprintf(stderr, "cooperative launch failed: %s (grid %d)\n", hipGetErrorString(e), grid);
}
```

```cpp
#include <hip/hip_runtime.h>
#include <hip/hip_cooperative_groups.h>
#include <cstdio>
#include <cstdint>
namespace cg = cooperative_groups;

#define LAS __attribute__((address_space(3)))
typedef unsigned short bf16_t;
typedef short bf16x8 __attribute__((ext_vector_type(8)));
typedef float f32x4 __attribute__((ext_vector_type(4)));
typedef unsigned u32x4 __attribute__((ext_vector_type(4)));
typedef unsigned u32x2 __attribute__((ext_vector_type(2)));

constexpr int BATCH = 8, SEQ = 4096, DM = 1024, MTOK = BATCH * SEQ;
constexpr int INW = 7184, DFF = 2816, DFF2 = 5632;
constexpr float EPS = 1e-6f;
constexpr float SB_THR = -106.0f * 1.4426950409f;

constexpr size_t MiB = 1u << 20;
constexpr size_t WS_GDOWN = 1 * MiB;
constexpr size_t WS_DEC = 3 * MiB;
constexpr size_t WS_WIN = 4 * MiB;
constexpr size_t WS_WP = 19 * MiB;
constexpr size_t WS_WOUT = 22 * MiB;
constexpr size_t WS_WUP = 24 * MiB;
constexpr size_t WS_WDN = 35 * MiB;
constexpr size_t WS_XN = 41 * MiB;
constexpr size_t WS_QA = 105 * MiB, WS_U = 137 * MiB, WS_GR = 169 * MiB;
constexpr size_t WS_KA = 201 * MiB, WS_VA = 233 * MiB, WS_SV = 265 * MiB, WS_GV = 297 * MiB;
constexpr size_t WS_GQ = 329 * MiB, WS_GK = 345 * MiB;
constexpr size_t WS_UPD = 361 * MiB;
constexpr size_t WS_GATES = 201 * MiB;
constexpr size_t WS_Y32 = 105 * MiB;
constexpr size_t WS_ACT = 105 * MiB;
constexpr size_t WS_HEAD = 282 * MiB;
constexpr size_t WS_TAIL = 288 * MiB;
constexpr size_t WS_Y32B = 300 * MiB;
constexpr size_t WS_HB = 428 * MiB;
constexpr size_t WS_END = 492 * MiB;

constexpr int LDS_BYTES = 147456;
constexpr int MISC_OFF = 147456 - 64;
constexpr size_t WS_BAR = 0;
constexpr int XT_OFF = 131072;

typedef float f32x2_t __attribute__((ext_vector_type(2)));
typedef __bf16 bf16x2_t __attribute__((ext_vector_type(2)));
__device__ __forceinline__ unsigned cvt_pk_bf16(float lo, float hi) { const f32x2_t v = {lo, hi}; const bf16x2_t b = __builtin_convertvector(v, bf16x2_t); return __builtin_bit_cast(unsigned, b); }
__device__ __forceinline__ float bf2f(unsigned short h) { return __uint_as_float(((unsigned)h) << 16); }
__device__ __forceinline__ float bflo(unsigned w) { return __uint_as_float(w << 16); }
__device__ __forceinline__ float bfhi(unsigned w) { return __uint_as_float(w & 0xffff0000u); }
__device__ __forceinline__ unsigned short f2bf(float f) { return (unsigned short)(cvt_pk_bf16(f, 0.f) & 0xffffu); }
__device__ __forceinline__ bf16x8 pack8(f32x4 a, f32x4 b) {
    u32x4 w; w.x = cvt_pk_bf16(a[0], a[1]); w.y = cvt_pk_bf16(a[2], a[3]); w.z = cvt_pk_bf16(b[0], b[1]); w.w = cvt_pk_bf16(b[2], b[3]);
    return __builtin_bit_cast(bf16x8, w);
}
__device__ __forceinline__ float rcpf_(float x) { return __builtin_amdgcn_rcpf(x); }
__device__ __forceinline__ float gelu_tanh_f(float x) { const float u = 0.7978845608f * (x + 0.044715f * x * x * x); return x * rcpf_(1.f + __expf(-2.f * u)); }
__device__ __forceinline__ float sigmoid_f(float x) { return rcpf_(1.f + __expf(-x)); }
__device__ __forceinline__ float logsig_f(float x) { return fminf(x, 0.f) - __logf(1.f + __expf(-fabsf(x))); }
__device__ __forceinline__ float logsig2_f(float x2) { return fminf(x2, 0.f) - __builtin_amdgcn_logf(1.f + __builtin_amdgcn_exp2f(-fabsf(x2))); }
__device__ __forceinline__ f32x4 mfma16(bf16x8 a, bf16x8 b, f32x4 c) { return __builtin_amdgcn_mfma_f32_16x16x32_bf16(a, b, c, 0, 0, 0); }
__device__ __forceinline__ float wave_sum(float v) {
#pragma unroll
    for (int o = 1; o < 64; o <<= 1) v += __shfl_xor(v, o);
    return v;
}
#define LDS_WAIT() asm volatile("s_waitcnt lgkmcnt(0)" ::: "memory")
template <class T> __device__ __forceinline__ T* launder(T* p) {
    const unsigned long long v = (unsigned long long)p; unsigned lo = __builtin_amdgcn_readfirstlane((unsigned)v), hi = __builtin_amdgcn_readfirstlane((unsigned)(v >> 32));
    asm volatile("" : "+s"(lo), "+s"(hi)); return (T*)(((unsigned long long)hi << 32) | lo); }
__device__ __forceinline__ int lane_id_() { int l = (int)__builtin_amdgcn_mbcnt_hi(~0u, __builtin_amdgcn_mbcnt_lo(~0u, 0u)); asm volatile("" : "+v"(l)); return l; }
__device__ __forceinline__ int vlaunder(int x) { asm volatile("" : "+v"(x)); return x; }
__device__ __forceinline__ float dpp_shr1(float v) { return __builtin_bit_cast(float, __builtin_amdgcn_update_dpp(0, __builtin_bit_cast(int, v), 0x111, 0xf, 0xf, true)); }
__device__ __forceinline__ float dpp_shr2(float v) { return __builtin_bit_cast(float, __builtin_amdgcn_update_dpp(0, __builtin_bit_cast(int, v), 0x112, 0xf, 0xf, true)); }
__device__ __forceinline__ float dpp_shl14(float v) { return __builtin_bit_cast(float, __builtin_amdgcn_update_dpp(0, __builtin_bit_cast(int, v), 0x10E, 0xf, 0xf, true)); }
__device__ __forceinline__ float dpp_shl15(float v) { return __builtin_bit_cast(float, __builtin_amdgcn_update_dpp(0, __builtin_bit_cast(int, v), 0x10F, 0xf, 0xf, true)); }

struct Params {
    const float* x; const float* mix_pre_g; const float* mix_post_g; const float* w_in; const float* sg_ln_g; const float* sg_ln_b; const float* sg_w; const float* sg_b;
    const float* gla_w_gup; const float* gla_b_gate; const float* gla_norm_g; const float* p_a; const float* p_b; const float* p_c; const float* w_out;
    const float* ffn_pre_g; const float* ffn_post_g; const float* ffn_w_up; const float* ffn_conv_w; const float* ffn_conv_b; const float* ffn_w_down;
    float* out; unsigned char* ws;
};
#include <cstddef>
__device__ __forceinline__ const void* karg_(int byte_off) { const char __attribute__((address_space(4)))* ka = (const char __attribute__((address_space(4)))*)__builtin_amdgcn_kernarg_segment_ptr(); return *(const void* const volatile __attribute__((address_space(4)))*)(ka + byte_off); }
#define PP(field) ((decltype(Params::field))karg_((int)offsetof(Params, field)))

namespace pg8 {
constexpr int BM = 256, BK = 64, HALF = 128, HTB = HALF * BK * 2, NXCD = 8, WGM = 8;
__device__ __forceinline__ int lds_byte(int r, int c) { const int st = (r >> 4) * 2 + (c >> 5), rr = r & 15, cc = c & 31, ob = rr * 64 + cc * 2; return st * 1024 + (ob ^ (((ob >> 9) & 1) << 5)); }
__device__ __forceinline__ void stage_rc(int b, int& R, int& C) { const int st = b / 1024, sb = b % 1024, swz = sb ^ (((sb >> 9) & 1) << 5); R = (st >> 1) * 16 + swz / 64; C = (st & 1) * 32 + (swz % 64) / 2; }
__device__ __forceinline__ int perm32(int rho) { const int n = rho >> 4, i = rho & 15; return 8 * (i >> 2) + 4 * n + (i & 3); }

struct Unit { int pm, pn; };
struct Gemm { const bf16_t* A; const bf16_t* Bt; int K, lda, ldb, adiv; size_t astride; };

struct StaticOrder {
    int nM, nN, nwg, G, c;
    __device__ __forceinline__ void init(int M, int N, int G_, int c_) { nM = M / BM; nN = N / BM; nwg = nM * nN; G = G_; c = c_; }
    __device__ __forceinline__ bool next(int i, Unit& u) const {
        const long L = (long)i * G + c; if (L >= nwg) return false;
        int wgid = (int)L; { const int q = nwg / NXCD, r = nwg % NXCD, xcd = wgid % NXCD, off = wgid / NXCD; wgid = (xcd < r ? xcd * (q + 1) : r * (q + 1) + (xcd - r) * q) + off; }
        const int nig = WGM * nN, gid = wgid / nig, fm = gid * WGM, gsz = (nM - fm) < WGM ? (nM - fm) : WGM;
        u.pm = fm + ((wgid % nig) % gsz); u.pn = (wgid % nig) / gsz; return true;
    }
};
struct MergeOrder {
    StaticOrder base;
    __device__ __forceinline__ bool next(int i, Unit& u) const { const int br = i % 3; Unit t; if (!base.next(i / 3, t)) return false; u.pm = t.pm; u.pn = t.pn + 4 * br; return true; }
};

template <class Epi, class Sched>
__device__ __forceinline__ void gemm_phase(LAS unsigned char* lds, const Gemm g, const Sched& S, const Epi& E, int wave_) {
    const int tid = vlaunder(wave_ * 64 + lane_id_()), wid = wave_, lane = tid & 63, wr = wid >> 2, wc = wid & 3, fr = lane & 15, fq = lane >> 4;
    const int K = g.K, nt = K / BK;
    unsigned voffA[2], voffB[2];
#pragma unroll
    for (int i = 0; i < 2; ++i) { int R, C; stage_rc(tid * 16 + i * 8192, R, C); const int Rb = Epi::PERM ? ((R & ~31) + perm32(R & 31)) : R;
        voffA[i] = (unsigned)(R * g.lda + C) * 2u; voffB[i] = (unsigned)(Rb * g.ldb + C) * 2u; }
    const size_t kstep = (size_t)(BK * 2);
    const size_t hstepA = (size_t)HALF * g.lda * 2, hstepB = (size_t)HALF * g.ldb * 2;
    const size_t tstepA = 2 * hstepA, tstepB = 2 * hstepB;
    const unsigned ldsw = (unsigned)wid * 1024u;
    const int aoff = lds_byte(wr * 64 + fr, fq * 8), boff = lds_byte(wc * 32 + fr, fq * 8);
#define PG8_SA(b, h) (((b) * 2 + (h)) * HTB)
#define PG8_SB(b, h) ((4 + (b) * 2 + (h)) * HTB)
#define PG8_STAGE(bufoff, gbase, voff) do { _Pragma("unroll") for (int _i = 0; _i < 2; ++_i) \
        __builtin_amdgcn_global_load_lds((const unsigned*)((const char*)(gbase) + (voff)[_i]), (LAS unsigned*)(lds + (bufoff) + ldsw + _i * 8192), 16, 0, 0); } while (0)
#define PG8_LDA(dst, b, h) do { _Pragma("unroll") for (int m = 0; m < 4; ++m) _Pragma("unroll") for (int k = 0; k < 2; ++k) dst[m][k] = *(const LAS bf16x8*)(lds + PG8_SA(b, h) + aoff + m * 2048 + k * 1024); } while (0)
#define PG8_LDB(dst, b, h) do { _Pragma("unroll") for (int n = 0; n < 2; ++n) _Pragma("unroll") for (int k = 0; k < 2; ++k) dst[n][k] = *(const LAS bf16x8*)(lds + PG8_SB(b, h) + boff + n * 2048 + k * 1024); } while (0)
#define PG8_MMA(ai, bj, At, Bt) do { __builtin_amdgcn_s_setprio(1); _Pragma("unroll") for (int m = 0; m < 4; ++m) _Pragma("unroll") for (int n = 0; n < 2; ++n) _Pragma("unroll") for (int k = 0; k < 2; ++k) \
        acc[ai][bj][m][n] = __builtin_amdgcn_mfma_f32_16x16x32_bf16(Bt[n][k], At[m][k], acc[ai][bj][m][n], 0, 0, 0); __builtin_amdgcn_s_setprio(0); } while (0)
#define PG8_WAIT_V(n) asm volatile("s_waitcnt vmcnt(" #n ")" ::: "memory")
#define PG8_WAIT_L(n) asm volatile("s_waitcnt lgkmcnt(" #n ")" ::: "memory")
#define PG8_BAR __builtin_amdgcn_s_barrier()
#define PG8_SCHED __builtin_amdgcn_sched_barrier(0)
    Unit cur, nxt; int ui = 0;
    (void)S.next(0, cur);
    f32x4 acc[2][2][4][2];
#pragma unroll
    for (int a = 0; a < 2; ++a)
#pragma unroll
        for (int b = 0; b < 2; ++b)
#pragma unroll
            for (int m = 0; m < 4; ++m)
#pragma unroll
                for (int n = 0; n < 2; ++n) acc[a][b][m][n] = (f32x4){0.f, 0.f, 0.f, 0.f};
    bf16x8 At[4][2], B0[2][2], B1[2][2];
    const char* cA = (const char*)g.A + (size_t)cur.pm * tstepA + (g.adiv ? (size_t)(cur.pn / g.adiv) * g.astride : 0);
    const char* cB = (const char*)g.Bt + (size_t)cur.pn * tstepB;
    PG8_STAGE(PG8_SB(0, 0), cB, voffB); PG8_STAGE(PG8_SB(0, 1), cB + hstepB, voffB); PG8_STAGE(PG8_SA(0, 0), cA, voffA); PG8_STAGE(PG8_SA(0, 1), cA + hstepA, voffA);
    if (wr == 1) PG8_BAR;
    PG8_WAIT_V(2); PG8_BAR;
    PG8_STAGE(PG8_SB(1, 0), cB + kstep, voffB); PG8_STAGE(PG8_SA(1, 0), cA + kstep, voffA); PG8_STAGE(PG8_SB(1, 1), cB + hstepB + kstep, voffB);
    PG8_WAIT_V(6); PG8_BAR;
    for (;;) {
        const bool has_next = S.next(ui + 1, nxt);
        const char* nA = has_next ? (const char*)g.A + (size_t)nxt.pm * tstepA + (g.adiv ? (size_t)(nxt.pn / g.adiv) * g.astride : 0) : cA;
        const char* nB = has_next ? (const char*)g.Bt + (size_t)nxt.pn * tstepB : cB;
        for (int t = 0; t < nt; t += 2) {
            const bool last = (t == nt - 2);
            const char* a1 = cA + (size_t)(t + 1) * kstep;
            const char* a2 = last ? nA : cA + (size_t)(t + 2) * kstep; const char* b2 = last ? nB : cB + (size_t)(t + 2) * kstep;
            const char* a3 = a2 + kstep; const char* b3 = b2 + kstep;
            PG8_LDB(B0, 0, 0); PG8_LDB(B1, 0, 1); PG8_SCHED; PG8_LDA(At, 0, 0); PG8_STAGE(PG8_SA(1, 1), a1 + hstepA, voffA);
            PG8_WAIT_V(8); PG8_WAIT_L(0); PG8_BAR; PG8_MMA(0, 0, At, B0); PG8_MMA(0, 1, At, B1); PG8_BAR; PG8_SCHED;
            PG8_LDA(At, 0, 1); PG8_STAGE(PG8_SB(0, 0), b2, voffB); PG8_STAGE(PG8_SB(0, 1), b2 + hstepB, voffB); PG8_STAGE(PG8_SA(0, 0), a2, voffA);
            PG8_WAIT_V(8); PG8_WAIT_L(0); PG8_BAR; PG8_MMA(1, 0, At, B0); PG8_MMA(1, 1, At, B1); PG8_BAR; PG8_SCHED;
            PG8_LDB(B0, 1, 0); PG8_LDB(B1, 1, 1); PG8_SCHED; PG8_LDA(At, 1, 0); PG8_STAGE(PG8_SA(0, 1), a2 + hstepA, voffA);
            PG8_WAIT_V(8); PG8_WAIT_L(0); PG8_BAR; PG8_MMA(0, 0, At, B0); PG8_MMA(0, 1, At, B1); PG8_BAR; PG8_SCHED;
            PG8_LDA(At, 1, 1); PG8_STAGE(PG8_SB(1, 0), b3, voffB); PG8_STAGE(PG8_SB(1, 1), b3 + hstepB, voffB); PG8_STAGE(PG8_SA(1, 0), a3, voffA);
            PG8_WAIT_V(8); PG8_WAIT_L(0); PG8_BAR; PG8_MMA(1, 0, At, B0); PG8_MMA(1, 1, At, B1); PG8_BAR; PG8_SCHED;
        }
        if (wr == 0) PG8_BAR;
        E(acc, cur, wr, wc, fr, fq, lds);
        if (!has_next) break;
#pragma unroll
        for (int a = 0; a < 2; ++a)
#pragma unroll
            for (int b = 0; b < 2; ++b)
#pragma unroll
                for (int m = 0; m < 4; ++m)
#pragma unroll
                    for (int n = 0; n < 2; ++n) acc[a][b][m][n] = (f32x4){0.f, 0.f, 0.f, 0.f};
        cur = nxt; cA = nA; cB = nB; ++ui;
        if (wr == 1) PG8_BAR;
    }
    PG8_WAIT_V(0);
    PG8_BAR;
#undef PG8_SA
#undef PG8_SB
#undef PG8_STAGE
#undef PG8_LDA
#undef PG8_LDB
#undef PG8_MMA
#undef PG8_WAIT_V
#undef PG8_WAIT_L
#undef PG8_BAR
#undef PG8_SCHED
}

typedef const f32x4 (&AccRef)[2][2][4][2];

struct EpiG1 {
    static constexpr bool PERM = true;
    unsigned char* ws;
    __device__ __forceinline__ void operator()(f32x4 (&acc)[2][2][4][2], const Unit& u, int wr, int wc, int fr, int fq, LAS unsigned char*) const {
        const int pn = u.pn;
        const int row0 = u.pm * BM + wr * 64 + fr;
        if (pn == 16) {
            if (wc == 0 && fq < 2) { float* G = (float*)(ws + WS_GDOWN);
#pragma unroll
                for (int ai = 0; ai < 2; ++ai)
#pragma unroll
                    for (int m = 0; m < 4; ++m)
#pragma unroll
                        for (int n = 0; n < 2; ++n) *(f32x4*)(G + (size_t)(row0 + ai * HALF + m * 16) * 16 + 8 * fq + 4 * n) = acc[ai][0][m][n]; }
            return;
        }
        size_t off; int ldc = 512, colt, act = 0;
        if (pn < 2) { off = WS_QA; colt = pn * 256; }
        else if (pn < 4) { off = WS_KA; colt = (pn - 2) * 256; }
        else if (pn < 6) { off = WS_VA; colt = (pn - 4) * 256; }
        else if (pn < 8) { off = WS_U; colt = (pn - 6) * 256; act = 1; }
        else if (pn < 10) { off = WS_SV; colt = (pn - 8) * 256; act = 1; }
        else if (pn == 10) { off = WS_GQ; colt = 0; ldc = 256; }
        else if (pn == 11) { off = WS_GK; colt = 0; ldc = 256; }
        else if (pn < 14) { off = WS_GV; colt = (pn - 12) * 256; }
        else { off = WS_GR; colt = (pn - 14) * 256; act = 2; }
        bf16_t* base = (bf16_t*)(ws + off);
        const int col0 = colt + wc * 32 + 8 * fq;
#pragma unroll
        for (int ai = 0; ai < 2; ++ai)
#pragma unroll
            for (int m = 0; m < 4; ++m) { bf16_t* rowp = base + (size_t)(row0 + ai * HALF + m * 16) * ldc + col0;
#pragma unroll
                for (int bj = 0; bj < 2; ++bj) { f32x4 v0 = acc[ai][bj][m][0], v1 = acc[ai][bj][m][1];
                    if (act == 1) {
#pragma unroll
                        for (int e = 0; e < 4; ++e) { v0[e] = gelu_tanh_f(v0[e]); v1[e] = gelu_tanh_f(v1[e]); }
                    } else if (act == 2) {
#pragma unroll
                        for (int e = 0; e < 4; ++e) { v0[e] = v0[e] * sigmoid_f(v0[e]); v1[e] = v1[e] * sigmoid_f(v1[e]); }
                    }
                    u32x4 w; w.x = cvt_pk_bf16(v0[0], v0[1]); w.y = cvt_pk_bf16(v0[2], v0[3]); w.z = cvt_pk_bf16(v1[0], v1[1]); w.w = cvt_pk_bf16(v1[2], v1[3]);
                    *(u32x4*)(rowp + bj * HALF) = w; } }
    }
};
struct EpiGates {
    static constexpr bool PERM = true;
    bf16_t* O;
    __device__ __forceinline__ void operator()(f32x4 (&acc)[2][2][4][2], const Unit& u, int wr, int wc, int fr, int fq, LAS unsigned char*) const {
        const int row0 = u.pm * BM + wr * 64 + fr, col0 = u.pn * BM + wc * 32 + 8 * fq;
#pragma unroll
        for (int ai = 0; ai < 2; ++ai)
#pragma unroll
            for (int m = 0; m < 4; ++m) { bf16_t* rowp = O + (size_t)(row0 + ai * HALF + m * 16) * 3072 + col0;
#pragma unroll
                for (int bj = 0; bj < 2; ++bj) { f32x4 v0 = acc[ai][bj][m][0], v1 = acc[ai][bj][m][1];
#pragma unroll
                    for (int e = 0; e < 4; ++e) { v0[e] = sigmoid_f(v0[e]); v1[e] = sigmoid_f(v1[e]); }
                    u32x4 w; w.x = cvt_pk_bf16(v0[0], v0[1]); w.y = cvt_pk_bf16(v0[2], v0[3]); w.z = cvt_pk_bf16(v1[0], v1[1]); w.w = cvt_pk_bf16(v1[2], v1[3]);
                    *(u32x4*)(rowp + bj * HALF) = w; } }
    }
};
struct EpiMerge {
    static constexpr bool PERM = true;
    const bf16_t* gates; bf16_t* O;
    __device__ __forceinline__ void operator()(f32x4 (&acc)[2][2][4][2], const Unit& u, int wr, int wc, int fr, int fq, LAS unsigned char*) const {
        const int br = u.pn >> 2, ct = u.pn & 3;
        const int row0 = u.pm * BM + wr * 64 + fr, col0 = ct * BM + wc * 32 + 8 * fq;
#pragma unroll
        for (int ai = 0; ai < 2; ++ai)
#pragma unroll
            for (int m = 0; m < 4; ++m) { const size_t row = (size_t)(row0 + ai * HALF + m * 16);
#pragma unroll
                for (int bj = 0; bj < 2; ++bj) { f32x4 v0 = acc[ai][bj][m][0], v1 = acc[ai][bj][m][1];
                    const u32x4 gw = *(const u32x4*)(gates + row * 3072 + br * 1024 + col0 + bj * HALF);
                    v0[0] *= bflo(gw.x); v0[1] *= bfhi(gw.x); v0[2] *= bflo(gw.y); v0[3] *= bfhi(gw.y);
                    v1[0] *= bflo(gw.z); v1[1] *= bfhi(gw.z); v1[2] *= bflo(gw.w); v1[3] *= bfhi(gw.w);
                    bf16_t* op = O + row * 1024 + col0 + bj * HALF;
                    if (br > 0) { const u32x4 pw = *(const u32x4*)op;
                        v0[0] += bflo(pw.x); v0[1] += bfhi(pw.x); v0[2] += bflo(pw.y); v0[3] += bfhi(pw.y);
                        v1[0] += bflo(pw.z); v1[1] += bfhi(pw.z); v1[2] += bflo(pw.w); v1[3] += bfhi(pw.w); }
                    u32x4 w; w.x = cvt_pk_bf16(v0[0], v0[1]); w.y = cvt_pk_bf16(v0[2], v0[3]); w.z = cvt_pk_bf16(v1[0], v1[1]); w.w = cvt_pk_bf16(v1[2], v1[3]);
                    *(u32x4*)op = w; } }
    }
};
struct EpiF32 {
    static constexpr bool PERM = true;
    bf16_t* O;
    __device__ __forceinline__ void operator()(f32x4 (&acc)[2][2][4][2], const Unit& u, int wr, int wc, int fr, int fq, LAS unsigned char*) const {
        const int row0 = u.pm * BM + wr * 64 + fr, col0 = u.pn * BM + wc * 32 + 8 * fq;
#pragma unroll
        for (int ai = 0; ai < 2; ++ai)
#pragma unroll
            for (int m = 0; m < 4; ++m) { bf16_t* rowp = O + (size_t)(row0 + ai * HALF + m * 16) * 1024 + col0;
#pragma unroll
                for (int bj = 0; bj < 2; ++bj) { const f32x4 v0 = acc[ai][bj][m][0], v1 = acc[ai][bj][m][1];
                    u32x4 w; w.x = cvt_pk_bf16(v0[0], v0[1]); w.y = cvt_pk_bf16(v0[2], v0[3]); w.z = cvt_pk_bf16(v1[0], v1[1]); w.w = cvt_pk_bf16(v1[2], v1[3]);
                    *(u32x4*)(rowp + bj * HALF) = w; } }
    }
};
struct EpiConv {
    static constexpr bool PERM = true;
    const float* cw; const float* cb; bf16_t* act; float* head; float* tail;
    __device__ __forceinline__ void operator()(f32x4 (&acc)[2][2][4][2], const Unit& u, int wr, int wc, int fr, int fq, LAS unsigned char* lds) const {
        LAS float* XT = (LAS float*)(lds + XT_OFF);
        const int ccol = wc * 32 + 8 * fq;
        if (fr >= 14) {
#pragma unroll
            for (int ai = 0; ai < 2; ++ai)
#pragma unroll
                for (int bj = 0; bj < 2; ++bj)
#pragma unroll
                    for (int n = 0; n < 2; ++n) *(LAS f32x4*)(XT + ((ai * 2 + wr) * 2 + (fr - 14)) * 256 + bj * HALF + ccol + 4 * n) = acc[ai][bj][3][n];
            if (wr == 1) {
#pragma unroll
                for (int bj = 0; bj < 2; ++bj)
#pragma unroll
                    for (int n = 0; n < 2; ++n) *(f32x4*)(tail + ((size_t)u.pm * 2 + (fr - 14)) * DFF2 + u.pn * BM + bj * HALF + ccol + 4 * n) = acc[1][bj][3][n];
            }
        }
        if (fr < 2 && wr == 0) {
#pragma unroll
            for (int bj = 0; bj < 2; ++bj)
#pragma unroll
                for (int n = 0; n < 2; ++n) *(f32x4*)(head + ((size_t)u.pm * 2 + fr) * DFF2 + u.pn * BM + bj * HALF + ccol + 4 * n) = acc[0][bj][0][n];
        }
        asm volatile("s_waitcnt lgkmcnt(0)" ::: "memory"); __builtin_amdgcn_s_barrier(); asm volatile("" ::: "memory");
#pragma unroll
        for (int n = 0; n < 2; ++n) {
            const int ch = u.pn * HALF + ccol + 4 * n;
            const f32x4 wa0 = *(const f32x4*)(cw + ch), wa1 = *(const f32x4*)(cw + DFF2 + ch), wa2 = *(const f32x4*)(cw + 2 * DFF2 + ch), ba = *(const f32x4*)(cb + ch);
            const f32x4 wu0 = *(const f32x4*)(cw + DFF + ch), wu1 = *(const f32x4*)(cw + DFF2 + DFF + ch), wu2 = *(const f32x4*)(cw + 2 * DFF2 + DFF + ch), bu = *(const f32x4*)(cb + DFF + ch);
#pragma unroll
            for (int ai = 1; ai >= 0; --ai)
#pragma unroll
                for (int m = 3; m >= 0; --m) {
                    f32x4 pa, pu;
                    if (m > 0) { pa = acc[ai][0][m - 1][n]; pu = acc[ai][1][m - 1][n]; }
                    else {
                        const int slot = ai * 2 + wr - 1;
                        if (slot >= 0) { pa = *(const LAS f32x4*)(XT + (slot * 2 + (fr & 1)) * 256 + ccol + 4 * n); pu = *(const LAS f32x4*)(XT + (slot * 2 + (fr & 1)) * 256 + HALF + ccol + 4 * n); }
                        else { pa = (f32x4){0.f, 0.f, 0.f, 0.f}; pu = pa; }
                    }
                    f32x4 xa = acc[ai][0][m][n], xu = acc[ai][1][m][n];
                    asm volatile("" : "+v"(xa), "+v"(xu), "+v"(pa), "+v"(pu));
                    f32x4 res;
#pragma unroll
                    for (int e = 0; e < 4; ++e) {
                        const float a1 = dpp_shr1(xa[e]) + dpp_shl15(pa[e]), a2 = dpp_shr2(xa[e]) + dpp_shl14(pa[e]);
                        const float u1 = dpp_shr1(xu[e]) + dpp_shl15(pu[e]), u2 = dpp_shr2(xu[e]) + dpp_shl14(pu[e]);
                        const float ca = ba[e] + wa0[e] * a2 + wa1[e] * a1 + wa2[e] * xa[e];
                        const float cu = bu[e] + wu0[e] * u2 + wu1[e] * u1 + wu2[e] * xu[e];
                        res[e] = gelu_tanh_f(ca) * cu;
                    }
                    asm volatile("" : "+v"(res));
                    acc[ai][0][m][n] = res;
                }
        }
        const int row0 = u.pm * BM + wr * 64 + fr;
#pragma unroll
        for (int ai = 0; ai < 2; ++ai)
#pragma unroll
            for (int m = 0; m < 4; ++m) { const f32x4 v0 = acc[ai][0][m][0], v1 = acc[ai][0][m][1];
                u32x4 w; w.x = cvt_pk_bf16(v0[0], v0[1]); w.y = cvt_pk_bf16(v0[2], v0[3]); w.z = cvt_pk_bf16(v1[0], v1[1]); w.w = cvt_pk_bf16(v1[2], v1[3]);
                *(u32x4*)(act + (size_t)(row0 + ai * HALF + m * 16) * DFF + u.pn * HALF + ccol) = w; }
    }
};
template <class Epi, class Sched>
__device__ __forceinline__ void gemm_merge_phase(LAS unsigned char* lds, const Gemm g, const Sched& S, const Epi& E, int wave_) {
    const int tid = vlaunder(wave_ * 64 + lane_id_()), wid = wave_, lane = tid & 63, wr = wid >> 2, wc = wid & 3, fr = lane & 15, fq = lane >> 4;
    const int K = g.K, nt = K / BK;
    unsigned voffA[2], voffB[2];
#pragma unroll
    for (int i = 0; i < 2; ++i) { int R, C; stage_rc(tid * 16 + i * 8192, R, C); const int Rb = Epi::PERM ? ((R & ~31) + perm32(R & 31)) : R;
        voffA[i] = (unsigned)(R * g.lda + C) * 2u; voffB[i] = (unsigned)(Rb * g.ldb + C) * 2u; }
    const size_t kstep = (size_t)(BK * 2);
    const size_t hstepA = (size_t)HALF * g.lda * 2, hstepB = (size_t)HALF * g.ldb * 2;
    const size_t tstepA = 2 * hstepA, tstepB = 2 * hstepB;
    const unsigned ldsw = (unsigned)wid * 1024u;
    const int aoff = lds_byte(wr * 64 + fr, fq * 8), boff = lds_byte(wc * 32 + fr, fq * 8);
#define PG8_SA(b, h) (((b) * 2 + (h)) * HTB)
#define PG8_SB(b, h) ((4 + (b) * 2 + (h)) * HTB)
#define PG8_STAGE(bufoff, gbase, voff) do { _Pragma("unroll") for (int _i = 0; _i < 2; ++_i) \
        __builtin_amdgcn_global_load_lds((const unsigned*)((const char*)(gbase) + (voff)[_i]), (LAS unsigned*)(lds + (bufoff) + ldsw + _i * 8192), 16, 0, 0); } while (0)
#define PG8_LDA(dst, b, h) do { _Pragma("unroll") for (int m = 0; m < 4; ++m) _Pragma("unroll") for (int k = 0; k < 2; ++k) dst[m][k] = *(const LAS bf16x8*)(lds + PG8_SA(b, h) + aoff + m * 2048 + k * 1024); } while (0)
#define PG8_LDB(dst, b, h) do { _Pragma("unroll") for (int n = 0; n < 2; ++n) _Pragma("unroll") for (int k = 0; k < 2; ++k) dst[n][k] = *(const LAS bf16x8*)(lds + PG8_SB(b, h) + boff + n * 2048 + k * 1024); } while (0)
#define PG8_MMA(ai, bj, At, Bt) do { __builtin_amdgcn_s_setprio(1); _Pragma("unroll") for (int m = 0; m < 4; ++m) _Pragma("unroll") for (int n = 0; n < 2; ++n) _Pragma("unroll") for (int k = 0; k < 2; ++k) \
        acc[ai][bj][m][n] = __builtin_amdgcn_mfma_f32_16x16x32_bf16(Bt[n][k], At[m][k], acc[ai][bj][m][n], 0, 0, 0); __builtin_amdgcn_s_setprio(0); } while (0)
#define PG8_WAIT_V(n) asm volatile("s_waitcnt vmcnt(" #n ")" ::: "memory")
#define PG8_WAIT_L(n) asm volatile("s_waitcnt lgkmcnt(" #n ")" ::: "memory")
#define PG8_BAR __builtin_amdgcn_s_barrier()
#define PG8_SCHED __builtin_amdgcn_sched_barrier(0)
    Unit cur, nxt; int ui = 0;
    (void)S.next(0, cur);
    f32x4 acc[2][2][4][2];
#pragma unroll
    for (int a = 0; a < 2; ++a)
#pragma unroll
        for (int b = 0; b < 2; ++b)
#pragma unroll
            for (int m = 0; m < 4; ++m)
#pragma unroll
                for (int n = 0; n < 2; ++n) acc[a][b][m][n] = (f32x4){0.f, 0.f, 0.f, 0.f};
    bf16x8 At[4][2], B0[2][2], B1[2][2];
#define PG8_AT(base, t) ((base) + (size_t)((t) >> 3) * g.astride + (size_t)((t) & 7) * kstep)
    const char* cA = (const char*)g.A + (size_t)cur.pm * tstepA;
    const char* cB = (const char*)g.Bt + (size_t)cur.pn * tstepB;
    PG8_STAGE(PG8_SB(0, 0), cB, voffB); PG8_STAGE(PG8_SB(0, 1), cB + hstepB, voffB); PG8_STAGE(PG8_SA(0, 0), cA, voffA); PG8_STAGE(PG8_SA(0, 1), cA + hstepA, voffA);
    if (wr == 1) PG8_BAR;
    PG8_WAIT_V(2); PG8_BAR;
    PG8_STAGE(PG8_SB(1, 0), cB + kstep, voffB); PG8_STAGE(PG8_SA(1, 0), cA + kstep, voffA); PG8_STAGE(PG8_SB(1, 1), cB + hstepB + kstep, voffB);
    PG8_WAIT_V(6); PG8_BAR;
    for (;;) {
        const bool has_next = S.next(ui + 1, nxt);
        const char* nA = has_next ? (const char*)g.A + (size_t)nxt.pm * tstepA : cA;
        const char* nB = has_next ? (const char*)g.Bt + (size_t)nxt.pn * tstepB : cB;
#define PG8_KBODY(t) { \
            const bool last = ((t) == nt - 2); \
            const char* a1 = PG8_AT(cA, t + 1); \
            const char* a2 = last ? nA : PG8_AT(cA, t + 2); const char* b2 = last ? nB : cB + (size_t)(t + 2) * kstep; \
            const char* a3 = last ? nA + kstep : PG8_AT(cA, t + 3); const char* b3 = b2 + kstep; \
            PG8_LDB(B0, 0, 0); PG8_LDB(B1, 0, 1); PG8_SCHED; PG8_LDA(At, 0, 0); PG8_STAGE(PG8_SA(1, 1), a1 + hstepA, voffA); \
            PG8_WAIT_V(8); PG8_WAIT_L(0); PG8_BAR; PG8_MMA(0, 0, At, B0); PG8_MMA(0, 1, At, B1); PG8_BAR; PG8_SCHED; \
            PG8_LDA(At, 0, 1); PG8_STAGE(PG8_SB(0, 0), b2, voffB); PG8_STAGE(PG8_SB(0, 1), b2 + hstepB, voffB); PG8_STAGE(PG8_SA(0, 0), a2, voffA); \
            PG8_WAIT_V(8); PG8_WAIT_L(0); PG8_BAR; PG8_MMA(1, 0, At, B0); PG8_MMA(1, 1, At, B1); PG8_BAR; PG8_SCHED; \
            PG8_LDB(B0, 1, 0); PG8_LDB(B1, 1, 1); PG8_SCHED; PG8_LDA(At, 1, 0); PG8_STAGE(PG8_SA(0, 1), a2 + hstepA, voffA); \
            PG8_WAIT_V(8); PG8_WAIT_L(0); PG8_BAR; PG8_MMA(0, 0, At, B0); PG8_MMA(0, 1, At, B1); PG8_BAR; PG8_SCHED; \
            PG8_LDA(At, 1, 1); PG8_STAGE(PG8_SB(1, 0), b3, voffB); PG8_STAGE(PG8_SB(1, 1), b3 + hstepB, voffB); PG8_STAGE(PG8_SA(1, 0), a3, voffA); \
            PG8_WAIT_V(8); PG8_WAIT_L(0); PG8_BAR; PG8_MMA(1, 0, At, B0); PG8_MMA(1, 1, At, B1); PG8_BAR; PG8_SCHED; \
        }
        for (int t = 0; t < 8; t += 2) PG8_KBODY(t)
        E.hook(acc, cur, 0, wr, wc, fr, fq);
        for (int t = 8; t < 16; t += 2) PG8_KBODY(t)
        E.hook(acc, cur, 1, wr, wc, fr, fq);
        for (int t = 16; t < 24; t += 2) PG8_KBODY(t)
#undef PG8_KBODY
        if (wr == 0) PG8_BAR;
        E(acc, cur, wr, wc, fr, fq, lds);
        if (!has_next) break;
#pragma unroll
        for (int a = 0; a < 2; ++a)
#pragma unroll
            for (int b = 0; b < 2; ++b)
#pragma unroll
                for (int m = 0; m < 4; ++m)
#pragma unroll
                    for (int n = 0; n < 2; ++n) acc[a][b][m][n] = (f32x4){0.f, 0.f, 0.f, 0.f};
        cur = nxt; cA = nA; cB = nB; ++ui;
        if (wr == 1) PG8_BAR;
    }
    PG8_WAIT_V(0);
    PG8_BAR;
#undef PG8_AT
#undef PG8_SA
#undef PG8_SB
#undef PG8_STAGE
#undef PG8_LDA
#undef PG8_LDB
#undef PG8_MMA
#undef PG8_WAIT_V
#undef PG8_WAIT_L
#undef PG8_BAR
#undef PG8_SCHED
}

struct EpiMerge3 {
    static constexpr bool PERM = true;
    const bf16_t* gates; bf16_t* O;
    static __device__ __forceinline__ float cl(float g) { return fmaxf(g, 1e-30f); }
    __device__ __forceinline__ void hook(f32x4 (&acc)[2][2][4][2], const Unit& u, int seam, int wr, int wc, int fr, int fq) const {
        const int row0 = vlaunder(u.pm * BM + wr * 64 + fr), col0 = vlaunder(u.pn * BM + wc * 32 + 8 * fq);
#pragma unroll
        for (int ai = 0; ai < 2; ++ai) {
            u32x4 ga[4][2], gb[4][2];
#pragma unroll
            for (int m = 0; m < 4; ++m)
#pragma unroll
                for (int bj = 0; bj < 2; ++bj) { const bf16_t* gp = gates + (size_t)(row0 + ai * HALF + m * 16) * 3072 + seam * 1024 + col0 + bj * HALF; ga[m][bj] = *(const u32x4*)gp; gb[m][bj] = *(const u32x4*)(gp + 1024); }
#pragma unroll
            for (int m = 0; m < 4; ++m)
#pragma unroll
                for (int bj = 0; bj < 2; ++bj) { const u32x4 a = ga[m][bj], b = gb[m][bj];
                    acc[ai][bj][m][0][0] *= cl(bflo(a.x)) * rcpf_(cl(bflo(b.x))); acc[ai][bj][m][0][1] *= cl(bfhi(a.x)) * rcpf_(cl(bfhi(b.x)));
                    acc[ai][bj][m][0][2] *= cl(bflo(a.y)) * rcpf_(cl(bflo(b.y))); acc[ai][bj][m][0][3] *= cl(bfhi(a.y)) * rcpf_(cl(bfhi(b.y)));
                    acc[ai][bj][m][1][0] *= cl(bflo(a.z)) * rcpf_(cl(bflo(b.z))); acc[ai][bj][m][1][1] *= cl(bfhi(a.z)) * rcpf_(cl(bfhi(b.z)));
                    acc[ai][bj][m][1][2] *= cl(bflo(a.w)) * rcpf_(cl(bflo(b.w))); acc[ai][bj][m][1][3] *= cl(bfhi(a.w)) * rcpf_(cl(bfhi(b.w))); }
            asm volatile("" ::: "memory");
        }
    }
    __device__ __forceinline__ void operator()(f32x4 (&acc)[2][2][4][2], const Unit& u, int wr, int wc, int fr, int fq, LAS unsigned char*) const {
        const int row0 = vlaunder(u.pm * BM + wr * 64 + fr), col0 = vlaunder(u.pn * BM + wc * 32 + 8 * fq);
#pragma unroll
        for (int ai = 0; ai < 2; ++ai) {
            u32x4 gc[4][2];
#pragma unroll
            for (int m = 0; m < 4; ++m)
#pragma unroll
                for (int bj = 0; bj < 2; ++bj) gc[m][bj] = *(const u32x4*)(gates + (size_t)(row0 + ai * HALF + m * 16) * 3072 + 2048 + col0 + bj * HALF);
#pragma unroll
            for (int m = 0; m < 4; ++m)
#pragma unroll
                for (int bj = 0; bj < 2; ++bj) { const u32x4 c = gc[m][bj]; const f32x4 v0 = acc[ai][bj][m][0], v1 = acc[ai][bj][m][1];
                    u32x4 w; w.x = cvt_pk_bf16(v0[0] * cl(bflo(c.x)), v0[1] * cl(bfhi(c.x))); w.y = cvt_pk_bf16(v0[2] * cl(bflo(c.y)), v0[3] * cl(bfhi(c.y)));
                    w.z = cvt_pk_bf16(v1[0] * cl(bflo(c.z)), v1[1] * cl(bfhi(c.z))); w.w = cvt_pk_bf16(v1[2] * cl(bflo(c.w)), v1[3] * cl(bfhi(c.w)));
                    *(u32x4*)(O + (size_t)(row0 + ai * HALF + m * 16) * 1024 + col0 + bj * HALF) = w; }
            asm volatile("" ::: "memory");
        }
    }
};
}

__device__ __forceinline__ void transpose_item(const float* W, int ldsrc, int k0, int nsrc0, bf16_t* WT, int K, int ndst0, LAS float* scr, int lane) {
    float wv[32];
#pragma unroll
    for (int i = 0; i < 32; ++i) wv[i] = W[(size_t)(k0 + 2 * i + (lane >> 5)) * ldsrc + nsrc0 + (lane & 31)];
#pragma unroll
    for (int i = 0; i < 32; ++i) scr[(2 * i + (lane >> 5)) * 33 + (lane & 31)] = wv[i];
    LDS_WAIT(); asm volatile("" ::: "memory");
    const int c = lane & 7;
#pragma unroll
    for (int j = 0; j < 4; ++j) { const int n = (lane >> 3) + 8 * j; const LAS float* s = scr + (8 * c) * 33 + n;
        u32x4 o; o.x = cvt_pk_bf16(s[0 * 33], s[1 * 33]); o.y = cvt_pk_bf16(s[2 * 33], s[3 * 33]); o.z = cvt_pk_bf16(s[4 * 33], s[5 * 33]); o.w = cvt_pk_bf16(s[6 * 33], s[7 * 33]);
        *(u32x4*)(WT + (size_t)(ndst0 + n) * K + k0 + 8 * c) = o; }
    LDS_WAIT(); asm volatile("" ::: "memory");
}
__device__ __forceinline__ void convert_weights(const Params& p, int l, LAS unsigned char* lds, int gw, int ngw, int wave, int lane) {
    lane = vlaunder(lane_id_());
    LAS float* scr = (LAS float*)(lds + wave * 16384);
    unsigned char* ws = launder(PP(ws));
    bf16_t* Win = (bf16_t*)(ws + WS_WIN); bf16_t* WP = (bf16_t*)(ws + WS_WP); bf16_t* WO = (bf16_t*)(ws + WS_WOUT); bf16_t* WU = (bf16_t*)(ws + WS_WUP); bf16_t* WD = (bf16_t*)(ws + WS_WDN);
    const float* w_in = launder(PP(w_in)) + (size_t)l * DM * INW;
    constexpr int I0 = 16 * 128, I1 = 16 * 96, I2 = 8 * 32, I5 = 16 * 32, I6 = 16 * 176, I7 = 44 * 32;
    constexpr int NITEMS = I0 + I1 + 3 * I2 + I5 + I6 + I7;
    for (int it = gw; it < NITEMS; it += ngw) {
        int r = it;
        if (r < I0) { const int kb = r / 128, nb = r % 128; transpose_item(w_in, INW, 64 * kb, 32 * nb, Win, 1024, 32 * nb, scr, lane); continue; } r -= I0;
        if (r < I1) { const int kb = r / 96, nb = r % 96; transpose_item(w_in, INW, 64 * kb, 4112 + 32 * nb, Win, 1024, 4352 + 32 * nb, scr, lane); continue; } r -= I1;
        if (r < 3 * I2) { const int br = r / I2, q = r % I2, kb = q / 32, nb = q % 32;
            const float* src = launder(br == 0 ? PP(p_a) : (br == 1 ? PP(p_b) : PP(p_c))) + (size_t)l * 512 * 1024;
            transpose_item(src, 1024, 64 * kb, 32 * nb, WP + 512 * br, 1536, 32 * nb, scr, lane); continue; } r -= 3 * I2;
        if (r < I5) { const int kb = r / 32, nb = r % 32; transpose_item(launder(PP(w_out)) + (size_t)l * 1024 * 1024, 1024, 64 * kb, 32 * nb, WO, 1024, 32 * nb, scr, lane); continue; } r -= I5;
        if (r < I6) { const int kb = r / 176, nb = r % 176, j = nb >> 3, half = (nb >> 2) & 1, q = nb & 3;
            transpose_item(launder(PP(ffn_w_up)) + (size_t)l * 1024 * DFF2, DFF2, 64 * kb, DFF * half + 128 * j + 32 * q, WU, 1024, 256 * j + 128 * half + 32 * q, scr, lane); continue; } r -= I6;
        { const int kb = r / 32, nb = r % 32; transpose_item(launder(PP(ffn_w_down)) + (size_t)l * DFF * 1024, 1024, 64 * kb, 32 * nb, WD, DFF, 32 * nb, scr, lane); }
    }
    for (int idx = gw * 64 + lane; idx < 256 * 1024; idx += ngw * 64) { const int n = idx >> 10, k = idx & 1023;
        const float v = (n < 16) ? w_in[(size_t)k * INW + 4096 + n] : 0.f; Win[(size_t)(4096 + n) * 1024 + k] = f2bf(v); }
}

constexpr int NRW = 4;
template <bool HAS_Y, bool HAS_OUT, bool HAS_XN, bool HIN_BF, bool HOUT_BF>
__device__ __forceinline__ void row_phase(const void* hin_, const bf16_t* y, const float* gpost, void* hout_, const float* gpre, bf16_t* xn, int gw, int ngw, int lane) {
    hin_ = launder(hin_); y = launder(y); hout_ = launder(hout_); xn = launder(xn); gpost = launder(gpost); gpre = launder(gpre); lane = vlaunder(lane_id_());
    for (int m0 = gw; m0 < MTOK; m0 += NRW * ngw) {
        f32x4 v[NRW][4]; u32x2 hw[NRW][4]; u32x2 yw[NRW][4];
#pragma unroll
        for (int rr_ = 0; rr_ < NRW; ++rr_) { const int m = m0 + rr_ * ngw;
            if (HIN_BF) { const u32x2* hr = (const u32x2*)((const bf16_t*)hin_ + (size_t)m * DM) + lane;
#pragma unroll
                for (int j = 0; j < 4; ++j) hw[rr_][j] = hr[64 * j]; }
            else { const f32x4* hr = (const f32x4*)((const float*)hin_ + (size_t)m * DM) + lane;
#pragma unroll
                for (int j = 0; j < 4; ++j) v[rr_][j] = hr[64 * j]; }
            if (HAS_Y) { const u32x2* yr = (const u32x2*)(y + (size_t)m * DM) + lane;
#pragma unroll
                for (int j = 0; j < 4; ++j) yw[rr_][j] = yr[64 * j]; } }
#pragma unroll
        for (int rr_ = 0; rr_ < NRW; ++rr_) {
            const int m = m0 + rr_ * ngw;
            if (HIN_BF) {
#pragma unroll
                for (int j = 0; j < 4; ++j) v[rr_][j] = (f32x4){bflo(hw[rr_][j].x), bfhi(hw[rr_][j].x), bflo(hw[rr_][j].y), bfhi(hw[rr_][j].y)};
            }
            if (HAS_Y) {
                f32x4 yv[4]; float s = 0.f;
#pragma unroll
                for (int j = 0; j < 4; ++j) { yv[j] = (f32x4){bflo(yw[rr_][j].x), bfhi(yw[rr_][j].x), bflo(yw[rr_][j].y), bfhi(yw[rr_][j].y)}; s += (yv[j].x * yv[j].x + yv[j].y * yv[j].y) + (yv[j].z * yv[j].z + yv[j].w * yv[j].w); }
                const float r = __builtin_amdgcn_rsqf(wave_sum(s) * (1.f / DM) + EPS);
#pragma unroll
                for (int j = 0; j < 4; ++j) { const f32x4 gp = *((const f32x4*)gpost + lane + 64 * j); v[rr_][j] += yv[j] * r * gp; }
            }
            if (HAS_OUT) {
                if (HOUT_BF) { u32x2* ho = (u32x2*)((bf16_t*)hout_ + (size_t)m * DM) + lane;
#pragma unroll
                    for (int j = 0; j < 4; ++j) { u32x2 w; w.x = cvt_pk_bf16(v[rr_][j].x, v[rr_][j].y); w.y = cvt_pk_bf16(v[rr_][j].z, v[rr_][j].w); ho[64 * j] = w;
                        v[rr_][j] = (f32x4){bflo(w.x), bfhi(w.x), bflo(w.y), bfhi(w.y)}; }
                } else { f32x4* ho = (f32x4*)((float*)hout_ + (size_t)m * DM) + lane;
#pragma unroll
                    for (int j = 0; j < 4; ++j) ho[64 * j] = v[rr_][j]; }
            }
            if (HAS_XN) {
                float s = 0.f;
#pragma unroll
                for (int j = 0; j < 4; ++j) s += (v[rr_][j].x * v[rr_][j].x + v[rr_][j].y * v[rr_][j].y) + (v[rr_][j].z * v[rr_][j].z + v[rr_][j].w * v[rr_][j].w);
                const float r = __builtin_amdgcn_rsqf(wave_sum(s) * (1.f / DM) + EPS);
                u32x2* xo = (u32x2*)(xn + (size_t)m * DM) + lane;
#pragma unroll
                for (int j = 0; j < 4; ++j) { const f32x4 g = *((const f32x4*)gpre + lane + 64 * j); const f32x4 o = v[rr_][j] * r * g; u32x2 w; w.x = cvt_pk_bf16(o.x, o.y); w.y = cvt_pk_bf16(o.z, o.w); xo[64 * j] = w; }
            }
        }
    }
}

__device__ __forceinline__ void sb_phase(LAS unsigned char* lds, unsigned char* ws, int tid, int wave, int lane, size_t dst_off = WS_QA) {
    ws = launder(ws); tid = vlaunder(wave * 64 + lane_id_()); lane = tid & 63;
    bf16_t* QA = (bf16_t*)(ws + WS_QA); bf16_t* YA = (bf16_t*)(ws + dst_off); const bf16_t* KA = (const bf16_t*)(ws + WS_KA); const bf16_t* VA = (const bf16_t*)(ws + WS_VA);
    LAS bf16_t* sK = (LAS bf16_t*)lds;
    LAS bf16_t* sVt = (LAS bf16_t*)(lds + 9216);
    const int r = lane & 15, g = lane >> 4;
    for (int u = blockIdx.x; u < BATCH * 8 * 32; u += gridDim.x) {
        const int b = u >> 8, h = (u >> 5) & 7, qb = u & 31;
        const int tq0 = qb * 128 + wave * 16, t = tq0 + r;
        const size_t rowbase = (size_t)b * SEQ;
        bf16x8 qf[2];
#pragma unroll
        for (int ks = 0; ks < 2; ++ks) qf[ks] = *(const bf16x8*)(QA + (rowbase + t) * 512 + h * 64 + 32 * ks + 8 * g);
        f32x4 o[4];
#pragma unroll
        for (int i = 0; i < 4; ++i) o[i] = (f32x4){0.f, 0.f, 0.f, 0.f};
        float carry = 0.f;
        const int skey = tid >> 3, sch = tid & 7;
        u32x4 kv, vv;
        { const size_t goff = (rowbase + (qb * 2 + 1) * 64 + skey) * 512 + h * 64 + 8 * sch; kv = *(const u32x4*)(KA + goff); vv = *(const u32x4*)(VA + goff); }
        for (int kt = qb * 2 + 1; kt >= 0; --kt) {
            {
                const int key = skey, ch = sch;
                *(LAS u32x4*)(sK + key * 72 + 8 * ch) = kv;
                LAS bf16_t* vd = sVt + (8 * ch) * 68 + key;
                vd[0 * 68] = (bf16_t)(vv.x & 0xffff); vd[1 * 68] = (bf16_t)(vv.x >> 16); vd[2 * 68] = (bf16_t)(vv.y & 0xffff); vd[3 * 68] = (bf16_t)(vv.y >> 16);
                vd[4 * 68] = (bf16_t)(vv.z & 0xffff); vd[5 * 68] = (bf16_t)(vv.z >> 16); vd[6 * 68] = (bf16_t)(vv.w & 0xffff); vd[7 * 68] = (bf16_t)(vv.w >> 16);
            }
            __syncthreads();
            if (kt > 0) { const size_t goff = (rowbase + (kt - 1) * 64 + skey) * 512 + h * 64 + 8 * sch; kv = *(const u32x4*)(KA + goff); vv = *(const u32x4*)(VA + goff); }
            const bool wdone = __all(carry < SB_THR);
            const bool active = (kt * 64) < (tq0 + 15) && !wdone;
            if (active) {
                f32x4 s[4];
#pragma unroll
                for (int kb = 0; kb < 4; ++kb) { s[kb] = (f32x4){0.f, 0.f, 0.f, 0.f};
#pragma unroll
                    for (int ks = 0; ks < 2; ++ks) { const bf16x8 a = *(const LAS bf16x8*)(sK + (16 * kb + r) * 72 + 32 * ks + 8 * g); s[kb] = mfma16(a, qf[ks], s[kb]); } }
                f32x4 w[4];
                const float zs = 0.125f * 1.4426950409f;
                if (kt * 64 + 63 < tq0) {
#pragma unroll
                    for (int kb = 3; kb >= 0; --kb) {
                        float l[4], ls[4];
#pragma unroll
                        for (int j = 0; j < 4; ++j) { const float z = s[kb][j] * zs; const float lsz = logsig2_f(z); ls[j] = lsz; l[j] = lsz - z; }
                        const float sg = (l[0] + l[1]) + (l[2] + l[3]);
                        const float a_ = __shfl_xor(sg, 16); const float b_ = sg + a_; const float c_ = __shfl_xor(b_, 32);
                        const float suf = ((g & 1) == 0 ? a_ : 0.f) + ((g & 2) == 0 ? c_ : 0.f);
                        const float t3 = carry + suf, t2 = t3 + l[3], t1 = t2 + l[2], t0 = t1 + l[1];
                        w[kb][0] = __builtin_amdgcn_exp2f(ls[0] + t0); w[kb][1] = __builtin_amdgcn_exp2f(ls[1] + t1);
                        w[kb][2] = __builtin_amdgcn_exp2f(ls[2] + t2); w[kb][3] = __builtin_amdgcn_exp2f(ls[3] + t3);
                        carry += b_ + c_;
                    }
                } else {
#pragma unroll
                    for (int kb = 3; kb >= 0; --kb) {
                        float l[4], ls[4]; bool mk[4];
#pragma unroll
                        for (int j = 0; j < 4; ++j) { const int key = kt * 64 + 16 * kb + 4 * g + j; const float z = s[kb][j] * zs; mk[j] = key < t;
                            const float lsz = logsig2_f(z); ls[j] = lsz; l[j] = mk[j] ? (lsz - z) : 0.f; }
                        const float sg = (l[0] + l[1]) + (l[2] + l[3]);
                        const float a_ = __shfl_xor(sg, 16); const float b_ = sg + a_; const float c_ = __shfl_xor(b_, 32);
                        const float suf = ((g & 1) == 0 ? a_ : 0.f) + ((g & 2) == 0 ? c_ : 0.f);
                        const float t3 = carry + suf, t2 = t3 + l[3], t1 = t2 + l[2], t0 = t1 + l[1];
                        w[kb][0] = mk[0] ? __builtin_amdgcn_exp2f(ls[0] + t0) : 0.f; w[kb][1] = mk[1] ? __builtin_amdgcn_exp2f(ls[1] + t1) : 0.f;
                        w[kb][2] = mk[2] ? __builtin_amdgcn_exp2f(ls[2] + t2) : 0.f; w[kb][3] = mk[3] ? __builtin_amdgcn_exp2f(ls[3] + t3) : 0.f;
                        carry += b_ + c_;
                    }
                }
#pragma unroll
                for (int sI = 0; sI < 2; ++sI) {
                    const bf16x8 pb = pack8(w[2 * sI], w[2 * sI + 1]);
#pragma unroll
                    for (int dvb = 0; dvb < 4; ++dvb) {
                        const LAS bf16_t* vp = sVt + (16 * dvb + r) * 68 + 32 * sI + 4 * g;
                        const u32x2 lo = *(const LAS u32x2*)vp, hi = *(const LAS u32x2*)(vp + 16);
                        u32x4 av; av.x = lo.x; av.y = lo.y; av.z = hi.x; av.w = hi.y;
                        o[dvb] = mfma16(__builtin_bit_cast(bf16x8, av), pb, o[dvb]);
                    }
                }
            }
            const int done = __all(carry < SB_THR) ? 1 : 0;
            if (__syncthreads_and(done)) break;
        }
#pragma unroll
        for (int dvb = 0; dvb < 4; ++dvb) { u32x2 w2; w2.x = cvt_pk_bf16(o[dvb][0], o[dvb][1]); w2.y = cvt_pk_bf16(o[dvb][2], o[dvb][3]);
            *(u32x2*)(YA + (rowbase + t) * 512 + h * 64 + 16 * dvb + 4 * g) = w2; }
        __syncthreads();
    }
}

__device__ __forceinline__ void sg_phase(LAS unsigned char* lds, const Params& p, int l, int tid, int wave, int lane) {
    unsigned char* ws = launder(PP(ws)); tid = vlaunder(wave * 64 + lane_id_()); lane = tid & 63;
    bf16_t* U = (bf16_t*)(ws + WS_U); const bf16_t* SV = (const bf16_t*)(ws + WS_SV);
    LAS bf16_t* sVn = (LAS bf16_t*)(lds + wave * (64 * 136 * 2));
    LAS float* sSt = (LAS float*)(lds + 8 * 64 * 136 * 2);
    const int r = lane & 15, gq = lane >> 4;
    const float* lng = launder(PP(sg_ln_g)) + l * 512; const float* lnb = launder(PP(sg_ln_b)) + l * 512;
    const float* W = launder(PP(sg_w)) + ((size_t)(l * 8 + wave)) * 128 * 128;
    const float* Bs = launder(PP(sg_b)) + (l * 8 + wave) * 128;
    for (int u = blockIdx.x; u < BATCH * 32; u += gridDim.x) {
        const size_t row0 = (size_t)u * 128;
        {
            const int tok = wave * 16 + (lane >> 2);
            const u32x4* sp = (const u32x4*)(SV + (row0 + tok) * 512 + (lane & 3) * 128);
            u32x4 vv[16];
#pragma unroll
            for (int c = 0; c < 16; ++c) vv[c] = sp[c];
            float s = 0.f;
#pragma unroll
            for (int c = 0; c < 16; ++c) s += ((bflo(vv[c].x) + bfhi(vv[c].x)) + (bflo(vv[c].y) + bfhi(vv[c].y))) + ((bflo(vv[c].z) + bfhi(vv[c].z)) + (bflo(vv[c].w) + bfhi(vv[c].w)));
            s += __shfl_xor(s, 1); s += __shfl_xor(s, 2);
            const float mu = s * (1.f / 512.f);
            float q = 0.f;
#pragma unroll
            for (int c = 0; c < 16; ++c) { const float x[8] = {bflo(vv[c].x), bfhi(vv[c].x), bflo(vv[c].y), bfhi(vv[c].y), bflo(vv[c].z), bfhi(vv[c].z), bflo(vv[c].w), bfhi(vv[c].w)};
#pragma unroll
                for (int e = 0; e < 8; ++e) { const float d = x[e] - mu; q += d * d; } }
            q += __shfl_xor(q, 1); q += __shfl_xor(q, 2);
            const float rs = __builtin_amdgcn_rsqf(q * (1.f / 512.f) + EPS);
            if ((lane & 3) == 0) { sSt[tok * 2] = mu; sSt[tok * 2 + 1] = rs; }
        }
        __syncthreads();
#pragma unroll
        for (int i = 0; i < 2; ++i) {
            const int s = lane + 64 * i; const float mu = sSt[s * 2], rs = sSt[s * 2 + 1];
#pragma unroll
            for (int c = 0; c < 8; ++c) {
                const u32x4 vv = *(const u32x4*)(SV + (row0 + s) * 512 + wave * 64 + 8 * c);
                const float x[8] = {bflo(vv.x), bfhi(vv.x), bflo(vv.y), bfhi(vv.y), bflo(vv.z), bfhi(vv.z), bflo(vv.w), bfhi(vv.w)};
                const f32x4 g0 = *(const f32x4*)(lng + wave * 64 + 8 * c), g1 = *(const f32x4*)(lng + wave * 64 + 8 * c + 4);
                const f32x4 b0 = *(const f32x4*)(lnb + wave * 64 + 8 * c), b1 = *(const f32x4*)(lnb + wave * 64 + 8 * c + 4);
#pragma unroll
                for (int e = 0; e < 8; ++e) { const float gg = e < 4 ? g0[e & 3] : g1[e & 3], bb = e < 4 ? b0[e & 3] : b1[e & 3];
                    sVn[(8 * c + e) * 136 + s] = f2bf((x[e] - mu) * rs * gg + bb); }
            }
        }
        __syncthreads();
        {
            f32x4 acc[8][4];
#pragma unroll
            for (int tb = 0; tb < 8; ++tb)
#pragma unroll
                for (int i = 0; i < 4; ++i) acc[tb][i] = (f32x4){0.f, 0.f, 0.f, 0.f};
#pragma unroll
            for (int ks = 0; ks < 4; ++ks) {
                const int s0 = 32 * ks + 8 * gq;
                bf16x8 bb[4];
#pragma unroll
                for (int db = 0; db < 4; ++db) bb[db] = *(const LAS bf16x8*)(sVn + (16 * db + r) * 136 + s0);
#pragma unroll
                for (int tb = 2 * ks; tb < 8; ++tb) {
                    const int t = 16 * tb + r;
                    f32x4 w0 = *(const f32x4*)(W + t * 128 + s0), w1 = *(const f32x4*)(W + t * 128 + s0 + 4);
#pragma unroll
                    for (int e = 0; e < 4; ++e) { if (s0 + e > t) w0[e] = 0.f; if (s0 + 4 + e > t) w1[e] = 0.f; }
                    const bf16x8 a = pack8(w0, w1);
#pragma unroll
                    for (int db = 0; db < 4; ++db) acc[tb][db] = mfma16(a, bb[db], acc[tb][db]);
                }
            }
#pragma unroll
            for (int tb = 0; tb < 8; ++tb) {
                bf16_t uu[4][4];
#pragma unroll
                for (int j = 0; j < 4; ++j)
#pragma unroll
                    for (int db = 0; db < 4; ++db) uu[j][db] = U[(row0 + 16 * tb + 4 * gq + j) * 512 + wave * 64 + 16 * db + r];
#pragma unroll
                for (int j = 0; j < 4; ++j) { const int tt = 16 * tb + 4 * gq + j; const float bsv = Bs[tt];
#pragma unroll
                    for (int db = 0; db < 4; ++db) U[(row0 + tt) * 512 + wave * 64 + 16 * db + r] = f2bf(bf2f(uu[j][db]) * (acc[tb][db][j] + bsv)); }
            }
        }
        __syncthreads();
    }
}

template <bool PASS_C>
__device__ __forceinline__ void gla_phase(LAS unsigned char* lds, const Params& p, int l, int tid, int wave, int lane) {
    unsigned char* ws = launder(PP(ws)); tid = vlaunder(wave * 64 + lane_id_()); lane = tid & 63;
    const bf16_t* GQ = (const bf16_t*)(ws + WS_GQ); const bf16_t* GK = (const bf16_t*)(ws + WS_GK); const bf16_t* GV = (const bf16_t*)(ws + WS_GV);
    bf16_t* GR = (bf16_t*)(ws + WS_GR); const float* GD = (const float*)(ws + WS_GDOWN); float* UPD = (float*)(ws + WS_UPD); float* DEC = (float*)(ws + WS_DEC);
    LAS float* sCum = (LAS float*)lds;
    LAS float* sTot = (LAS float*)(lds + 16384);
    LAS bf16_t* sQD = (LAS bf16_t*)(lds + 18432);
    LAS bf16_t* sKI = (LAS bf16_t*)(lds + 27648);
    LAS bf16_t* sKEt = (LAS bf16_t*)(lds + 36864);
    LAS bf16_t* sVt = (LAS bf16_t*)(lds + 46080);
    LAS bf16_t* sAT = (LAS bf16_t*)(lds + 64512);
    LAS bf16_t* sSt = (LAS bf16_t*)(lds + 73728);
    LAS float* sSS = (LAS float*)(lds + 92160);
    const int r = lane & 15, gq = lane >> 4;
    const float* wgup = launder(PP(gla_w_gup)) + l * 16 * 256; const float* bgate = launder(PP(gla_b_gate)) + l * 256; const float* ng = launder(PP(gla_norm_g)) + l * 128;
    for (int u = blockIdx.x; u < BATCH * 4 * 64; u += gridDim.x) {
        const int b = u >> 8, h = (u >> 6) & 3, n = u & 63;
        const size_t r0 = (size_t)b * SEQ + n * 64;
        const int t_ = tid >> 3, k8 = (tid & 7) * 8;
        const u32x4 kw = *(const u32x4*)(GK + (r0 + t_) * 256 + h * 64 + k8);
        const u32x4 gv0 = *(const u32x4*)(GV + (r0 + (tid >> 3)) * 512 + h * 128 + 16 * (tid & 7)), gv1 = *(const u32x4*)(GV + (r0 + (tid >> 3)) * 512 + h * 128 + 16 * (tid & 7) + 8);
        u32x4 qw = (u32x4){0u, 0u, 0u, 0u}; f32x4 st0 = (f32x4){0.f, 0.f, 0.f, 0.f}, st1 = st0, st2 = st0, st3 = st0; bf16_t gg[4][4];
        if (PASS_C) {
            qw = *(const u32x4*)(GQ + (r0 + t_) * 256 + h * 64 + k8);
            const f32x4* sp = (const f32x4*)(UPD + ((size_t)u * 128 + (tid >> 2)) * 64 + (tid & 3) * 16); st0 = sp[0]; st1 = sp[1]; st2 = sp[2]; st3 = sp[3];
#pragma unroll
            for (int j = 0; j < 4; ++j)
#pragma unroll
                for (int i = 0; i < 4; ++i) gg[j][i] = GR[(r0 + 16 * (wave & 3) + 4 * gq + j) * 512 + h * 128 + 16 * (4 * (wave >> 2) + i) + r];
        }
        {
            const f32x4* gdp = (const f32x4*)(GD + (r0 + t_) * 16);
            const f32x4 g0 = gdp[0], g1 = gdp[1], g2 = gdp[2], g3 = gdp[3];
            const float gd[16] = {g0[0], g0[1], g0[2], g0[3], g1[0], g1[1], g1[2], g1[3], g2[0], g2[1], g2[2], g2[3], g3[0], g3[1], g3[2], g3[3]};
            f32x4 a0 = *(const f32x4*)(bgate + h * 64 + k8), a1 = *(const f32x4*)(bgate + h * 64 + k8 + 4);
#pragma unroll
            for (int rr = 0; rr < 16; ++rr) { const f32x4 w0 = *(const f32x4*)(wgup + rr * 256 + h * 64 + k8), w1 = *(const f32x4*)(wgup + rr * 256 + h * 64 + k8 + 4); a0 += w0 * gd[rr]; a1 += w1 * gd[rr]; }
            f32x4 o0, o1;
#pragma unroll
            for (int e = 0; e < 4; ++e) { o0[e] = logsig_f(a0[e]) * 0.0625f; o1[e] = logsig_f(a1[e]) * 0.0625f; }
            *(LAS f32x4*)(sCum + t_ * 64 + k8) = o0; *(LAS f32x4*)(sCum + t_ * 64 + k8 + 4) = o1;
        }
        __syncthreads();
        {
            const int k = tid & 63, seg = tid >> 6; float run = 0.f;
#pragma unroll
            for (int i = 0; i < 8; ++i) { run += sCum[(8 * seg + i) * 64 + k]; sCum[(8 * seg + i) * 64 + k] = run; }
            sTot[seg * 64 + k] = run;
            __syncthreads();
            float pre = 0.f;
#pragma unroll
            for (int s = 0; s < 7; ++s) pre += (s < seg) ? sTot[s * 64 + k] : 0.f;
#pragma unroll
            for (int i = 0; i < 8; ++i) sCum[(8 * seg + i) * 64 + k] += pre;
        }
        __syncthreads();
        {
            const f32x4 c0 = *(const LAS f32x4*)(sCum + t_ * 64 + k8), c1 = *(const LAS f32x4*)(sCum + t_ * 64 + k8 + 4);
            const f32x4 e0 = *(const LAS f32x4*)(sCum + 63 * 64 + k8), e1 = *(const LAS f32x4*)(sCum + 63 * 64 + k8 + 4);
            const float kk[8] = {bflo(kw.x), bfhi(kw.x), bflo(kw.y), bfhi(kw.y), bflo(kw.z), bfhi(kw.z), bflo(kw.w), bfhi(kw.w)};
            const float cm[8] = {c0[0], c0[1], c0[2], c0[3], c1[0], c1[1], c1[2], c1[3]};
            const float ce[8] = {e0[0], e0[1], e0[2], e0[3], e1[0], e1[1], e1[2], e1[3]};
            if (PASS_C) {
                const float qq[8] = {bflo(qw.x), bfhi(qw.x), bflo(qw.y), bfhi(qw.y), bflo(qw.z), bfhi(qw.z), bflo(qw.w), bfhi(qw.w)};
                f32x4 qa, qb, ka, kb;
#pragma unroll
                for (int e = 0; e < 4; ++e) { qa[e] = qq[e] * 0.125f * __expf(cm[e]); qb[e] = qq[e + 4] * 0.125f * __expf(cm[e + 4]); ka[e] = kk[e] * __expf(-cm[e]); kb[e] = kk[e + 4] * __expf(-cm[e + 4]); }
                *(LAS bf16x8*)(sQD + t_ * 72 + k8) = pack8(qa, qb); *(LAS bf16x8*)(sKI + t_ * 72 + k8) = pack8(ka, kb);
                const int dv = tid >> 2, kq = (tid & 3) * 16;
                *(LAS bf16x8*)(sSt + dv * 72 + kq) = pack8(st0, st1); *(LAS bf16x8*)(sSt + dv * 72 + kq + 8) = pack8(st2, st3);
            } else {
#pragma unroll
                for (int e = 0; e < 8; ++e) sKEt[(k8 + e) * 72 + t_] = f2bf(kk[e] * __expf(ce[e] - cm[e]));
                if (t_ == 63) {
#pragma unroll
                    for (int e = 0; e < 8; ++e) DEC[(size_t)u * 64 + k8 + e] = __expf(ce[e]);
                }
            }
            const int s = tid >> 3, c = tid & 7;
            const u32x4 v0 = gv0, v1 = gv1;
            LAS bf16_t* vd = sVt + (16 * c) * 72 + s;
            vd[0 * 72] = (bf16_t)(v0.x & 0xffff); vd[1 * 72] = (bf16_t)(v0.x >> 16); vd[2 * 72] = (bf16_t)(v0.y & 0xffff); vd[3 * 72] = (bf16_t)(v0.y >> 16);
            vd[4 * 72] = (bf16_t)(v0.z & 0xffff); vd[5 * 72] = (bf16_t)(v0.z >> 16); vd[6 * 72] = (bf16_t)(v0.w & 0xffff); vd[7 * 72] = (bf16_t)(v0.w >> 16);
            vd[8 * 72] = (bf16_t)(v1.x & 0xffff); vd[9 * 72] = (bf16_t)(v1.x >> 16); vd[10 * 72] = (bf16_t)(v1.y & 0xffff); vd[11 * 72] = (bf16_t)(v1.y >> 16);
            vd[12 * 72] = (bf16_t)(v1.z & 0xffff); vd[13 * 72] = (bf16_t)(v1.z >> 16); vd[14 * 72] = (bf16_t)(v1.w & 0xffff); vd[15 * 72] = (bf16_t)(v1.w >> 16);
        }
        __syncthreads();
        if (!PASS_C) {
#pragma unroll
            for (int kb = 0; kb < 4; ++kb) { f32x4 acc = (f32x4){0.f, 0.f, 0.f, 0.f};
#pragma unroll
                for (int ks = 0; ks < 2; ++ks) { const bf16x8 a = *(const LAS bf16x8*)(sKEt + (16 * kb + r) * 72 + 32 * ks + 8 * gq); const bf16x8 bb = *(const LAS bf16x8*)(sVt + (16 * wave + r) * 72 + 32 * ks + 8 * gq); acc = mfma16(a, bb, acc); }
                *(f32x4*)(UPD + ((size_t)u * 128 + 16 * wave + r) * 64 + 16 * kb + 4 * gq) = acc; }
        } else {
            {
                const int tb = wave >> 1;
#pragma unroll
                for (int i = 0; i < 2; ++i) { const int sb = 2 * (wave & 1) + i;
                    f32x4 acc = (f32x4){0.f, 0.f, 0.f, 0.f};
                    if (sb <= tb) {
#pragma unroll
                        for (int ks = 0; ks < 2; ++ks) { const bf16x8 a = *(const LAS bf16x8*)(sQD + (16 * tb + r) * 72 + 32 * ks + 8 * gq); const bf16x8 bb = *(const LAS bf16x8*)(sKI + (16 * sb + r) * 72 + 32 * ks + 8 * gq); acc = mfma16(a, bb, acc); }
                    }
#pragma unroll
                    for (int j = 0; j < 4; ++j) { const int tt = 16 * tb + 4 * gq + j, ss = 16 * sb + r; sAT[tt * 72 + ss] = f2bf((sb <= tb && ss <= tt) ? acc[j] : 0.f); } }
            }
            __syncthreads();
            const int tb = wave & 3, hv = wave >> 2;
            f32x4 acc[4];
#pragma unroll
            for (int i = 0; i < 4; ++i) { acc[i] = (f32x4){0.f, 0.f, 0.f, 0.f}; const int dvb = 4 * hv + i;
#pragma unroll
                for (int ks = 0; ks < 2; ++ks) {
                    const bf16x8 a1 = *(const LAS bf16x8*)(sAT + (16 * tb + r) * 72 + 32 * ks + 8 * gq); const bf16x8 b1 = *(const LAS bf16x8*)(sVt + (16 * dvb + r) * 72 + 32 * ks + 8 * gq); acc[i] = mfma16(a1, b1, acc[i]);
                    const bf16x8 a2 = *(const LAS bf16x8*)(sQD + (16 * tb + r) * 72 + 32 * ks + 8 * gq); const bf16x8 b2 = *(const LAS bf16x8*)(sSt + (16 * dvb + r) * 72 + 32 * ks + 8 * gq); acc[i] = mfma16(a2, b2, acc[i]);
                } }
            float ss[4];
#pragma unroll
            for (int j = 0; j < 4; ++j) { float q = 0.f;
#pragma unroll
                for (int i = 0; i < 4; ++i) q += acc[i][j] * acc[i][j];
                q += __shfl_xor(q, 1); q += __shfl_xor(q, 2); q += __shfl_xor(q, 4); q += __shfl_xor(q, 8); ss[j] = q; }
            if (r == 0) {
#pragma unroll
                for (int j = 0; j < 4; ++j) sSS[hv * 64 + 16 * tb + 4 * gq + j] = ss[j];
            }
            __syncthreads();
#pragma unroll
            for (int j = 0; j < 4; ++j) { const int tt = 16 * tb + 4 * gq + j; const float rs = __builtin_amdgcn_rsqf((sSS[tt] + sSS[64 + tt]) * (1.f / 128.f) + EPS);
#pragma unroll
                for (int i = 0; i < 4; ++i) { const int dv = 16 * (4 * hv + i) + r; GR[(r0 + tt) * 512 + h * 128 + dv] = f2bf(acc[i][j] * rs * ng[dv] * bf2f(gg[j][i])); } }
        }
        __syncthreads();
    }
}
__device__ __forceinline__ void gla_scan(unsigned char* ws, int wave, int ngt) {
    ws = launder(ws); const int gtid = blockIdx.x * 512 + vlaunder(wave * 64 + lane_id_());
    float* UPD = (float*)(ws + WS_UPD); const float* DEC = (const float*)(ws + WS_DEC);
    for (int e = gtid; e < 32 * 8192; e += ngt) {
        const int bh = e >> 13, rem = e & 8191, dk = rem & 63; float S = 0.f;
#pragma unroll 1
        for (int n0 = 0; n0 < 64; n0 += 16) {
            float uv[16], dv[16];
#pragma unroll
            for (int i = 0; i < 16; ++i) { uv[i] = UPD[((size_t)(bh * 64 + n0 + i)) * 8192 + rem]; dv[i] = DEC[(bh * 64 + n0 + i) * 64 + dk]; }
#pragma unroll
            for (int i = 0; i < 16; ++i) { UPD[((size_t)(bh * 64 + n0 + i)) * 8192 + rem] = S; S = dv[i] * S + uv[i]; }
        }
    }
}
__device__ __forceinline__ void conv_fix(const Params& p, int l, int wave, int ngt) {
    unsigned char* ws = launder(PP(ws)); const int gtid = blockIdx.x * 512 + vlaunder(wave * 64 + lane_id_());
    const float* head = (const float*)(ws + WS_HEAD); const float* tail = (const float*)(ws + WS_TAIL); bf16_t* act = (bf16_t*)(ws + WS_ACT);
    const float* cw = launder(PP(ffn_conv_w)) + (size_t)l * 3 * DFF2; const float* cb = launder(PP(ffn_conv_b)) + (size_t)l * DFF2;
    for (int e = gtid; e < 128 * DFF; e += ngt) {
        const int pm = e / DFF, c = e % DFF, j = c >> 7, cc = c & 127; const int pa = 256 * j + cc, pu = pa + 128;
        const bool first = (pm & 15) == 0;
        const float ta0 = first ? 0.f : tail[((size_t)(pm - 1) * 2 + 0) * DFF2 + pa], ta1 = first ? 0.f : tail[((size_t)(pm - 1) * 2 + 1) * DFF2 + pa];
        const float tu0 = first ? 0.f : tail[((size_t)(pm - 1) * 2 + 0) * DFF2 + pu], tu1 = first ? 0.f : tail[((size_t)(pm - 1) * 2 + 1) * DFF2 + pu];
        const float ha0 = head[((size_t)pm * 2 + 0) * DFF2 + pa], ha1 = head[((size_t)pm * 2 + 1) * DFF2 + pa];
        const float hu0 = head[((size_t)pm * 2 + 0) * DFF2 + pu], hu1 = head[((size_t)pm * 2 + 1) * DFF2 + pu];
        const float wa0 = cw[c], wa1 = cw[DFF2 + c], wa2 = cw[2 * DFF2 + c], ba = cb[c];
        const float wu0 = cw[DFF + c], wu1 = cw[DFF2 + DFF + c], wu2 = cw[2 * DFF2 + DFF + c], bu = cb[DFF + c];
        const float ca0 = ba + wa0 * ta0 + wa1 * ta1 + wa2 * ha0, cu0 = bu + wu0 * tu0 + wu1 * tu1 + wu2 * hu0;
        const float ca1 = ba + wa0 * ta1 + wa1 * ha0 + wa2 * ha1, cu1 = bu + wu0 * tu1 + wu1 * hu0 + wu2 * hu1;
        act[((size_t)pm * 256 + 0) * DFF + c] = f2bf(gelu_tanh_f(ca0) * cu0);
        act[((size_t)pm * 256 + 1) * DFF + c] = f2bf(gelu_tanh_f(ca1) * cu1);
    }
}

#define XB_TMO      128
#define XB_XCNT(j)  (256  + 64 * (j))
#define XB_XSUB(j)  (1280 + 64 * (j))
#define XB_XGEN(j)  (2304 + 64 * (j))
#define XB_TOP      3328
#define XB_TOPGEN   3392
#define XCD_BAR_WORDS 3456
#define XB_SPIN_CAP (1u << 18)

__device__ __forceinline__ unsigned xb_ld(unsigned* p)              { return __hip_atomic_load(p, __ATOMIC_RELAXED, __HIP_MEMORY_SCOPE_AGENT); }
__device__ __forceinline__ unsigned xb_add(unsigned* p, unsigned v) { return __hip_atomic_fetch_add(p, v, __ATOMIC_RELAXED, __HIP_MEMORY_SCOPE_AGENT); }
__device__ __forceinline__ unsigned xb_xcc_id() { return (unsigned)__builtin_amdgcn_s_getreg((3 << 11) | 20) & 0xFu; }
#define XB_SPIN(cond, bar) do { unsigned _sp = 0; while (cond) { __builtin_amdgcn_s_sleep(1); \
    if ((++_sp & 255u) == 0u) { if (xb_ld(&(bar)[XB_TMO])) break; if (_sp > XB_SPIN_CAP) { atomicAdd(&(bar)[XB_TMO], 1u); break; } } } } while (0)

struct XcdBarrier {
    unsigned* bar; unsigned x;
    volatile LAS unsigned* st;
};

__device__ __forceinline__ XcdBarrier xcd_barrier_post(unsigned* bar, volatile LAS unsigned* st, int wave_) {
    XcdBarrier b; b.bar = bar; b.x = xb_xcc_id(); b.st = st;
    if (wave_ == 0 && lane_id_() == 0) (void)xb_add(&bar[XB_XCNT(b.x)], 1u);
    return b;
}
__device__ __forceinline__ void xcd_barrier_complete(unsigned* bar, unsigned x, unsigned& nloc, unsigned& nx) {
    const unsigned G = gridDim.x * gridDim.y * gridDim.z;
    unsigned sum, cnt, mine, sp = 0u;
    for (;;) {
        sum = 0u; cnt = 0u; mine = 0u;
#pragma unroll
        for (unsigned j = 0; j < 16; ++j) { const unsigned c = xb_ld(&bar[XB_XCNT(j)]); sum += c; cnt += (c > 0u) ? 1u : 0u; mine = (j == x) ? c : mine; }
        if (sum == G) break;
        __builtin_amdgcn_s_sleep(1);
        if ((++sp & 255u) == 0u) { if (xb_ld(&bar[XB_TMO])) break; if (sp > XB_SPIN_CAP) { atomicAdd(&bar[XB_TMO], 1u); break; } }
    }
    nloc = mine > 0u ? mine : 1u; nx = cnt > 0u ? cnt : 1u;
}

__device__ __forceinline__ void xcd_barrier(const XcdBarrier& b, int wave_) {
    asm volatile("s_waitcnt vmcnt(0)" ::: "memory");
    __syncthreads();
    if (wave_ == 0 && lane_id_() == 0) {
        unsigned* bar = b.bar;
        __builtin_amdgcn_s_waitcnt(0);
        unsigned nloc = b.st[0], nx = b.st[1];
        if (nloc == 0u) { xcd_barrier_complete(bar, b.x, nloc, nx); b.st[0] = nloc; b.st[1] = nx; }
        const unsigned old = xb_add(&bar[XB_XSUB(b.x)], 1u);
        const unsigned gen = old / nloc;
        if (old + 1u == (gen + 1u) * nloc) {
            __builtin_amdgcn_fence(__ATOMIC_RELEASE, "agent");
            asm volatile("s_waitcnt vmcnt(0)" ::: "memory");
            const unsigned og = xb_add(&bar[XB_TOP], 1u);
            const unsigned tg = og / nx;
            if (og + 1u == (tg + 1u) * nx) xb_add(&bar[XB_TOPGEN], 1u);
            else XB_SPIN(xb_ld(&bar[XB_TOPGEN]) == tg, bar);
            __builtin_amdgcn_fence(__ATOMIC_ACQUIRE, "agent");
            xb_add(&bar[XB_XGEN(b.x)], 1u);
            asm volatile("s_waitcnt vmcnt(0)" ::: "memory");
        } else {
            XB_SPIN(xb_ld(&bar[XB_XGEN(b.x)]) == gen, bar);
            __builtin_amdgcn_fence(__ATOMIC_ACQUIRE, "agent");
            asm volatile("s_waitcnt vmcnt(0)" ::: "memory");
        }
    }
    __syncthreads();
}
#define CG_SYNC() do { asm volatile("s_waitcnt vmcnt(0) lgkmcnt(0)" ::: "memory"); grid.sync(); } while (0)
#define GRID_SYNC() do { for (int rs_ = 0; rs_ < REP_SYNC; ++rs_) { xcd_barrier(xbar, wave); } } while (0)
#define TSTAMP(k) do { if (TS_PHASE >= 0) { const unsigned long long now_ = __builtin_amdgcn_s_memrealtime(); if ((k) == TS_PHASE) tsel += now_ - tprev; tprev = now_; } } while (0)
#ifndef DBG_STOP
#define DBG_STOP 0
#endif
#ifndef REP_GEMM
#define REP_GEMM 1
#endif
#ifndef REP_SYNC
#define REP_SYNC 1
#endif
#ifndef PROBE
#define PROBE 0
#endif
#ifndef TS_PHASE
#define TS_PHASE -1
#endif
#ifndef G2_STAGGER
#define G2_STAGGER 800
#endif
__device__ __forceinline__ void dbg_dump(float* out, const bf16_t* a, const bf16_t* b, const bf16_t* c, int lda) {
    for (size_t e = (size_t)blockIdx.x * 512 + threadIdx.x; e < (size_t)MTOK * DM; e += (size_t)gridDim.x * 512) {
        const size_t m = e >> 10; const int col = (lda == 3072) ? (int)(e & 1023) + 1024 * (int)(m % 3) : (int)(e & 1023) % lda; float v = bf2f(a[m * lda + col]); if (b) v += bf2f(b[m * lda + col]); if (c) v += bf2f(c[m * lda + col]); out[e] = v; }
}
__global__ void __launch_bounds__(512, 2) mega_fwd(Params p) {
    extern __shared__ __attribute__((aligned(16))) unsigned char lds_raw[];
    LAS unsigned char* lds = (LAS unsigned char*)lds_raw;
    cg::grid_group grid = cg::this_grid();
    const int tid = 0, lane = 0, wave = __builtin_amdgcn_readfirstlane((int)threadIdx.x >> 6);
    const int G = gridDim.x, gw = blockIdx.x * 8 + wave, ngw = G * 8, ngt = G * 512;
    unsigned char* ws = PP(ws);
    bf16_t* XN = (bf16_t*)(ws + WS_XN);
    volatile LAS unsigned* misc = (volatile LAS unsigned*)(lds + MISC_OFF);
    if (wave == 0 && lane_id_() < 4) misc[lane_id_()] = 0u;
    __syncthreads();
    const XcdBarrier xbar = xcd_barrier_post((unsigned*)(ws + WS_BAR), misc, wave);

    unsigned long long tprev = (TS_PHASE >= 0) ? __builtin_amdgcn_s_memrealtime() : 0ull, tsel = 0ull;
    convert_weights(p, 0, lds, gw, ngw, wave, lane);
    if (PROBE & 1) convert_weights(p, 0, lds, gw, ngw, wave, lane);
    row_phase<false, false, true, false, false>(PP(x), nullptr, nullptr, nullptr, PP(mix_pre_g), XN, gw, ngw, lane);
    CG_SYNC();
    TSTAMP(0);
    if (DBG_STOP == 8) {
        {
            unsigned char* ws = launder(PP(ws)); bf16_t* XN = (bf16_t*)(ws + WS_XN);
            pg8::Gemm g{XN, (const bf16_t*)(ws + WS_WIN) + (size_t)4352 * 1024, 1024, 1024, 1024, 0, 0}; pg8::StaticOrder S; S.init(MTOK, 3072, G, (int)blockIdx.x);
            pg8::EpiGates E{(bf16_t*)(ws + WS_GATES)}; pg8::gemm_phase(lds, g, S, E, wave);
        }
        GRID_SYNC();
        TSTAMP(1);
        dbg_dump(PP(out), (const bf16_t*)(ws + WS_GATES), nullptr, nullptr, 3072); return;
    }
#pragma unroll 1
    for (int l = 0; l < 2; ++l) {
        {
            unsigned char* ws = launder(PP(ws)); bf16_t* XN = (bf16_t*)(ws + WS_XN);
            pg8::Gemm g{XN, (const bf16_t*)(ws + WS_WIN), 1024, 1024, 1024, 0, 0}; pg8::StaticOrder S; S.init(MTOK, 4352, G, (int)blockIdx.x);
            pg8::EpiG1 E{ws}; for (int rep_ = 0; rep_ < REP_GEMM; ++rep_) pg8::gemm_phase(lds, g, S, E, wave);
        }
        GRID_SYNC();
        TSTAMP(2);
        if (DBG_STOP == 1) { dbg_dump(PP(out), (const bf16_t*)(ws + WS_KA), (const bf16_t*)(ws + WS_SV), (const bf16_t*)(ws + WS_GV), 512); return; }
        if (PROBE & 16) sb_phase(lds, ws, tid, wave, lane, 428 * MiB);
        sb_phase(lds, ws, tid, wave, lane);
        TSTAMP(15);
        sg_phase(lds, p, l, tid, wave, lane);
        TSTAMP(16);
        gla_phase<false>(lds, p, l, tid, wave, lane);
        if (PROBE & 4) gla_phase<false>(lds, p, l, tid, wave, lane);
        GRID_SYNC();
        TSTAMP(3);
        gla_scan(ws, wave, ngt);
        GRID_SYNC();
        TSTAMP(4);
        gla_phase<true>(lds, p, l, tid, wave, lane);
        GRID_SYNC();
        TSTAMP(5);
        if (DBG_STOP == 2) { dbg_dump(PP(out), (const bf16_t*)(ws + WS_QA), (const bf16_t*)(ws + WS_U), (const bf16_t*)(ws + WS_GR), 512); return; }
        {
            unsigned char* ws = launder(PP(ws)); bf16_t* XN = (bf16_t*)(ws + WS_XN);
            pg8::Gemm g{XN, (const bf16_t*)(ws + WS_WIN) + (size_t)4352 * 1024, 1024, 1024, 1024, 0, 0}; pg8::StaticOrder S; S.init(MTOK, 3072, G, (int)blockIdx.x);
            pg8::EpiGates E{(bf16_t*)(ws + WS_GATES)}; for (int rep_ = 0; rep_ < REP_GEMM; ++rep_) pg8::gemm_phase(lds, g, S, E, wave);
        }
        GRID_SYNC();
        TSTAMP(6);
        if (DBG_STOP == 7) { dbg_dump(PP(out), (const bf16_t*)(ws + WS_GATES), nullptr, nullptr, 3072); return; }
        {
            unsigned char* ws = launder(PP(ws)); bf16_t* XN = (bf16_t*)(ws + WS_XN);
            pg8::Gemm g{(const bf16_t*)(ws + WS_QA), (const bf16_t*)(ws + WS_WP), 1536, 512, 1536, 0, (size_t)(32 * MiB)}; pg8::StaticOrder S; S.init(MTOK, 1024, G, (int)blockIdx.x);
            pg8::EpiMerge3 E{(const bf16_t*)(ws + WS_GATES), XN};
            pg8::gemm_merge_phase(lds, g, S, E, wave);
        }
        GRID_SYNC();
        TSTAMP(7);
        if (DBG_STOP == 3) { dbg_dump(PP(out), (const bf16_t*)(ws + WS_XN), nullptr, nullptr, 1024); return; }
        {
            unsigned char* ws = launder(PP(ws)); bf16_t* XN = (bf16_t*)(ws + WS_XN);
            pg8::Gemm g{XN, (const bf16_t*)(ws + WS_WOUT), 1024, 1024, 1024, 0, 0}; pg8::StaticOrder S; S.init(MTOK, 1024, G, (int)blockIdx.x);
            pg8::EpiF32 E{(bf16_t*)(ws + WS_Y32)}; for (int rep_ = 0; rep_ < REP_GEMM; ++rep_) pg8::gemm_phase(lds, g, S, E, wave);
        }
        GRID_SYNC();
        TSTAMP(8);
        if (l == 0) row_phase<true, true, true, false, true>(PP(x), (const bf16_t*)(ws + WS_Y32), PP(mix_post_g), ws + WS_HB, PP(ffn_pre_g), XN, gw, ngw, lane);
        else row_phase<true, true, true, true, true>(ws + WS_HB, (const bf16_t*)(ws + WS_Y32), PP(mix_post_g) + DM, ws + WS_HB, PP(ffn_pre_g) + DM, XN, gw, ngw, lane);
        GRID_SYNC();
        TSTAMP(9);
        if (DBG_STOP == 4) return;
        {
            unsigned char* ws = launder(PP(ws)); bf16_t* XN = (bf16_t*)(ws + WS_XN);
            pg8::Gemm g{XN, (const bf16_t*)(ws + WS_WUP), 1024, 1024, 1024, 0, 0}; pg8::StaticOrder S; S.init(MTOK, DFF2, G, (int)blockIdx.x);
            pg8::EpiConv E{launder(PP(ffn_conv_w)) + (size_t)l * 3 * DFF2, launder(PP(ffn_conv_b)) + (size_t)l * DFF2, (bf16_t*)(ws + WS_ACT), (float*)(ws + WS_HEAD), (float*)(ws + WS_TAIL)};
            for (int rep_ = 0; rep_ < REP_GEMM; ++rep_) pg8::gemm_phase(lds, g, S, E, wave);
        }
        GRID_SYNC();
        TSTAMP(10);
        conv_fix(p, l, wave, ngt);
        GRID_SYNC();
        TSTAMP(11);
        if (DBG_STOP == 5) { dbg_dump(PP(out), (const bf16_t*)(ws + WS_ACT), nullptr, nullptr, 1024); return; }
        {
            unsigned char* ws = launder(PP(ws));
            pg8::Gemm g{(const bf16_t*)(ws + WS_ACT), (const bf16_t*)(ws + WS_WDN), DFF, DFF, DFF, 0, 0}; pg8::StaticOrder S; S.init(MTOK, 1024, G, (int)blockIdx.x);
            pg8::EpiF32 E{(bf16_t*)(ws + WS_Y32B)}; for (int rep_ = 0; rep_ < REP_GEMM; ++rep_) pg8::gemm_phase(lds, g, S, E, wave);
        }
        GRID_SYNC();
        TSTAMP(12);
        if (l == 0) {
            row_phase<true, true, true, true, true>(ws + WS_HB, (const bf16_t*)(ws + WS_Y32B), PP(ffn_post_g), ws + WS_HB, PP(mix_pre_g) + DM, XN, gw, ngw, lane);
            convert_weights(p, 1, lds, gw, ngw, wave, lane);
            if (PROBE & 1) convert_weights(p, 1, lds, gw, ngw, wave, lane);
            GRID_SYNC();
            TSTAMP(13);
            if (DBG_STOP == 6) return;
        } else {
            row_phase<true, true, false, true, false>(ws + WS_HB, (const bf16_t*)(ws + WS_Y32B), PP(ffn_post_g) + DM, PP(out), nullptr, nullptr, gw, ngw, lane);
        }
    }
    if (TS_PHASE >= 0) { TSTAMP(14); if (blockIdx.x == 0 && wave == 0 && lane_id_() == 0) { const unsigned long long t0_ = __builtin_amdgcn_s_memrealtime(); while (__builtin_amdgcn_s_memrealtime() - t0_ < tsel) __builtin_amdgcn_s_sleep(8); } }
}

extern "C" void kernel_launch(void* const* d_in, const int* in_sizes, int n_in, void* d_out, int out_size, void* d_ws, size_t ws_size, hipStream_t stream) {
    static int grid = 0;
    if (grid == 0) {
        if (n_in != 21 || out_size != MTOK * DM || ws_size < WS_END) { fprintf(stderr, "kernel_launch: unexpected shapes (n_in %d, out %d, ws %zu)\n", n_in, out_size, ws_size); grid = -1; return; }
        int dev = 0, cus = 0, per_cu = 0;
        hipGetDevice(&dev); hipDeviceGetAttribute(&cus, hipDeviceAttributeMultiprocessorCount, dev);
        if (hipFuncSetAttribute((const void*)mega_fwd, hipFuncAttributeMaxDynamicSharedMemorySize, LDS_BYTES) != hipSuccess) { fprintf(stderr, "kernel_launch: hipFuncSetAttribute failed\n"); grid = -1; return; }
        if (hipOccupancyMaxActiveBlocksPerMultiprocessor(&per_cu, (const void*)mega_fwd, 512, LDS_BYTES) != hipSuccess || per_cu < 1) { fprintf(stderr, "kernel_launch: occupancy query says %d blocks/CU\n", per_cu); per_cu = 1; }
        (void)hipGetLastError();
        if (cus > 512) cus = 512;
        grid = cus;
    }
    if (grid < 0) return;
    Params p{};
    const float** f = (const float**)&p;
    for (int i = 0; i < 21; ++i) f[i] = (const float*)d_in[i];
    p.out = (float*)d_out; p.ws = (unsigned char*)d_ws;
    (void)hipMemsetAsync(d_ws, 0, 65536, stream);
    void* args[] = {&p};
    hipError_t e = hipLaunchCooperativeKernel((const void*)mega_fwd, dim3(grid), dim3(512), args, LDS_BYTES, stream);
    if (e != hipSuccess) fprintf(stderr, "cooperative launch failed: %s (grid %d)\n", hipGetErrorString(e), grid);
}
```

```cpp
#include <hip/hip_runtime.h>
#include <hip/hip_cooperative_groups.h>
#include <cstdio>
#include <cstdint>
namespace cg = cooperative_groups;

#define LAS __attribute__((address_space(3)))
typedef unsigned short bf16_t;
typedef short bf16x8 __attribute__((ext_vector_type(8)));
typedef float f32x4 __attribute__((ext_vector_type(4)));
typedef unsigned u32x4 __attribute__((ext_vector_type(4)));
typedef unsigned u32x2 __attribute__((ext_vector_type(2)));

constexpr int BATCH = 8, SEQ = 4096, DM = 1024, MTOK = BATCH * SEQ;
constexpr int INW = 7184, DFF = 2816, DFF2 = 5632;
constexpr float EPS = 1e-6f;
constexpr float SB_THR = 1e-37f;

constexpr size_t MiB = 1u << 20;
constexpr size_t WS_GDOWN = 1 * MiB;
constexpr size_t WS_DEC = 3 * MiB;
constexpr size_t WS_WIN = 4 * MiB;
constexpr size_t WS_WP = 19 * MiB;
constexpr size_t WS_WOUT = 22 * MiB;
constexpr size_t WS_WUP = 24 * MiB;
constexpr size_t WS_WDN = 35 * MiB;
constexpr size_t WS_XN = 41 * MiB;
constexpr size_t WS_QA = 105 * MiB, WS_U = 137 * MiB, WS_GR = 169 * MiB;
constexpr size_t WS_KA = 201 * MiB, WS_VA = 233 * MiB, WS_SV = 265 * MiB, WS_GV = 297 * MiB;
constexpr size_t WS_GQ = 329 * MiB, WS_GK = 345 * MiB;
constexpr size_t WS_UPD = 361 * MiB;
constexpr size_t WS_GATES = 201 * MiB;
constexpr size_t WS_Y32 = 105 * MiB;
constexpr size_t WS_ACT = 105 * MiB;
constexpr size_t WS_HEAD = 282 * MiB;
constexpr size_t WS_TAIL = 288 * MiB;
constexpr size_t WS_Y32B = 300 * MiB;
constexpr size_t WS_HB = 428 * MiB;
constexpr size_t WS_END = 492 * MiB;

constexpr int LDS_BYTES = 147456;
constexpr int MISC_OFF = 147456 - 64;
constexpr size_t WS_BAR = 0;
constexpr int XT_OFF = 131072;

typedef float f32x2_t __attribute__((ext_vector_type(2)));
typedef __bf16 bf16x2_t __attribute__((ext_vector_type(2)));
__device__ __forceinline__ unsigned cvt_pk_bf16(float lo, float hi) { const f32x2_t v = {lo, hi}; const bf16x2_t b = __builtin_convertvector(v, bf16x2_t); return __builtin_bit_cast(unsigned, b); }
__device__ __forceinline__ float bf2f(unsigned short h) { return __uint_as_float(((unsigned)h) << 16); }
__device__ __forceinline__ float bflo(unsigned w) { return __uint_as_float(w << 16); }
__device__ __forceinline__ float bfhi(unsigned w) { return __uint_as_float(w & 0xffff0000u); }
__device__ __forceinline__ unsigned short f2bf(float f) { return (unsigned short)(cvt_pk_bf16(f, 0.f) & 0xffffu); }
__device__ __forceinline__ bf16x8 pack8(f32x4 a, f32x4 b) {
    u32x4 w; w.x = cvt_pk_bf16(a[0], a[1]); w.y = cvt_pk_bf16(a[2], a[3]); w.z = cvt_pk_bf16(b[0], b[1]); w.w = cvt_pk_bf16(b[2], b[3]);
    return __builtin_bit_cast(bf16x8, w);
}
__device__ __forceinline__ float rcpf_(float x) { return __builtin_amdgcn_rcpf(x); }
__device__ __forceinline__ float gelu_tanh_f(float x) { const float u = 0.7978845608f * (x + 0.044715f * x * x * x); return x * rcpf_(1.f + __expf(-2.f * u)); }
__device__ __forceinline__ float sigmoid_f(float x) { return rcpf_(1.f + __expf(-x)); }
__device__ __forceinline__ float logsig_f(float x) { return fminf(x, 0.f) - __logf(1.f + __expf(-fabsf(x))); }
__device__ __forceinline__ float logsig2_f(float x2) { return fminf(x2, 0.f) - __builtin_amdgcn_logf(1.f + __builtin_amdgcn_exp2f(-fabsf(x2))); }
__device__ __forceinline__ f32x4 mfma16(bf16x8 a, bf16x8 b, f32x4 c) { return __builtin_amdgcn_mfma_f32_16x16x32_bf16(a, b, c, 0, 0, 0); }
__device__ __forceinline__ float wave_sum(float v) {
#pragma unroll
    for (int o = 1; o < 64; o <<= 1) v += __shfl_xor(v, o);
    return v;
}
#define LDS_WAIT() asm volatile("s_waitcnt lgkmcnt(0)" ::: "memory")
template <class T> __device__ __forceinline__ T* launder(T* p) {
    const unsigned long long v = (unsigned long long)p; unsigned lo = __builtin_amdgcn_readfirstlane((unsigned)v), hi = __builtin_amdgcn_readfirstlane((unsigned)(v >> 32));
    asm volatile("" : "+s"(lo), "+s"(hi)); return (T*)(((unsigned long long)hi << 32) | lo); }
__device__ __forceinline__ int lane_id_() { int l = (int)__builtin_amdgcn_mbcnt_hi(~0u, __builtin_amdgcn_mbcnt_lo(~0u, 0u)); asm volatile("" : "+v"(l)); return l; }
__device__ __forceinline__ int vlaunder(int x) { asm volatile("" : "+v"(x)); return x; }
__device__ __forceinline__ float dpp_shr1(float v) { return __builtin_bit_cast(float, __builtin_amdgcn_update_dpp(0, __builtin_bit_cast(int, v), 0x111, 0xf, 0xf, true)); }
__device__ __forceinline__ float dpp_shr2(float v) { return __builtin_bit_cast(float, __builtin_amdgcn_update_dpp(0, __builtin_bit_cast(int, v), 0x112, 0xf, 0xf, true)); }
__device__ __forceinline__ float dpp_shl14(float v) { return __builtin_bit_cast(float, __builtin_amdgcn_update_dpp(0, __builtin_bit_cast(int, v), 0x10E, 0xf, 0xf, true)); }
__device__ __forceinline__ float dpp_shl15(float v) { return __builtin_bit_cast(float, __builtin_amdgcn_update_dpp(0, __builtin_bit_cast(int, v), 0x10F, 0xf, 0xf, true)); }

struct Params {
    const float* x; const float* mix_pre_g; const float* mix_post_g; const float* w_in; const float* sg_ln_g; const float* sg_ln_b; const float* sg_w; const float* sg_b;
    const float* gla_w_gup; const float* gla_b_gate; const float* gla_norm_g; const float* p_a; const float* p_b; const float* p_c; const float* w_out;
    const float* ffn_pre_g; const float* ffn_post_g; const float* ffn_w_up; const float* ffn_conv_w; const float* ffn_conv_b; const float* ffn_w_down;
    float* out; unsigned char* ws;
};
#include <cstddef>
__device__ __forceinline__ const void* karg_(int byte_off) { const char __attribute__((address_space(4)))* ka = (const char __attribute__((address_space(4)))*)__builtin_amdgcn_kernarg_segment_ptr(); return *(const void* const volatile __attribute__((address_space(4)))*)(ka + byte_off); }
#define PP(field) ((decltype(Params::field))karg_((int)offsetof(Params, field)))

namespace pg8 {
constexpr int BM = 256, BK = 64, HALF = 128, HTB = HALF * BK * 2, NXCD = 8, WGM = 8;
__device__ __forceinline__ int lds_byte(int r, int c) { const int st = (r >> 4) * 2 + (c >> 5), rr = r & 15, cc = c & 31, ob = rr * 64 + cc * 2; return st * 1024 + (ob ^ (((ob >> 9) & 1) << 5)); }
__device__ __forceinline__ void stage_rc(int b, int& R, int& C) { const int st = b / 1024, sb = b % 1024, swz = sb ^ (((sb >> 9) & 1) << 5); R = (st >> 1) * 16 + swz / 64; C = (st & 1) * 32 + (swz % 64) / 2; }
__device__ __forceinline__ int perm32(int rho) { const int n = rho >> 4, i = rho & 15; return 8 * (i >> 2) + 4 * n + (i & 3); }

struct Unit { int pm, pn; };
struct Gemm { const bf16_t* A; const bf16_t* Bt; int K, lda, ldb, adiv; size_t astride; };

struct StaticOrder {
    int nM, nN, nwg, G, c;
    __device__ __forceinline__ void init(int M, int N, int G_, int c_) { nM = M / BM; nN = N / BM; nwg = nM * nN; G = G_; c = c_; }
    __device__ __forceinline__ bool next(int i, Unit& u) const {
        const long L = (long)i * G + c; if (L >= nwg) return false;
        int wgid = (int)L; { const int q = nwg / NXCD, r = nwg % NXCD, xcd = wgid % NXCD, off = wgid / NXCD; wgid = (xcd < r ? xcd * (q + 1) : r * (q + 1) + (xcd - r) * q) + off; }
        const int nig = WGM * nN, gid = wgid / nig, fm = gid * WGM, gsz = (nM - fm) < WGM ? (nM - fm) : WGM;
        u.pm = fm + ((wgid % nig) % gsz); u.pn = (wgid % nig) / gsz; return true;
    }
};
struct MergeOrder {
    StaticOrder base;
    __device__ __forceinline__ bool next(int i, Unit& u) const { const int br = i % 3; Unit t; if (!base.next(i / 3, t)) return false; u.pm = t.pm; u.pn = t.pn + 4 * br; return true; }
};

template <class Epi, class Sched>
__device__ __forceinline__ void gemm_phase(LAS unsigned char* lds, const Gemm g, const Sched& S, const Epi& E, int wave_) {
    const int tid = vlaunder(wave_ * 64 + lane_id_()), wid = wave_, lane = tid & 63, wr = wid >> 2, wc = wid & 3, fr = lane & 15, fq = lane >> 4;
    const int K = g.K, nt = K / BK;
    unsigned voffA[2], voffB[2];
#pragma unroll
    for (int i = 0; i < 2; ++i) { int R, C; stage_rc(tid * 16 + i * 8192, R, C); const int Rb = Epi::PERM ? ((R & ~31) + perm32(R & 31)) : R;
        voffA[i] = (unsigned)(R * g.lda + C) * 2u; voffB[i] = (unsigned)(Rb * g.ldb + C) * 2u; }
    const size_t kstep = (size_t)(BK * 2);
    const size_t hstepA = (size_t)HALF * g.lda * 2, hstepB = (size_t)HALF * g.ldb * 2;
    const size_t tstepA = 2 * hstepA, tstepB = 2 * hstepB;
    const unsigned ldsw = (unsigned)wid * 1024u;
    const int aoff = lds_byte(wr * 64 + fr, fq * 8), boff = lds_byte(wc * 32 + fr, fq * 8);
#define PG8_SA(b, h) (((b) * 2 + (h)) * HTB)
#define PG8_SB(b, h) ((4 + (b) * 2 + (h)) * HTB)
#define PG8_STAGE(bufoff, gbase, voff) do { _Pragma("unroll") for (int _i = 0; _i < 2; ++_i) \
        __builtin_amdgcn_global_load_lds((const unsigned*)((const char*)(gbase) + (voff)[_i]), (LAS unsigned*)(lds + (bufoff) + ldsw + _i * 8192), 16, 0, 0); } while (0)
#define PG8_LDA(dst, b, h) do { _Pragma("unroll") for (int m = 0; m < 4; ++m) _Pragma("unroll") for (int k = 0; k < 2; ++k) dst[m][k] = *(const LAS bf16x8*)(lds + PG8_SA(b, h) + aoff + m * 2048 + k * 1024); } while (0)
#define PG8_LDB(dst, b, h) do { _Pragma("unroll") for (int n = 0; n < 2; ++n) _Pragma("unroll") for (int k = 0; k < 2; ++k) dst[n][k] = *(const LAS bf16x8*)(lds + PG8_SB(b, h) + boff + n * 2048 + k * 1024); } while (0)
#define PG8_MMA(ai, bj, At, Bt) do { __builtin_amdgcn_s_setprio(1); _Pragma("unroll") for (int m = 0; m < 4; ++m) _Pragma("unroll") for (int n = 0; n < 2; ++n) _Pragma("unroll") for (int k = 0; k < 2; ++k) \
        acc[ai][bj][m][n] = __builtin_amdgcn_mfma_f32_16x16x32_bf16(Bt[n][k], At[m][k], acc[ai][bj][m][n], 0, 0, 0); __builtin_amdgcn_s_setprio(0); } while (0)
#define PG8_WAIT_V(n) asm volatile("s_waitcnt vmcnt(" #n ")" ::: "memory")
#define PG8_WAIT_L(n) asm volatile("s_waitcnt lgkmcnt(" #n ")" ::: "memory")
#define PG8_BAR __builtin_amdgcn_s_barrier()
#define PG8_SCHED __builtin_amdgcn_sched_barrier(0)
    Unit cur, nxt; int ui = 0;
    (void)S.next(0, cur);
    f32x4 acc[2][2][4][2];
#pragma unroll
    for (int a = 0; a < 2; ++a)
#pragma unroll
        for (int b = 0; b < 2; ++b)
#pragma unroll
            for (int m = 0; m < 4; ++m)
#pragma unroll
                for (int n = 0; n < 2; ++n) acc[a][b][m][n] = (f32x4){0.f, 0.f, 0.f, 0.f};
    bf16x8 At[4][2], B0[2][2], B1[2][2];
    const char* cA = (const char*)g.A + (size_t)cur.pm * tstepA + (g.adiv ? (size_t)(cur.pn / g.adiv) * g.astride : 0);
    const char* cB = (const char*)g.Bt + (size_t)cur.pn * tstepB;
    PG8_STAGE(PG8_SB(0, 0), cB, voffB); PG8_STAGE(PG8_SB(0, 1), cB + hstepB, voffB); PG8_STAGE(PG8_SA(0, 0), cA, voffA); PG8_STAGE(PG8_SA(0, 1), cA + hstepA, voffA);
    if (wr == 1) PG8_BAR;
    PG8_WAIT_V(2); PG8_BAR;
    PG8_STAGE(PG8_SB(1, 0), cB + kstep, voffB); PG8_STAGE(PG8_SA(1, 0), cA + kstep, voffA); PG8_STAGE(PG8_SB(1, 1), cB + hstepB + kstep, voffB);
    PG8_WAIT_V(6); PG8_BAR;
    for (;;) {
        const bool has_next = S.next(ui + 1, nxt);
        const char* nA = has_next ? (const char*)g.A + (size_t)nxt.pm * tstepA + (g.adiv ? (size_t)(nxt.pn / g.adiv) * g.astride : 0) : cA;
        const char* nB = has_next ? (const char*)g.Bt + (size_t)nxt.pn * tstepB : cB;
        for (int t = 0; t < nt; t += 2) {
            const bool last = (t == nt - 2);
            const char* a1 = cA + (size_t)(t + 1) * kstep;
            const char* a2 = last ? nA : cA + (size_t)(t + 2) * kstep; const char* b2 = last ? nB : cB + (size_t)(t + 2) * kstep;
            const char* a3 = a2 + kstep; const char* b3 = b2 + kstep;
            PG8_LDB(B0, 0, 0); PG8_LDB(B1, 0, 1); PG8_SCHED; PG8_LDA(At, 0, 0); PG8_STAGE(PG8_SA(1, 1), a1 + hstepA, voffA);
            PG8_WAIT_V(8); PG8_WAIT_L(0); PG8_BAR; PG8_MMA(0, 0, At, B0); PG8_MMA(0, 1, At, B1); PG8_BAR; PG8_SCHED;
            PG8_LDA(At, 0, 1); PG8_STAGE(PG8_SB(0, 0), b2, voffB); PG8_STAGE(PG8_SB(0, 1), b2 + hstepB, voffB); PG8_STAGE(PG8_SA(0, 0), a2, voffA);
            PG8_WAIT_V(8); PG8_WAIT_L(0); PG8_BAR; PG8_MMA(1, 0, At, B0); PG8_MMA(1, 1, At, B1); PG8_BAR; PG8_SCHED;
            PG8_LDB(B0, 1, 0); PG8_LDB(B1, 1, 1); PG8_SCHED; PG8_LDA(At, 1, 0); PG8_STAGE(PG8_SA(0, 1), a2 + hstepA, voffA);
            PG8_WAIT_V(8); PG8_WAIT_L(0); PG8_BAR; PG8_MMA(0, 0, At, B0); PG8_MMA(0, 1, At, B1); PG8_BAR; PG8_SCHED;
            PG8_LDA(At, 1, 1); PG8_STAGE(PG8_SB(1, 0), b3, voffB); PG8_STAGE(PG8_SB(1, 1), b3 + hstepB, voffB); PG8_STAGE(PG8_SA(1, 0), a3, voffA);
            PG8_WAIT_V(8); PG8_WAIT_L(0); PG8_BAR; PG8_MMA(1, 0, At, B0); PG8_MMA(1, 1, At, B1); PG8_BAR; PG8_SCHED;
        }
        if (wr == 0) PG8_BAR;
        E(acc, cur, wr, wc, fr, fq, lds);
        if (!has_next) break;
#pragma unroll
        for (int a = 0; a < 2; ++a)
#pragma unroll
            for (int b = 0; b < 2; ++b)
#pragma unroll
                for (int m = 0; m < 4; ++m)
#pragma unroll
                    for (int n = 0; n < 2; ++n) acc[a][b][m][n] = (f32x4){0.f, 0.f, 0.f, 0.f};
        cur = nxt; cA = nA; cB = nB; ++ui;
        if (wr == 1) PG8_BAR;
    }
    PG8_WAIT_V(0);
    PG8_BAR;
#undef PG8_SA
#undef PG8_SB
#undef PG8_STAGE
#undef PG8_LDA
#undef PG8_LDB
#undef PG8_MMA
#undef PG8_WAIT_V
#undef PG8_WAIT_L
#undef PG8_BAR
#undef PG8_SCHED
}

typedef const f32x4 (&AccRef)[2][2][4][2];

struct EpiG1 {
    static constexpr bool PERM = true;
    unsigned char* ws;
    __device__ __forceinline__ void operator()(f32x4 (&acc)[2][2][4][2], const Unit& u, int wr, int wc, int fr, int fq, LAS unsigned char*) const {
        const int pn = u.pn;
        const int row0 = u.pm * BM + wr * 64 + fr;
        if (pn == 16) {
            if (wc == 0 && fq < 2) { float* G = (float*)(ws + WS_GDOWN);
#pragma unroll
                for (int ai = 0; ai < 2; ++ai)
#pragma unroll
                    for (int m = 0; m < 4; ++m)
#pragma unroll
                        for (int n = 0; n < 2; ++n) *(f32x4*)(G + (size_t)(row0 + ai * HALF + m * 16) * 16 + 8 * fq + 4 * n) = acc[ai][0][m][n]; }
            return;
        }
        size_t off; int ldc = 512, colt, act = 0;
        if (pn < 2) { off = WS_QA; colt = pn * 256; }
        else if (pn < 4) { off = WS_KA; colt = (pn - 2) * 256; }
        else if (pn < 6) { off = WS_VA; colt = (pn - 4) * 256; }
        else if (pn < 8) { off = WS_U; colt = (pn - 6) * 256; act = 1; }
        else if (pn < 10) { off = WS_SV; colt = (pn - 8) * 256; act = 1; }
        else if (pn == 10) { off = WS_GQ; colt = 0; ldc = 256; }
        else if (pn == 11) { off = WS_GK; colt = 0; ldc = 256; }
        else if (pn < 14) { off = WS_GV; colt = (pn - 12) * 256; }
        else { off = WS_GR; colt = (pn - 14) * 256; act = 2; }
        bf16_t* base = (bf16_t*)(ws + off);
        const int col0 = colt + wc * 32 + 8 * fq;
#pragma unroll
        for (int ai = 0; ai < 2; ++ai)
#pragma unroll
            for (int m = 0; m < 4; ++m) { bf16_t* rowp = base + (size_t)(row0 + ai * HALF + m * 16) * ldc + col0;
#pragma unroll
                for (int bj = 0; bj < 2; ++bj) { f32x4 v0 = acc[ai][bj][m][0], v1 = acc[ai][bj][m][1];
                    if (act == 1) {
#pragma unroll
                        for (int e = 0; e < 4; ++e) { v0[e] = gelu_tanh_f(v0[e]); v1[e] = gelu_tanh_f(v1[e]); }
                    } else if (act == 2) {
#pragma unroll
                        for (int e = 0; e < 4; ++e) { v0[e] = v0[e] * sigmoid_f(v0[e]); v1[e] = v1[e] * sigmoid_f(v1[e]); }
                    }
                    u32x4 w; w.x = cvt_pk_bf16(v0[0], v0[1]); w.y = cvt_pk_bf16(v0[2], v0[3]); w.z = cvt_pk_bf16(v1[0], v1[1]); w.w = cvt_pk_bf16(v1[2], v1[3]);
                    *(u32x4*)(rowp + bj * HALF) = w; } }
    }
};
struct EpiGates {
    static constexpr bool PERM = true;
    bf16_t* O;
    __device__ __forceinline__ void operator()(f32x4 (&acc)[2][2][4][2], const Unit& u, int wr, int wc, int fr, int fq, LAS unsigned char*) const {
        const int row0 = u.pm * BM + wr * 64 + fr, col0 = u.pn * BM + wc * 32 + 8 * fq;
#pragma unroll
        for (int ai = 0; ai < 2; ++ai)
#pragma unroll
            for (int m = 0; m < 4; ++m) { bf16_t* rowp = O + (size_t)(row0 + ai * HALF + m * 16) * 3072 + col0;
#pragma unroll
                for (int bj = 0; bj < 2; ++bj) { f32x4 v0 = acc[ai][bj][m][0], v1 = acc[ai][bj][m][1];
#pragma unroll
                    for (int e = 0; e < 4; ++e) { v0[e] = sigmoid_f(v0[e]); v1[e] = sigmoid_f(v1[e]); }
                    u32x4 w; w.x = cvt_pk_bf16(v0[0], v0[1]); w.y = cvt_pk_bf16(v0[2], v0[3]); w.z = cvt_pk_bf16(v1[0], v1[1]); w.w = cvt_pk_bf16(v1[2], v1[3]);
                    *(u32x4*)(rowp + bj * HALF) = w; } }
    }
};
struct EpiMerge {
    static constexpr bool PERM = true;
    const bf16_t* gates; bf16_t* O;
    __device__ __forceinline__ void operator()(f32x4 (&acc)[2][2][4][2], const Unit& u, int wr, int wc, int fr, int fq, LAS unsigned char*) const {
        const int br = u.pn >> 2, ct = u.pn & 3;
        const int row0 = u.pm * BM + wr * 64 + fr, col0 = ct * BM + wc * 32 + 8 * fq;
#pragma unroll
        for (int ai = 0; ai < 2; ++ai)
#pragma unroll
            for (int m = 0; m < 4; ++m) { const size_t row = (size_t)(row0 + ai * HALF + m * 16);
#pragma unroll
                for (int bj = 0; bj < 2; ++bj) { f32x4 v0 = acc[ai][bj][m][0], v1 = acc[ai][bj][m][1];
                    const u32x4 gw = *(const u32x4*)(gates + row * 3072 + br * 1024 + col0 + bj * HALF);
                    v0[0] *= bflo(gw.x); v0[1] *= bfhi(gw.x); v0[2] *= bflo(gw.y); v0[3] *= bfhi(gw.y);
                    v1[0] *= bflo(gw.z); v1[1] *= bfhi(gw.z); v1[2] *= bflo(gw.w); v1[3] *= bfhi(gw.w);
                    bf16_t* op = O + row * 1024 + col0 + bj * HALF;
                    if (br > 0) { const u32x4 pw = *(const u32x4*)op;
                        v0[0] += bflo(pw.x); v0[1] += bfhi(pw.x); v0[2] += bflo(pw.y); v0[3] += bfhi(pw.y);
                        v1[0] += bflo(pw.z); v1[1] += bfhi(pw.z); v1[2] += bflo(pw.w); v1[3] += bfhi(pw.w); }
                    u32x4 w; w.x = cvt_pk_bf16(v0[0], v0[1]); w.y = cvt_pk_bf16(v0[2], v0[3]); w.z = cvt_pk_bf16(v1[0], v1[1]); w.w = cvt_pk_bf16(v1[2], v1[3]);
                    *(u32x4*)op = w; } }
    }
};
struct EpiF32 {
    static constexpr bool PERM = true;
    bf16_t* O;
    __device__ __forceinline__ void operator()(f32x4 (&acc)[2][2][4][2], const Unit& u, int wr, int wc, int fr, int fq, LAS unsigned char*) const {
        const int row0 = u.pm * BM + wr * 64 + fr, col0 = u.pn * BM + wc * 32 + 8 * fq;
#pragma unroll
        for (int ai = 0; ai < 2; ++ai)
#pragma unroll
            for (int m = 0; m < 4; ++m) { bf16_t* rowp = O + (size_t)(row0 + ai * HALF + m * 16) * 1024 + col0;
#pragma unroll
                for (int bj = 0; bj < 2; ++bj) { const f32x4 v0 = acc[ai][bj][m][0], v1 = acc[ai][bj][m][1];
                    u32x4 w; w.x = cvt_pk_bf16(v0[0], v0[1]); w.y = cvt_pk_bf16(v0[2], v0[3]); w.z = cvt_pk_bf16(v1[0], v1[1]); w.w = cvt_pk_bf16(v1[2], v1[3]);
                    *(u32x4*)(rowp + bj * HALF) = w; } }
    }
};
struct EpiConv {
    static constexpr bool PERM = true;
    const float* cw; const float* cb; bf16_t* act; float* head; float* tail;
    __device__ __forceinline__ void operator()(f32x4 (&acc)[2][2][4][2], const Unit& u, int wr, int wc, int fr, int fq, LAS unsigned char* lds) const {
        LAS float* XT = (LAS float*)(lds + XT_OFF);
        const int ccol = wc * 32 + 8 * fq;
        if (fr >= 14) {
#pragma unroll
            for (int ai = 0; ai < 2; ++ai)
#pragma unroll
                for (int bj = 0; bj < 2; ++bj)
#pragma unroll
                    for (int n = 0; n < 2; ++n) *(LAS f32x4*)(XT + ((ai * 2 + wr) * 2 + (fr - 14)) * 256 + bj * HALF + ccol + 4 * n) = acc[ai][bj][3][n];
            if (wr == 1) {
#pragma unroll
                for (int bj = 0; bj < 2; ++bj)
#pragma unroll
                    for (int n = 0; n < 2; ++n) *(f32x4*)(tail + ((size_t)u.pm * 2 + (fr - 14)) * DFF2 + u.pn * BM + bj * HALF + ccol + 4 * n) = acc[1][bj][3][n];
            }
        }
        if (fr < 2 && wr == 0) {
#pragma unroll
            for (int bj = 0; bj < 2; ++bj)
#pragma unroll
                for (int n = 0; n < 2; ++n) *(f32x4*)(head + ((size_t)u.pm * 2 + fr) * DFF2 + u.pn * BM + bj * HALF + ccol + 4 * n) = acc[0][bj][0][n];
        }
        asm volatile("s_waitcnt lgkmcnt(0)" ::: "memory"); __builtin_amdgcn_s_barrier(); asm volatile("" ::: "memory");
#pragma unroll
        for (int n = 0; n < 2; ++n) {
            const int ch = u.pn * HALF + ccol + 4 * n;
            const f32x4 wa0 = *(const f32x4*)(cw + ch), wa1 = *(const f32x4*)(cw + DFF2 + ch), wa2 = *(const f32x4*)(cw + 2 * DFF2 + ch), ba = *(const f32x4*)(cb + ch);
            const f32x4 wu0 = *(const f32x4*)(cw + DFF + ch), wu1 = *(const f32x4*)(cw + DFF2 + DFF + ch), wu2 = *(const f32x4*)(cw + 2 * DFF2 + DFF + ch), bu = *(const f32x4*)(cb + DFF + ch);
#pragma unroll
            for (int ai = 1; ai >= 0; --ai)
#pragma unroll
                for (int m = 3; m >= 0; --m) {
                    f32x4 pa, pu;
                    if (m > 0) { pa = acc[ai][0][m - 1][n]; pu = acc[ai][1][m - 1][n]; }
                    else {
                        const int slot = ai * 2 + wr - 1;
                        if (slot >= 0) { pa = *(const LAS f32x4*)(XT + (slot * 2 + (fr & 1)) * 256 + ccol + 4 * n); pu = *(const LAS f32x4*)(XT + (slot * 2 + (fr & 1)) * 256 + HALF + ccol + 4 * n); }
                        else { pa = (f32x4){0.f, 0.f, 0.f, 0.f}; pu = pa; }
                    }
                    f32x4 xa = acc[ai][0][m][n], xu = acc[ai][1][m][n];
                    asm volatile("" : "+v"(xa), "+v"(xu), "+v"(pa), "+v"(pu));
                    f32x4 res;
#pragma unroll
                    for (int e = 0; e < 4; ++e) {
                        const float a1 = dpp_shr1(xa[e]) + dpp_shl15(pa[e]), a2 = dpp_shr2(xa[e]) + dpp_shl14(pa[e]);
                        const float u1 = dpp_shr1(xu[e]) + dpp_shl15(pu[e]), u2 = dpp_shr2(xu[e]) + dpp_shl14(pu[e]);
                        const float ca = ba[e] + wa0[e] * a2 + wa1[e] * a1 + wa2[e] * xa[e];
                        const float cu = bu[e] + wu0[e] * u2 + wu1[e] * u1 + wu2[e] * xu[e];
                        res[e] = gelu_tanh_f(ca) * cu;
                    }
                    asm volatile("" : "+v"(res));
                    acc[ai][0][m][n] = res;
                }
        }
        const int row0 = u.pm * BM + wr * 64 + fr;
#pragma unroll
        for (int ai = 0; ai < 2; ++ai)
#pragma unroll
            for (int m = 0; m < 4; ++m) { const f32x4 v0 = acc[ai][0][m][0], v1 = acc[ai][0][m][1];
                u32x4 w; w.x = cvt_pk_bf16(v0[0], v0[1]); w.y = cvt_pk_bf16(v0[2], v0[3]); w.z = cvt_pk_bf16(v1[0], v1[1]); w.w = cvt_pk_bf16(v1[2], v1[3]);
                *(u32x4*)(act + (size_t)(row0 + ai * HALF + m * 16) * DFF + u.pn * HALF + ccol) = w; }
    }
};
template <class Epi, class Sched>
__device__ __forceinline__ void gemm_merge_phase(LAS unsigned char* lds, const Gemm g, const Sched& S, const Epi& E, int wave_) {
    const int tid = vlaunder(wave_ * 64 + lane_id_()), wid = wave_, lane = tid & 63, wr = wid >> 2, wc = wid & 3, fr = lane & 15, fq = lane >> 4;
    const int K = g.K, nt = K / BK;
    unsigned voffA[2], voffB[2];
#pragma unroll
    for (int i = 0; i < 2; ++i) { int R, C; stage_rc(tid * 16 + i * 8192, R, C); const int Rb = Epi::PERM ? ((R & ~31) + perm32(R & 31)) : R;
        voffA[i] = (unsigned)(R * g.lda + C) * 2u; voffB[i] = (unsigned)(Rb * g.ldb + C) * 2u; }
    const size_t kstep = (size_t)(BK * 2);
    const size_t hstepA = (size_t)HALF * g.lda * 2, hstepB = (size_t)HALF * g.ldb * 2;
    const size_t tstepA = 2 * hstepA, tstepB = 2 * hstepB;
    const unsigned ldsw = (unsigned)wid * 1024u;
    const int aoff = lds_byte(wr * 64 + fr, fq * 8), boff = lds_byte(wc * 32 + fr, fq * 8);
#define PG8_SA(b, h) (((b) * 2 + (h)) * HTB)
#define PG8_SB(b, h) ((4 + (b) * 2 + (h)) * HTB)
#define PG8_STAGE(bufoff, gbase, voff) do { _Pragma("unroll") for (int _i = 0; _i < 2; ++_i) \
        __builtin_amdgcn_global_load_lds((const unsigned*)((const char*)(gbase) + (voff)[_i]), (LAS unsigned*)(lds + (bufoff) + ldsw + _i * 8192), 16, 0, 0); } while (0)
#define PG8_LDA(dst, b, h) do { _Pragma("unroll") for (int m = 0; m < 4; ++m) _Pragma("unroll") for (int k = 0; k < 2; ++k) dst[m][k] = *(const LAS bf16x8*)(lds + PG8_SA(b, h) + aoff + m * 2048 + k * 1024); } while (0)
#define PG8_LDB(dst, b, h) do { _Pragma("unroll") for (int n = 0; n < 2; ++n) _Pragma("unroll") for (int k = 0; k < 2; ++k) dst[n][k] = *(const LAS bf16x8*)(lds + PG8_SB(b, h) + boff + n * 2048 + k * 1024); } while (0)
#define PG8_MMA(ai, bj, At, Bt) do { __builtin_amdgcn_s_setprio(1); _Pragma("unroll") for (int m = 0; m < 4; ++m) _Pragma("unroll") for (int n = 0; n < 2; ++n) _Pragma("unroll") for (int k = 0; k < 2; ++k) \
        acc[ai][bj][m][n] = __builtin_amdgcn_mfma_f32_16x16x32_bf16(Bt[n][k], At[m][k], acc[ai][bj][m][n], 0, 0, 0); __builtin_amdgcn_s_setprio(0); } while (0)
#define PG8_WAIT_V(n) asm volatile("s_waitcnt vmcnt(" #n ")" ::: "memory")
#define PG8_WAIT_L(n) asm volatile("s_waitcnt lgkmcnt(" #n ")" ::: "memory")
#define PG8_BAR __builtin_amdgcn_s_barrier()
#define PG8_SCHED __builtin_amdgcn_sched_barrier(0)
    Unit cur, nxt; int ui = 0;
    (void)S.next(0, cur);
    f32x4 acc[2][2][4][2];
#pragma unroll
    for (int a = 0; a < 2; ++a)
#pragma unroll
        for (int b = 0; b < 2; ++b)
#pragma unroll
            for (int m = 0; m < 4; ++m)
#pragma unroll
                for (int n = 0; n < 2; ++n) acc[a][b][m][n] = (f32x4){0.f, 0.f, 0.f, 0.f};
    bf16x8 At[4][2], B0[2][2], B1[2][2];
#define PG8_AT(base, t) ((base) + (size_t)((t) >> 3) * g.astride + (size_t)((t) & 7) * kstep)
    const char* cA = (const char*)g.A + (size_t)cur.pm * tstepA;
    const char* cB = (const char*)g.Bt + (size_t)cur.pn * tstepB;
    PG8_STAGE(PG8_SB(0, 0), cB, voffB); PG8_STAGE(PG8_SB(0, 1), cB + hstepB, voffB); PG8_STAGE(PG8_SA(0, 0), cA, voffA); PG8_STAGE(PG8_SA(0, 1), cA + hstepA, voffA);
    if (wr == 1) PG8_BAR;
    PG8_WAIT_V(2); PG8_BAR;
    PG8_STAGE(PG8_SB(1, 0), cB + kstep, voffB); PG8_STAGE(PG8_SA(1, 0), cA + kstep, voffA); PG8_STAGE(PG8_SB(1, 1), cB + hstepB + kstep, voffB);
    PG8_WAIT_V(6); PG8_BAR;
    for (;;) {
        const bool has_next = S.next(ui + 1, nxt);
        const char* nA = has_next ? (const char*)g.A + (size_t)nxt.pm * tstepA : cA;
        const char* nB = has_next ? (const char*)g.Bt + (size_t)nxt.pn * tstepB : cB;
#define PG8_KBODY(t) { \
            const bool last = ((t) == nt - 2); \
            const char* a1 = PG8_AT(cA, t + 1); \
            const char* a2 = last ? nA : PG8_AT(cA, t + 2); const char* b2 = last ? nB : cB + (size_t)(t + 2) * kstep; \
            const char* a3 = last ? nA + kstep : PG8_AT(cA, t + 3); const char* b3 = b2 + kstep; \
            PG8_LDB(B0, 0, 0); PG8_LDB(B1, 0, 1); PG8_SCHED; PG8_LDA(At, 0, 0); PG8_STAGE(PG8_SA(1, 1), a1 + hstepA, voffA); \
            PG8_WAIT_V(8); PG8_WAIT_L(0); PG8_BAR; PG8_MMA(0, 0, At, B0); PG8_MMA(0, 1, At, B1); PG8_BAR; PG8_SCHED; \
            PG8_LDA(At, 0, 1); PG8_STAGE(PG8_SB(0, 0), b2, voffB); PG8_STAGE(PG8_SB(0, 1), b2 + hstepB, voffB); PG8_STAGE(PG8_SA(0, 0), a2, voffA); \
            PG8_WAIT_V(8); PG8_WAIT_L(0); PG8_BAR; PG8_MMA(1, 0, At, B0); PG8_MMA(1, 1, At, B1); PG8_BAR; PG8_SCHED; \
            PG8_LDB(B0, 1, 0); PG8_LDB(B1, 1, 1); PG8_SCHED; PG8_LDA(At, 1, 0); PG8_STAGE(PG8_SA(0, 1), a2 + hstepA, voffA); \
            PG8_WAIT_V(8); PG8_WAIT_L(0); PG8_BAR; PG8_MMA(0, 0, At, B0); PG8_MMA(0, 1, At, B1); PG8_BAR; PG8_SCHED; \
            PG8_LDA(At, 1, 1); PG8_STAGE(PG8_SB(1, 0), b3, voffB); PG8_STAGE(PG8_SB(1, 1), b3 + hstepB, voffB); PG8_STAGE(PG8_SA(1, 0), a3, voffA); \
            PG8_WAIT_V(8); PG8_WAIT_L(0); PG8_BAR; PG8_MMA(1, 0, At, B0); PG8_MMA(1, 1, At, B1); PG8_BAR; PG8_SCHED; \
        }
        for (int t = 0; t < 8; t += 2) PG8_KBODY(t)
        E.hook(acc, cur, 0, wr, wc, fr, fq);
        for (int t = 8; t < 16; t += 2) PG8_KBODY(t)
        E.hook(acc, cur, 1, wr, wc, fr, fq);
        for (int t = 16; t < 24; t += 2) PG8_KBODY(t)
#undef PG8_KBODY
        if (wr == 0) PG8_BAR;
        E(acc, cur, wr, wc, fr, fq, lds);
        if (!has_next) break;
#pragma unroll
        for (int a = 0; a < 2; ++a)
#pragma unroll
            for (int b = 0; b < 2; ++b)
#pragma unroll
                for (int m = 0; m < 4; ++m)
#pragma unroll
                    for (int n = 0; n < 2; ++n) acc[a][b][m][n] = (f32x4){0.f, 0.f, 0.f, 0.f};
        cur = nxt; cA = nA; cB = nB; ++ui;
        if (wr == 1) PG8_BAR;
    }
    PG8_WAIT_V(0);
    PG8_BAR;
#undef PG8_AT
#undef PG8_SA
#undef PG8_SB
#undef PG8_STAGE
#undef PG8_LDA
#undef PG8_LDB
#undef PG8_MMA
#undef PG8_WAIT_V
#undef PG8_WAIT_L
#undef PG8_BAR
#undef PG8_SCHED
}

struct EpiMerge3 {
    static constexpr bool PERM = true;
    const bf16_t* gates; bf16_t* O;
    static __device__ __forceinline__ float cl(float g) { return fmaxf(g, 1e-30f); }
    __device__ __forceinline__ void hook(f32x4 (&acc)[2][2][4][2], const Unit& u, int seam, int wr, int wc, int fr, int fq) const {
        const int row0 = vlaunder(u.pm * BM + wr * 64 + fr), col0 = vlaunder(u.pn * BM + wc * 32 + 8 * fq);
#pragma unroll
        for (int ai = 0; ai < 2; ++ai) {
            u32x4 ga[4][2], gb[4][2];
#pragma unroll
            for (int m = 0; m < 4; ++m)
#pragma unroll
                for (int bj = 0; bj < 2; ++bj) { const bf16_t* gp = gates + (size_t)(row0 + ai * HALF + m * 16) * 3072 + seam * 1024 + col0 + bj * HALF; ga[m][bj] = *(const u32x4*)gp; gb[m][bj] = *(const u32x4*)(gp + 1024); }
#pragma unroll
            for (int m = 0; m < 4; ++m)
#pragma unroll
                for (int bj = 0; bj < 2; ++bj) { const u32x4 a = ga[m][bj], b = gb[m][bj];
                    acc[ai][bj][m][0][0] *= cl(bflo(a.x)) * rcpf_(cl(bflo(b.x))); acc[ai][bj][m][0][1] *= cl(bfhi(a.x)) * rcpf_(cl(bfhi(b.x)));
                    acc[ai][bj][m][0][2] *= cl(bflo(a.y)) * rcpf_(cl(bflo(b.y))); acc[ai][bj][m][0][3] *= cl(bfhi(a.y)) * rcpf_(cl(bfhi(b.y)));
                    acc[ai][bj][m][1][0] *= cl(bflo(a.z)) * rcpf_(cl(bflo(b.z))); acc[ai][bj][m][1][1] *= cl(bfhi(a.z)) * rcpf_(cl(bfhi(b.z)));
                    acc[ai][bj][m][1][2] *= cl(bflo(a.w)) * rcpf_(cl(bflo(b.w))); acc[ai][bj][m][1][3] *= cl(bfhi(a.w)) * rcpf_(cl(bfhi(b.w))); }
            asm volatile("" ::: "memory");
        }
    }
    __device__ __forceinline__ void operator()(f32x4 (&acc)[2][2][4][2], const Unit& u, int wr, int wc, int fr, int fq, LAS unsigned char*) const {
        const int row0 = vlaunder(u.pm * BM + wr * 64 + fr), col0 = vlaunder(u.pn * BM + wc * 32 + 8 * fq);
#pragma unroll
        for (int ai = 0; ai < 2; ++ai) {
            u32x4 gc[4][2];
#pragma unroll
            for (int m = 0; m < 4; ++m)
#pragma unroll
                for (int bj = 0; bj < 2; ++bj) gc[m][bj] = *(const u32x4*)(gates + (size_t)(row0 + ai * HALF + m * 16) * 3072 + 2048 + col0 + bj * HALF);
#pragma unroll
            for (int m = 0; m < 4; ++m)
#pragma unroll
                for (int bj = 0; bj < 2; ++bj) { const u32x4 c = gc[m][bj]; const f32x4 v0 = acc[ai][bj][m][0], v1 = acc[ai][bj][m][1];
                    u32x4 w; w.x = cvt_pk_bf16(v0[0] * cl(bflo(c.x)), v0[1] * cl(bfhi(c.x))); w.y = cvt_pk_bf16(v0[2] * cl(bflo(c.y)), v0[3] * cl(bfhi(c.y)));
                    w.z = cvt_pk_bf16(v1[0] * cl(bflo(c.z)), v1[1] * cl(bfhi(c.z))); w.w = cvt_pk_bf16(v1[2] * cl(bflo(c.w)), v1[3] * cl(bfhi(c.w)));
                    *(u32x4*)(O + (size_t)(row0 + ai * HALF + m * 16) * 1024 + col0 + bj * HALF) = w; }
            asm volatile("" ::: "memory");
        }
    }
};
}

__device__ __forceinline__ void transpose_item(const float* W, int ldsrc, int k0, int nsrc0, bf16_t* WT, int K, int ndst0, LAS float* scr, int lane) {
    float wv[32];
#pragma unroll
    for (int i = 0; i < 32; ++i) wv[i] = W[(size_t)(k0 + 2 * i + (lane >> 5)) * ldsrc + nsrc0 + (lane & 31)];
#pragma unroll
    for (int i = 0; i < 32; ++i) scr[(2 * i + (lane >> 5)) * 33 + (lane & 31)] = wv[i];
    LDS_WAIT(); asm volatile("" ::: "memory");
    const int c = lane & 7;
#pragma unroll
    for (int j = 0; j < 4; ++j) { const int n = (lane >> 3) + 8 * j; const LAS float* s = scr + (8 * c) * 33 + n;
        u32x4 o; o.x = cvt_pk_bf16(s[0 * 33], s[1 * 33]); o.y = cvt_pk_bf16(s[2 * 33], s[3 * 33]); o.z = cvt_pk_bf16(s[4 * 33], s[5 * 33]); o.w = cvt_pk_bf16(s[6 * 33], s[7 * 33]);
        *(u32x4*)(WT + (size_t)(ndst0 + n) * K + k0 + 8 * c) = o; }
    LDS_WAIT(); asm volatile("" ::: "memory");
}
__device__ __forceinline__ void convert_weights(const Params& p, int l, LAS unsigned char* lds, int gw, int ngw, int wave, int lane) {
    lane = vlaunder(lane_id_());
    LAS float* scr = (LAS float*)(lds + wave * 16384);
    unsigned char* ws = launder(PP(ws));
    bf16_t* Win = (bf16_t*)(ws + WS_WIN); bf16_t* WP = (bf16_t*)(ws + WS_WP); bf16_t* WO = (bf16_t*)(ws + WS_WOUT); bf16_t* WU = (bf16_t*)(ws + WS_WUP); bf16_t* WD = (bf16_t*)(ws + WS_WDN);
    const float* w_in = launder(PP(w_in)) + (size_t)l * DM * INW;
    constexpr int I0 = 16 * 128, I1 = 16 * 96, I2 = 8 * 32, I5 = 16 * 32, I6 = 16 * 176, I7 = 44 * 32;
    constexpr int NITEMS = I0 + I1 + 3 * I2 + I5 + I6 + I7;
    for (int it = gw; it < NITEMS; it += ngw) {
        int r = it;
        if (r < I0) { const int kb = r / 128, nb = r % 128; transpose_item(w_in, INW, 64 * kb, 32 * nb, Win, 1024, 32 * nb, scr, lane); continue; } r -= I0;
        if (r < I1) { const int kb = r / 96, nb = r % 96; transpose_item(w_in, INW, 64 * kb, 4112 + 32 * nb, Win, 1024, 4352 + 32 * nb, scr, lane); continue; } r -= I1;
        if (r < 3 * I2) { const int br = r / I2, q = r % I2, kb = q / 32, nb = q % 32;
            const float* src = launder(br == 0 ? PP(p_a) : (br == 1 ? PP(p_b) : PP(p_c))) + (size_t)l * 512 * 1024;
            transpose_item(src, 1024, 64 * kb, 32 * nb, WP + 512 * br, 1536, 32 * nb, scr, lane); continue; } r -= 3 * I2;
        if (r < I5) { const int kb = r / 32, nb = r % 32; transpose_item(launder(PP(w_out)) + (size_t)l * 1024 * 1024, 1024, 64 * kb, 32 * nb, WO, 1024, 32 * nb, scr, lane); continue; } r -= I5;
        if (r < I6) { const int kb = r / 176, nb = r % 176, j = nb >> 3, half = (nb >> 2) & 1, q = nb & 3;
            transpose_item(launder(PP(ffn_w_up)) + (size_t)l * 1024 * DFF2, DFF2, 64 * kb, DFF * half + 128 * j + 32 * q, WU, 1024, 256 * j + 128 * half + 32 * q, scr, lane); continue; } r -= I6;
        { const int kb = r / 32, nb = r % 32; transpose_item(launder(PP(ffn_w_down)) + (size_t)l * DFF * 1024, 1024, 64 * kb, 32 * nb, WD, DFF, 32 * nb, scr, lane); }
    }
    for (int idx = gw * 64 + lane; idx < 256 * 1024; idx += ngw * 64) { const int n = idx >> 10, k = idx & 1023;
        const float v = (n < 16) ? w_in[(size_t)k * INW + 4096 + n] : 0.f; Win[(size_t)(4096 + n) * 1024 + k] = f2bf(v); }
}

constexpr int NRW = 4;
template <bool HAS_Y, bool HAS_OUT, bool HAS_XN, bool HIN_BF, bool HOUT_BF>
__device__ __forceinline__ void row_phase(const void* hin_, const bf16_t* y, const float* gpost, void* hout_, const float* gpre, bf16_t* xn, int gw, int ngw, int lane) {
    hin_ = launder(hin_); y = launder(y); hout_ = launder(hout_); xn = launder(xn); gpost = launder(gpost); gpre = launder(gpre); lane = vlaunder(lane_id_());
    for (int m0 = gw; m0 < MTOK; m0 += NRW * ngw) {
        f32x4 v[NRW][4]; u32x2 hw[NRW][4]; u32x2 yw[NRW][4];
#pragma unroll
        for (int rr_ = 0; rr_ < NRW; ++rr_) { const int m = m0 + rr_ * ngw;
            if (HIN_BF) { const u32x2* hr = (const u32x2*)((const bf16_t*)hin_ + (size_t)m * DM) + lane;
#pragma unroll
                for (int j = 0; j < 4; ++j) hw[rr_][j] = hr[64 * j]; }
            else { const f32x4* hr = (const f32x4*)((const float*)hin_ + (size_t)m * DM) + lane;
#pragma unroll
                for (int j = 0; j < 4; ++j) v[rr_][j] = hr[64 * j]; }
            if (HAS_Y) { const u32x2* yr = (const u32x2*)(y + (size_t)m * DM) + lane;
#pragma unroll
                for (int j = 0; j < 4; ++j) yw[rr_][j] = yr[64 * j]; } }
#pragma unroll
        for (int rr_ = 0; rr_ < NRW; ++rr_) {
            const int m = m0 + rr_ * ngw;
            if (HIN_BF) {
#pragma unroll
                for (int j = 0; j < 4; ++j) v[rr_][j] = (f32x4){bflo(hw[rr_][j].x), bfhi(hw[rr_][j].x), bflo(hw[rr_][j].y), bfhi(hw[rr_][j].y)};
            }
            if (HAS_Y) {
                f32x4 yv[4]; float s = 0.f;
#pragma unroll
                for (int j = 0; j < 4; ++j) { yv[j] = (f32x4){bflo(yw[rr_][j].x), bfhi(yw[rr_][j].x), bflo(yw[rr_][j].y), bfhi(yw[rr_][j].y)}; s += (yv[j].x * yv[j].x + yv[j].y * yv[j].y) + (yv[j].z * yv[j].z + yv[j].w * yv[j].w); }
                const float r = __builtin_amdgcn_rsqf(wave_sum(s) * (1.f / DM) + EPS);
#pragma unroll
                for (int j = 0; j < 4; ++j) { const f32x4 gp = *((const f32x4*)gpost + lane + 64 * j); v[rr_][j] += yv[j] * r * gp; }
            }
            if (HAS_OUT) {
                if (HOUT_BF) { u32x2* ho = (u32x2*)((bf16_t*)hout_ + (size_t)m * DM) + lane;
#pragma unroll
                    for (int j = 0; j < 4; ++j) { u32x2 w; w.x = cvt_pk_bf16(v[rr_][j].x, v[rr_][j].y); w.y = cvt_pk_bf16(v[rr_][j].z, v[rr_][j].w); ho[64 * j] = w;
                        v[rr_][j] = (f32x4){bflo(w.x), bfhi(w.x), bflo(w.y), bfhi(w.y)}; }
                } else { f32x4* ho = (f32x4*)((float*)hout_ + (size_t)m * DM) + lane;
#pragma unroll
                    for (int j = 0; j < 4; ++j) ho[64 * j] = v[rr_][j]; }
            }
            if (HAS_XN) {
                float s = 0.f;
#pragma unroll
                for (int j = 0; j < 4; ++j) s += (v[rr_][j].x * v[rr_][j].x + v[rr_][j].y * v[rr_][j].y) + (v[rr_][j].z * v[rr_][j].z + v[rr_][j].w * v[rr_][j].w);
                const float r = __builtin_amdgcn_rsqf(wave_sum(s) * (1.f / DM) + EPS);
                u32x2* xo = (u32x2*)(xn + (size_t)m * DM) + lane;
#pragma unroll
                for (int j = 0; j < 4; ++j) { const f32x4 g = *((const f32x4*)gpre + lane + 64 * j); const f32x4 o = v[rr_][j] * r * g; u32x2 w; w.x = cvt_pk_bf16(o.x, o.y); w.y = cvt_pk_bf16(o.z, o.w); xo[64 * j] = w; }
            }
        }
    }
}

__device__ __forceinline__ void sb_phase(LAS unsigned char* lds, unsigned char* ws, int tid, int wave, int lane, size_t dst_off = WS_QA) {
    ws = launder(ws); tid = vlaunder(wave * 64 + lane_id_()); lane = tid & 63;
    bf16_t* QA = (bf16_t*)(ws + WS_QA); bf16_t* YA = (bf16_t*)(ws + dst_off); const bf16_t* KA = (const bf16_t*)(ws + WS_KA); const bf16_t* VA = (const bf16_t*)(ws + WS_VA);
    LAS bf16_t* sK = (LAS bf16_t*)lds;
    LAS bf16_t* sVt = (LAS bf16_t*)(lds + 9216);
    const int r = lane & 15, g = lane >> 4;
    for (int u = blockIdx.x; u < BATCH * 8 * 32; u += gridDim.x) {
        const int b = u >> 8, h = (u >> 5) & 7, qb = u & 31;
        const int tq0 = qb * 128 + wave * 16, t = tq0 + r;
        const size_t rowbase = (size_t)b * SEQ;
        bf16x8 qf[2];
#pragma unroll
        for (int ks = 0; ks < 2; ++ks) qf[ks] = *(const bf16x8*)(QA + (rowbase + t) * 512 + h * 64 + 32 * ks + 8 * g);
        f32x4 o[4];
#pragma unroll
        for (int i = 0; i < 4; ++i) o[i] = (f32x4){0.f, 0.f, 0.f, 0.f};
        float carry = 1.f;
        const int skey = tid >> 3, sch = tid & 7;
        u32x4 kv, vv;
        { const size_t goff = (rowbase + (qb * 2 + 1) * 64 + skey) * 512 + h * 64 + 8 * sch; kv = *(const u32x4*)(KA + goff); vv = *(const u32x4*)(VA + goff); }
        for (int kt = qb * 2 + 1; kt >= 0; --kt) {
            {
                const int key = skey, ch = sch;
                *(LAS u32x4*)(sK + key * 72 + 8 * ch) = kv;
                LAS bf16_t* vd = sVt + (8 * ch) * 68 + key;
                vd[0 * 68] = (bf16_t)(vv.x & 0xffff); vd[1 * 68] = (bf16_t)(vv.x >> 16); vd[2 * 68] = (bf16_t)(vv.y & 0xffff); vd[3 * 68] = (bf16_t)(vv.y >> 16);
                vd[4 * 68] = (bf16_t)(vv.z & 0xffff); vd[5 * 68] = (bf16_t)(vv.z >> 16); vd[6 * 68] = (bf16_t)(vv.w & 0xffff); vd[7 * 68] = (bf16_t)(vv.w >> 16);
            }
            __syncthreads();
            if (kt > 0) { const size_t goff = (rowbase + (kt - 1) * 64 + skey) * 512 + h * 64 + 8 * sch; kv = *(const u32x4*)(KA + goff); vv = *(const u32x4*)(VA + goff); }
            const bool wdone = __all(carry < SB_THR);
            const bool active = (kt * 64) < (tq0 + 15) && !wdone;
            if (active) {
                f32x4 s[4];
#pragma unroll
                for (int kb = 0; kb < 4; ++kb) { s[kb] = (f32x4){0.f, 0.f, 0.f, 0.f};
#pragma unroll
                    for (int ks = 0; ks < 2; ++ks) { const bf16x8 a = *(const LAS bf16x8*)(sK + (16 * kb + r) * 72 + 32 * ks + 8 * g); s[kb] = mfma16(a, qf[ks], s[kb]); } }
                f32x4 w[4];
                const float zs = -0.125f * 1.4426950409f;
                const bool nomask = (kt * 64 + 63 < tq0);
#pragma unroll
                for (int kb = 3; kb >= 0; --kb) {
                    float be[4], om[4];
#pragma unroll
                    for (int j = 0; j < 4; ++j) { const float en = __builtin_amdgcn_exp2f(fminf(s[kb][j] * zs, 100.f)); const float b = rcpf_(1.f + en);
                        const bool mk = nomask || (kt * 64 + 16 * kb + 4 * g + j < t); be[j] = mk ? b : 0.f; om[j] = mk ? en * b : 1.f; }
                    const float sg = (om[0] * om[1]) * (om[2] * om[3]);
                    const float a_ = __shfl_xor(sg, 16); const float b_ = sg * a_; const float c_ = __shfl_xor(b_, 32);
                    const float suf = ((g & 1) == 0 ? a_ : 1.f) * ((g & 2) == 0 ? c_ : 1.f);
                    const float t3 = carry * suf, t2 = t3 * om[3], t1 = t2 * om[2], t0 = t1 * om[1];
                    w[kb][0] = be[0] * t0; w[kb][1] = be[1] * t1; w[kb][2] = be[2] * t2; w[kb][3] = be[3] * t3;
                    carry *= b_ * c_;
                }
#pragma unroll
                for (int sI = 0; sI < 2; ++sI) {
                    const bf16x8 pb = pack8(w[2 * sI], w[2 * sI + 1]);
#pragma unroll
                    for (int dvb = 0; dvb < 4; ++dvb) {
                        const LAS bf16_t* vp = sVt + (16 * dvb + r) * 68 + 32 * sI + 4 * g;
                        const u32x2 lo = *(const LAS u32x2*)vp, hi = *(const LAS u32x2*)(vp + 16);
                        u32x4 av; av.x = lo.x; av.y = lo.y; av.z = hi.x; av.w = hi.y;
                        o[dvb] = mfma16(__builtin_bit_cast(bf16x8, av), pb, o[dvb]);
                    }
                }
            }
            const int done = __all(carry < SB_THR) ? 1 : 0;
            if (__syncthreads_and(done)) break;
        }
#pragma unroll
        for (int dvb = 0; dvb < 4; ++dvb) { u32x2 w2; w2.x = cvt_pk_bf16(o[dvb][0], o[dvb][1]); w2.y = cvt_pk_bf16(o[dvb][2], o[dvb][3]);
            *(u32x2*)(YA + (rowbase + t) * 512 + h * 64 + 16 * dvb + 4 * g) = w2; }
        __syncthreads();
    }
}

__device__ __forceinline__ void sg_phase(LAS unsigned char* lds, const Params& p, int l, int tid, int wave, int lane) {
    unsigned char* ws = launder(PP(ws)); tid = vlaunder(wave * 64 + lane_id_()); lane = tid & 63;
    bf16_t* U = (bf16_t*)(ws + WS_U); const bf16_t* SV = (const bf16_t*)(ws + WS_SV);
    LAS bf16_t* sVn = (LAS bf16_t*)(lds + wave * (64 * 136 * 2));
    LAS float* sSt = (LAS float*)(lds + 8 * 64 * 136 * 2);
    const int r = lane & 15, gq = lane >> 4;
    const float* lng = launder(PP(sg_ln_g)) + l * 512; const float* lnb = launder(PP(sg_ln_b)) + l * 512;
    const float* W = launder(PP(sg_w)) + ((size_t)(l * 8 + wave)) * 128 * 128;
    const float* Bs = launder(PP(sg_b)) + (l * 8 + wave) * 128;
    for (int u = blockIdx.x; u < BATCH * 32; u += gridDim.x) {
        const size_t row0 = (size_t)u * 128;
        {
            const int tok = wave * 16 + (lane >> 2);
            const u32x4* sp = (const u32x4*)(SV + (row0 + tok) * 512 + (lane & 3) * 128);
            u32x4 vv[16];
#pragma unroll
            for (int c = 0; c < 16; ++c) vv[c] = sp[c];
            float s = 0.f;
#pragma unroll
            for (int c = 0; c < 16; ++c) s += ((bflo(vv[c].x) + bfhi(vv[c].x)) + (bflo(vv[c].y) + bfhi(vv[c].y))) + ((bflo(vv[c].z) + bfhi(vv[c].z)) + (bflo(vv[c].w) + bfhi(vv[c].w)));
            s += __shfl_xor(s, 1); s += __shfl_xor(s, 2);
            const float mu = s * (1.f / 512.f);
            float q = 0.f;
#pragma unroll
            for (int c = 0; c < 16; ++c) { const float x[8] = {bflo(vv[c].x), bfhi(vv[c].x), bflo(vv[c].y), bfhi(vv[c].y), bflo(vv[c].z), bfhi(vv[c].z), bflo(vv[c].w), bfhi(vv[c].w)};
#pragma unroll
                for (int e = 0; e < 8; ++e) { const float d = x[e] - mu; q += d * d; } }
            q += __shfl_xor(q, 1); q += __shfl_xor(q, 2);
            const float rs = __builtin_amdgcn_rsqf(q * (1.f / 512.f) + EPS);
            if ((lane & 3) == 0) { sSt[tok * 2] = mu; sSt[tok * 2 + 1] = rs; }
        }
        __syncthreads();
#pragma unroll
        for (int i = 0; i < 2; ++i) {
            const int s = lane + 64 * i; const float mu = sSt[s * 2], rs = sSt[s * 2 + 1];
#pragma unroll
            for (int c = 0; c < 8; ++c) {
                const u32x4 vv = *(const u32x4*)(SV + (row0 + s) * 512 + wave * 64 + 8 * c);
                const float x[8] = {bflo(vv.x), bfhi(vv.x), bflo(vv.y), bfhi(vv.y), bflo(vv.z), bfhi(vv.z), bflo(vv.w), bfhi(vv.w)};
                const f32x4 g0 = *(const f32x4*)(lng + wave * 64 + 8 * c), g1 = *(const f32x4*)(lng + wave * 64 + 8 * c + 4);
                const f32x4 b0 = *(const f32x4*)(lnb + wave * 64 + 8 * c), b1 = *(const f32x4*)(lnb + wave * 64 + 8 * c + 4);
#pragma unroll
                for (int e = 0; e < 8; ++e) { const float gg = e < 4 ? g0[e & 3] : g1[e & 3], bb = e < 4 ? b0[e & 3] : b1[e & 3];
                    sVn[(8 * c + e) * 136 + s] = f2bf((x[e] - mu) * rs * gg + bb); }
            }
        }
        __syncthreads();
        {
            f32x4 acc[8][4];
#pragma unroll
            for (int tb = 0; tb < 8; ++tb)
#pragma unroll
                for (int i = 0; i < 4; ++i) acc[tb][i] = (f32x4){0.f, 0.f, 0.f, 0.f};
#pragma unroll
            for (int ks = 0; ks < 4; ++ks) {
                const int s0 = 32 * ks + 8 * gq;
                bf16x8 bb[4];
#pragma unroll
                for (int db = 0; db < 4; ++db) bb[db] = *(const LAS bf16x8*)(sVn + (16 * db + r) * 136 + s0);
#pragma unroll
                for (int tb = 2 * ks; tb < 8; ++tb) {
                    const int t = 16 * tb + r;
                    f32x4 w0 = *(const f32x4*)(W + t * 128 + s0), w1 = *(const f32x4*)(W + t * 128 + s0 + 4);
#pragma unroll
                    for (int e = 0; e < 4; ++e) { if (s0 + e > t) w0[e] = 0.f; if (s0 + 4 + e > t) w1[e] = 0.f; }
                    const bf16x8 a = pack8(w0, w1);
#pragma unroll
                    for (int db = 0; db < 4; ++db) acc[tb][db] = mfma16(a, bb[db], acc[tb][db]);
                }
            }
#pragma unroll
            for (int tb = 0; tb < 8; ++tb) {
                bf16_t uu[4][4];
#pragma unroll
                for (int j = 0; j < 4; ++j)
#pragma unroll
                    for (int db = 0; db < 4; ++db) uu[j][db] = U[(row0 + 16 * tb + 4 * gq + j) * 512 + wave * 64 + 16 * db + r];
#pragma unroll
                for (int j = 0; j < 4; ++j) { const int tt = 16 * tb + 4 * gq + j; const float bsv = Bs[tt];
#pragma unroll
                    for (int db = 0; db < 4; ++db) U[(row0 + tt) * 512 + wave * 64 + 16 * db + r] = f2bf(bf2f(uu[j][db]) * (acc[tb][db][j] + bsv)); }
            }
        }
        __syncthreads();
    }
}

template <bool PASS_C>
__device__ __forceinline__ void gla_phase(LAS unsigned char* lds, const Params& p, int l, int tid, int wave, int lane) {
    unsigned char* ws = launder(PP(ws)); tid = vlaunder(wave * 64 + lane_id_()); lane = tid & 63;
    const bf16_t* GQ = (const bf16_t*)(ws + WS_GQ); const bf16_t* GK = (const bf16_t*)(ws + WS_GK); const bf16_t* GV = (const bf16_t*)(ws + WS_GV);
    bf16_t* GR = (bf16_t*)(ws + WS_GR); const float* GD = (const float*)(ws + WS_GDOWN); float* UPD = (float*)(ws + WS_UPD); float* DEC = (float*)(ws + WS_DEC);
    LAS float* sCum = (LAS float*)lds;
    LAS float* sTot = (LAS float*)(lds + 16384);
    LAS bf16_t* sQD = (LAS bf16_t*)(lds + 18432);
    LAS bf16_t* sKI = (LAS bf16_t*)(lds + 27648);
    LAS bf16_t* sKEt = (LAS bf16_t*)(lds + 36864);
    LAS bf16_t* sVt = (LAS bf16_t*)(lds + 46080);
    LAS bf16_t* sAT = (LAS bf16_t*)(lds + 64512);
    LAS bf16_t* sSt = (LAS bf16_t*)(lds + 73728);
    LAS float* sSS = (LAS float*)(lds + 92160);
    const int r = lane & 15, gq = lane >> 4;
    const float* wgup = launder(PP(gla_w_gup)) + l * 16 * 256; const float* bgate = launder(PP(gla_b_gate)) + l * 256; const float* ng = launder(PP(gla_norm_g)) + l * 128;
    for (int u = blockIdx.x; u < BATCH * 4 * 64; u += gridDim.x) {
        const int b = u >> 8, h = (u >> 6) & 3, n = u & 63;
        const size_t r0 = (size_t)b * SEQ + n * 64;
        const int t_ = tid >> 3, k8 = (tid & 7) * 8;
        const u32x4 kw = *(const u32x4*)(GK + (r0 + t_) * 256 + h * 64 + k8);
        const u32x4 gv0 = *(const u32x4*)(GV + (r0 + (tid >> 3)) * 512 + h * 128 + 16 * (tid & 7)), gv1 = *(const u32x4*)(GV + (r0 + (tid >> 3)) * 512 + h * 128 + 16 * (tid & 7) + 8);
        u32x4 qw = (u32x4){0u, 0u, 0u, 0u}; f32x4 st0 = (f32x4){0.f, 0.f, 0.f, 0.f}, st1 = st0, st2 = st0, st3 = st0; bf16_t gg[4][4];
        if (PASS_C) {
            qw = *(const u32x4*)(GQ + (r0 + t_) * 256 + h * 64 + k8);
            const f32x4* sp = (const f32x4*)(UPD + ((size_t)u * 128 + (tid >> 2)) * 64 + (tid & 3) * 16); st0 = sp[0]; st1 = sp[1]; st2 = sp[2]; st3 = sp[3];
#pragma unroll
            for (int j = 0; j < 4; ++j)
#pragma unroll
                for (int i = 0; i < 4; ++i) gg[j][i] = GR[(r0 + 16 * (wave & 3) + 4 * gq + j) * 512 + h * 128 + 16 * (4 * (wave >> 2) + i) + r];
        }
        {
            const f32x4* gdp = (const f32x4*)(GD + (r0 + t_) * 16);
            const f32x4 g0 = gdp[0], g1 = gdp[1], g2 = gdp[2], g3 = gdp[3];
            const float gd[16] = {g0[0], g0[1], g0[2], g0[3], g1[0], g1[1], g1[2], g1[3], g2[0], g2[1], g2[2], g2[3], g3[0], g3[1], g3[2], g3[3]};
            f32x4 a0 = *(const f32x4*)(bgate + h * 64 + k8), a1 = *(const f32x4*)(bgate + h * 64 + k8 + 4);
#pragma unroll
            for (int rr = 0; rr < 16; ++rr) { const f32x4 w0 = *(const f32x4*)(wgup + rr * 256 + h * 64 + k8), w1 = *(const f32x4*)(wgup + rr * 256 + h * 64 + k8 + 4); a0 += w0 * gd[rr]; a1 += w1 * gd[rr]; }
            f32x4 o0, o1;
#pragma unroll
            for (int e = 0; e < 4; ++e) { o0[e] = logsig_f(a0[e]) * 0.0625f; o1[e] = logsig_f(a1[e]) * 0.0625f; }
            *(LAS f32x4*)(sCum + t_ * 64 + k8) = o0; *(LAS f32x4*)(sCum + t_ * 64 + k8 + 4) = o1;
        }
        __syncthreads();
        {
            const int k = tid & 63, seg = tid >> 6; float run = 0.f;
#pragma unroll
            for (int i = 0; i < 8; ++i) { run += sCum[(8 * seg + i) * 64 + k]; sCum[(8 * seg + i) * 64 + k] = run; }
            sTot[seg * 64 + k] = run;
            __syncthreads();
            float pre = 0.f;
#pragma unroll
            for (int s = 0; s < 7; ++s) pre += (s < seg) ? sTot[s * 64 + k] : 0.f;
#pragma unroll
            for (int i = 0; i < 8; ++i) sCum[(8 * seg + i) * 64 + k] += pre;
        }
        __syncthreads();
        {
            const f32x4 c0 = *(const LAS f32x4*)(sCum + t_ * 64 + k8), c1 = *(const LAS f32x4*)(sCum + t_ * 64 + k8 + 4);
            const f32x4 e0 = *(const LAS f32x4*)(sCum + 63 * 64 + k8), e1 = *(const LAS f32x4*)(sCum + 63 * 64 + k8 + 4);
            const float kk[8] = {bflo(kw.x), bfhi(kw.x), bflo(kw.y), bfhi(kw.y), bflo(kw.z), bfhi(kw.z), bflo(kw.w), bfhi(kw.w)};
            const float cm[8] = {c0[0], c0[1], c0[2], c0[3], c1[0], c1[1], c1[2], c1[3]};
            const float ce[8] = {e0[0], e0[1], e0[2], e0[3], e1[0], e1[1], e1[2], e1[3]};
            if (PASS_C) {
                const float qq[8] = {bflo(qw.x), bfhi(qw.x), bflo(qw.y), bfhi(qw.y), bflo(qw.z), bfhi(qw.z), bflo(qw.w), bfhi(qw.w)};
                f32x4 qa, qb, ka, kb;
#pragma unroll
                for (int e = 0; e < 4; ++e) { qa[e] = qq[e] * 0.125f * __expf(cm[e]); qb[e] = qq[e + 4] * 0.125f * __expf(cm[e + 4]); ka[e] = kk[e] * __expf(-cm[e]); kb[e] = kk[e + 4] * __expf(-cm[e + 4]); }
                *(LAS bf16x8*)(sQD + t_ * 72 + k8) = pack8(qa, qb); *(LAS bf16x8*)(sKI + t_ * 72 + k8) = pack8(ka, kb);
                const int dv = tid >> 2, kq = (tid & 3) * 16;
                *(LAS bf16x8*)(sSt + dv * 72 + kq) = pack8(st0, st1); *(LAS bf16x8*)(sSt + dv * 72 + kq + 8) = pack8(st2, st3);
            } else {
#pragma unroll
                for (int e = 0; e < 8; ++e) sKEt[(k8 + e) * 72 + t_] = f2bf(kk[e] * __expf(ce[e] - cm[e]));
                if (t_ == 63) {
#pragma unroll
                    for (int e = 0; e < 8; ++e) DEC[(size_t)u * 64 + k8 + e] = __expf(ce[e]);
                }
            }
            const int s = tid >> 3, c = tid & 7;
            const u32x4 v0 = gv0, v1 = gv1;
            LAS bf16_t* vd = sVt + (16 * c) * 72 + s;
            vd[0 * 72] = (bf16_t)(v0.x & 0xffff); vd[1 * 72] = (bf16_t)(v0.x >> 16); vd[2 * 72] = (bf16_t)(v0.y & 0xffff); vd[3 * 72] = (bf16_t)(v0.y >> 16);
            vd[4 * 72] = (bf16_t)(v0.z & 0xffff); vd[5 * 72] = (bf16_t)(v0.z >> 16); vd[6 * 72] = (bf16_t)(v0.w & 0xffff); vd[7 * 72] = (bf16_t)(v0.w >> 16);
            vd[8 * 72] = (bf16_t)(v1.x & 0xffff); vd[9 * 72] = (bf16_t)(v1.x >> 16); vd[10 * 72] = (bf16_t)(v1.y & 0xffff); vd[11 * 72] = (bf16_t)(v1.y >> 16);
            vd[12 * 72] = (bf16_t)(v1.z & 0xffff); vd[13 * 72] = (bf16_t)(v1.z >> 16); vd[14 * 72] = (bf16_t)(v1.w & 0xffff); vd[15 * 72] = (bf16_t)(v1.w >> 16);
        }
        __syncthreads();
        if (!PASS_C) {
#pragma unroll
            for (int kb = 0; kb < 4; ++kb) { f32x4 acc = (f32x4){0.f, 0.f, 0.f, 0.f};
#pragma unroll
                for (int ks = 0; ks < 2; ++ks) { const bf16x8 a = *(const LAS bf16x8*)(sKEt + (16 * kb + r) * 72 + 32 * ks + 8 * gq); const bf16x8 bb = *(const LAS bf16x8*)(sVt + (16 * wave + r) * 72 + 32 * ks + 8 * gq); acc = mfma16(a, bb, acc); }
                *(f32x4*)(UPD + ((size_t)u * 128 + 16 * wave + r) * 64 + 16 * kb + 4 * gq) = acc; }
        } else {
            {
                const int tb = wave >> 1;
#pragma unroll
                for (int i = 0; i < 2; ++i) { const int sb = 2 * (wave & 1) + i;
                    f32x4 acc = (f32x4){0.f, 0.f, 0.f, 0.f};
                    if (sb <= tb) {
#pragma unroll
                        for (int ks = 0; ks < 2; ++ks) { const bf16x8 a = *(const LAS bf16x8*)(sQD + (16 * tb + r) * 72 + 32 * ks + 8 * gq); const bf16x8 bb = *(const LAS bf16x8*)(sKI + (16 * sb + r) * 72 + 32 * ks + 8 * gq); acc = mfma16(a, bb, acc); }
                    }
#pragma unroll
                    for (int j = 0; j < 4; ++j) { const int tt = 16 * tb + 4 * gq + j, ss = 16 * sb + r; sAT[tt * 72 + ss] = f2bf((sb <= tb && ss <= tt) ? acc[j] : 0.f); } }
            }
            __syncthreads();
            const int tb = wave & 3, hv = wave >> 2;
            f32x4 acc[4];
#pragma unroll
            for (int i = 0; i < 4; ++i) { acc[i] = (f32x4){0.f, 0.f, 0.f, 0.f}; const int dvb = 4 * hv + i;
#pragma unroll
                for (int ks = 0; ks < 2; ++ks) {
                    const bf16x8 a1 = *(const LAS bf16x8*)(sAT + (16 * tb + r) * 72 + 32 * ks + 8 * gq); const bf16x8 b1 = *(const LAS bf16x8*)(sVt + (16 * dvb + r) * 72 + 32 * ks + 8 * gq); acc[i] = mfma16(a1, b1, acc[i]);
                    const bf16x8 a2 = *(const LAS bf16x8*)(sQD + (16 * tb + r) * 72 + 32 * ks + 8 * gq); const bf16x8 b2 = *(const LAS bf16x8*)(sSt + (16 * dvb + r) * 72 + 32 * ks + 8 * gq); acc[i] = mfma16(a2, b2, acc[i]);
                } }
            float ss[4];
#pragma unroll
            for (int j = 0; j < 4; ++j) { float q = 0.f;
#pragma unroll
                for (int i = 0; i < 4; ++i) q += acc[i][j] * acc[i][j];
                q += __shfl_xor(q, 1); q += __shfl_xor(q, 2); q += __shfl_xor(q, 4); q += __shfl_xor(q, 8); ss[j] = q; }
            if (r == 0) {
#pragma unroll
                for (int j = 0; j < 4; ++j) sSS[hv * 64 + 16 * tb + 4 * gq + j] = ss[j];
            }
            __syncthreads();
#pragma unroll
            for (int j = 0; j < 4; ++j) { const int tt = 16 * tb + 4 * gq + j; const float rs = __builtin_amdgcn_rsqf((sSS[tt] + sSS[64 + tt]) * (1.f / 128.f) + EPS);
#pragma unroll
                for (int i = 0; i < 4; ++i) { const int dv = 16 * (4 * hv + i) + r; GR[(r0 + tt) * 512 + h * 128 + dv] = f2bf(acc[i][j] * rs * ng[dv] * bf2f(gg[j][i])); } }
        }
        __syncthreads();
    }
}
__device__ __forceinline__ void gla_scan(unsigned char* ws, int wave, int ngt) {
    ws = launder(ws); const int gtid = blockIdx.x * 512 + vlaunder(wave * 64 + lane_id_());
    float* UPD = (float*)(ws + WS_UPD); const float* DEC = (const float*)(ws + WS_DEC);
    for (int e = gtid; e < 32 * 8192; e += ngt) {
        const int bh = e >> 13, rem = e & 8191, dk = rem & 63; float S = 0.f;
#pragma unroll 1
        for (int n0 = 0; n0 < 64; n0 += 16) {
            float uv[16], dv[16];
#pragma unroll
            for (int i = 0; i < 16; ++i) { uv[i] = UPD[((size_t)(bh * 64 + n0 + i)) * 8192 + rem]; dv[i] = DEC[(bh * 64 + n0 + i) * 64 + dk]; }
#pragma unroll
            for (int i = 0; i < 16; ++i) { UPD[((size_t)(bh * 64 + n0 + i)) * 8192 + rem] = S; S = dv[i] * S + uv[i]; }
        }
    }
}
__device__ __forceinline__ void conv_fix(const Params& p, int l, int wave, int ngt) {
    unsigned char* ws = launder(PP(ws)); const int gtid = blockIdx.x * 512 + vlaunder(wave * 64 + lane_id_());
    const float* head = (const float*)(ws + WS_HEAD); const float* tail = (const float*)(ws + WS_TAIL); bf16_t* act = (bf16_t*)(ws + WS_ACT);
    const float* cw = launder(PP(ffn_conv_w)) + (size_t)l * 3 * DFF2; const float* cb = launder(PP(ffn_conv_b)) + (size_t)l * DFF2;
    for (int e = gtid; e < 128 * DFF; e += ngt) {
        const int pm = e / DFF, c = e % DFF, j = c >> 7, cc = c & 127; const int pa = 256 * j + cc, pu = pa + 128;
        const bool first = (pm & 15) == 0;
        const float ta0 = first ? 0.f : tail[((size_t)(pm - 1) * 2 + 0) * DFF2 + pa], ta1 = first ? 0.f : tail[((size_t)(pm - 1) * 2 + 1) * DFF2 + pa];
        const float tu0 = first ? 0.f : tail[((size_t)(pm - 1) * 2 + 0) * DFF2 + pu], tu1 = first ? 0.f : tail[((size_t)(pm - 1) * 2 + 1) * DFF2 + pu];
        const float ha0 = head[((size_t)pm * 2 + 0) * DFF2 + pa], ha1 = head[((size_t)pm * 2 + 1) * DFF2 + pa];
        const float hu0 = head[((size_t)pm * 2 + 0) * DFF2 + pu], hu1 = head[((size_t)pm * 2 + 1) * DFF2 + pu];
        const float wa0 = cw[c], wa1 = cw[DFF2 + c], wa2 = cw[2 * DFF2 + c], ba = cb[c];
        const float wu0 = cw[DFF + c], wu1 = cw[DFF2 + DFF + c], wu2 = cw[2 * DFF2 + DFF + c], bu = cb[DFF + c];
        const float ca0 = ba + wa0 * ta0 + wa1 * ta1 + wa2 * ha0, cu0 = bu + wu0 * tu0 + wu1 * tu1 + wu2 * hu0;
        const float ca1 = ba + wa0 * ta1 + wa1 * ha0 + wa2 * ha1, cu1 = bu + wu0 * tu1 + wu1 * hu0 + wu2 * hu1;
        act[((size_t)pm * 256 + 0) * DFF + c] = f2bf(gelu_tanh_f(ca0) * cu0);
        act[((size_t)pm * 256 + 1) * DFF + c] = f2bf(gelu_tanh_f(ca1) * cu1);
    }
}

#define XB_TMO      128
#define XB_XCNT(j)  (256  + 64 * (j))
#define XB_XSUB(j)  (1280 + 64 * (j))
#define XB_XGEN(j)  (2304 + 64 * (j))
#define XB_TOP      3328
#define XB_TOPGEN   3392
#define XCD_BAR_WORDS 3456
#define XB_SPIN_CAP (1u << 18)

__device__ __forceinline__ unsigned xb_ld(unsigned* p)              { return __hip_atomic_load(p, __ATOMIC_RELAXED, __HIP_MEMORY_SCOPE_AGENT); }
__device__ __forceinline__ unsigned xb_add(unsigned* p, unsigned v) { return __hip_atomic_fetch_add(p, v, __ATOMIC_RELAXED, __HIP_MEMORY_SCOPE_AGENT); }
__device__ __forceinline__ unsigned xb_xcc_id() { return (unsigned)__builtin_amdgcn_s_getreg((3 << 11) | 20) & 0xFu; }
#define XB_SPIN(cond, bar) do { unsigned _sp = 0; while (cond) { __builtin_amdgcn_s_sleep(1); \
    if ((++_sp & 255u) == 0u) { if (xb_ld(&(bar)[XB_TMO])) break; if (_sp > XB_SPIN_CAP) { atomicAdd(&(bar)[XB_TMO], 1u); break; } } } } while (0)

struct XcdBarrier {
    unsigned* bar; unsigned x;
    volatile LAS unsigned* st;
};

__device__ __forceinline__ XcdBarrier xcd_barrier_post(unsigned* bar, volatile LAS unsigned* st, int wave_) {
    XcdBarrier b; b.bar = bar; b.x = xb_xcc_id(); b.st = st;
    if (wave_ == 0 && lane_id_() == 0) (void)xb_add(&bar[XB_XCNT(b.x)], 1u);
    return b;
}
__device__ __forceinline__ void xcd_barrier_complete(unsigned* bar, unsigned x, unsigned& nloc, unsigned& nx) {
    const unsigned G = gridDim.x * gridDim.y * gridDim.z;
    unsigned sum, cnt, mine, sp = 0u;
    for (;;) {
        sum = 0u; cnt = 0u; mine = 0u;
#pragma unroll
        for (unsigned j = 0; j < 16; ++j) { const unsigned c = xb_ld(&bar[XB_XCNT(j)]); sum += c; cnt += (c > 0u) ? 1u : 0u; mine = (j == x) ? c : mine; }
        if (sum == G) break;
        __builtin_amdgcn_s_sleep(1);
        if ((++sp & 255u) == 0u) { if (xb_ld(&bar[XB_TMO])) break; if (sp > XB_SPIN_CAP) { atomicAdd(&bar[XB_TMO], 1u); break; } }
    }
    nloc = mine > 0u ? mine : 1u; nx = cnt > 0u ? cnt : 1u;
}

__device__ __forceinline__ void xcd_barrier(const XcdBarrier& b, int wave_) {
    asm volatile("s_waitcnt vmcnt(0)" ::: "memory");
    __syncthreads();
    if (wave_ == 0 && lane_id_() == 0) {
        unsigned* bar = b.bar;
        __builtin_amdgcn_s_waitcnt(0);
        unsigned nloc = b.st[0], nx = b.st[1];
        if (nloc == 0u) { xcd_barrier_complete(bar, b.x, nloc, nx); b.st[0] = nloc; b.st[1] = nx; }
        const unsigned old = xb_add(&bar[XB_XSUB(b.x)], 1u);
        const unsigned gen = old / nloc;
        if (old + 1u == (gen + 1u) * nloc) {
            __builtin_amdgcn_fence(__ATOMIC_RELEASE, "agent");
            asm volatile("s_waitcnt vmcnt(0)" ::: "memory");
            const unsigned og = xb_add(&bar[XB_TOP], 1u);
            const unsigned tg = og / nx;
            if (og + 1u == (tg + 1u) * nx) xb_add(&bar[XB_TOPGEN], 1u);
            else XB_SPIN(xb_ld(&bar[XB_TOPGEN]) == tg, bar);
            __builtin_amdgcn_fence(__ATOMIC_ACQUIRE, "agent");
            xb_add(&bar[XB_XGEN(b.x)], 1u);
            asm volatile("s_waitcnt vmcnt(0)" ::: "memory");
        } else {
            XB_SPIN(xb_ld(&bar[XB_XGEN(b.x)]) == gen, bar);
            __builtin_amdgcn_fence(__ATOMIC_ACQUIRE, "agent");
            asm volatile("s_waitcnt vmcnt(0)" ::: "memory");
        }
    }
    __syncthreads();
}
#define CG_SYNC() do { asm volatile("s_waitcnt vmcnt(0) lgkmcnt(0)" ::: "memory"); grid.sync(); } while (0)
#define GRID_SYNC() do { for (int rs_ = 0; rs_ < REP_SYNC; ++rs_) { xcd_barrier(xbar, wave); } } while (0)
#define TSTAMP(k) do { if (TS_PHASE >= 0) { const unsigned long long now_ = __builtin_amdgcn_s_memrealtime(); if ((k) == TS_PHASE) tsel += now_ - tprev; tprev = now_; } } while (0)
#ifndef DBG_STOP
#define DBG_STOP 0
#endif
#ifndef REP_GEMM
#define REP_GEMM 1
#endif
#ifndef REP_SYNC
#define REP_SYNC 1
#endif
#ifndef PROBE
#define PROBE 0
#endif
#ifndef TS_PHASE
#define TS_PHASE -1
#endif
#ifndef G2_STAGGER
#define G2_STAGGER 800
#endif
__device__ __forceinline__ void dbg_dump(float* out, const bf16_t* a, const bf16_t* b, const bf16_t* c, int lda) {
    for (size_t e = (size_t)blockIdx.x * 512 + threadIdx.x; e < (size_t)MTOK * DM; e += (size_t)gridDim.x * 512) {
        const size_t m = e >> 10; const int col = (lda == 3072) ? (int)(e & 1023) + 1024 * (int)(m % 3) : (int)(e & 1023) % lda; float v = bf2f(a[m * lda + col]); if (b) v += bf2f(b[m * lda + col]); if (c) v += bf2f(c[m * lda + col]); out[e] = v; }
}
__global__ void __launch_bounds__(512, 2) mega_fwd(Params p) {
    extern __shared__ __attribute__((aligned(16))) unsigned char lds_raw[];
    LAS unsigned char* lds = (LAS unsigned char*)lds_raw;
    cg::grid_group grid = cg::this_grid();
    const int tid = 0, lane = 0, wave = __builtin_amdgcn_readfirstlane((int)threadIdx.x >> 6);
    const int G = gridDim.x, gw = blockIdx.x * 8 + wave, ngw = G * 8, ngt = G * 512;
    unsigned char* ws = PP(ws);
    bf16_t* XN = (bf16_t*)(ws + WS_XN);
    volatile LAS unsigned* misc = (volatile LAS unsigned*)(lds + MISC_OFF);
    if (wave == 0 && lane_id_() < 4) misc[lane_id_()] = 0u;
    __syncthreads();
    const XcdBarrier xbar = xcd_barrier_post((unsigned*)(ws + WS_BAR), misc, wave);

    unsigned long long tprev = (TS_PHASE >= 0) ? __builtin_amdgcn_s_memrealtime() : 0ull, tsel = 0ull;
    convert_weights(p, 0, lds, gw, ngw, wave, lane);
    if (PROBE & 1) convert_weights(p, 0, lds, gw, ngw, wave, lane);
    row_phase<false, false, true, false, false>(PP(x), nullptr, nullptr, nullptr, PP(mix_pre_g), XN, gw, ngw, lane);
    CG_SYNC();
    TSTAMP(0);
    if (DBG_STOP == 8) {
        {
            unsigned char* ws = launder(PP(ws)); bf16_t* XN = (bf16_t*)(ws + WS_XN);
            pg8::Gemm g{XN, (const bf16_t*)(ws + WS_WIN) + (size_t)4352 * 1024, 1024, 1024, 1024, 0, 0}; pg8::StaticOrder S; S.init(MTOK, 3072, G, (int)blockIdx.x);
            pg8::EpiGates E{(bf16_t*)(ws + WS_GATES)}; pg8::gemm_phase(lds, g, S, E, wave);
        }
        GRID_SYNC();
        TSTAMP(1);
        dbg_dump(PP(out), (const bf16_t*)(ws + WS_GATES), nullptr, nullptr, 3072); return;
    }
#pragma unroll 1
    for (int l = 0; l < 2; ++l) {
        {
            unsigned char* ws = launder(PP(ws)); bf16_t* XN = (bf16_t*)(ws + WS_XN);
            pg8::Gemm g{XN, (const bf16_t*)(ws + WS_WIN), 1024, 1024, 1024, 0, 0}; pg8::StaticOrder S; S.init(MTOK, 4352, G, (int)blockIdx.x);
            pg8::EpiG1 E{ws}; for (int rep_ = 0; rep_ < REP_GEMM; ++rep_) pg8::gemm_phase(lds, g, S, E, wave);
        }
        GRID_SYNC();
        TSTAMP(2);
        if (DBG_STOP == 1) { dbg_dump(PP(out), (const bf16_t*)(ws + WS_KA), (const bf16_t*)(ws + WS_SV), (const bf16_t*)(ws + WS_GV), 512); return; }
        if (PROBE & 16) sb_phase(lds, ws, tid, wave, lane, 428 * MiB);
        sb_phase(lds, ws, tid, wave, lane);
        TSTAMP(15);
        sg_phase(lds, p, l, tid, wave, lane);
        TSTAMP(16);
        gla_phase<false>(lds, p, l, tid, wave, lane);
        if (PROBE & 4) gla_phase<false>(lds, p, l, tid, wave, lane);
        GRID_SYNC();
        TSTAMP(3);
        gla_scan(ws, wave, ngt);
        GRID_SYNC();
        TSTAMP(4);
        gla_phase<true>(lds, p, l, tid, wave, lane);
        GRID_SYNC();
        TSTAMP(5);
        if (DBG_STOP == 2) { dbg_dump(PP(out), (const bf16_t*)(ws + WS_QA), (const bf16_t*)(ws + WS_U), (const bf16_t*)(ws + WS_GR), 512); return; }
        {
            unsigned char* ws = launder(PP(ws)); bf16_t* XN = (bf16_t*)(ws + WS_XN);
            pg8::Gemm g{XN, (const bf16_t*)(ws + WS_WIN) + (size_t)4352 * 1024, 1024, 1024, 1024, 0, 0}; pg8::StaticOrder S; S.init(MTOK, 3072, G, (int)blockIdx.x);
            pg8::EpiGates E{(bf16_t*)(ws + WS_GATES)}; for (int rep_ = 0; rep_ < REP_GEMM; ++rep_) pg8::gemm_phase(lds, g, S, E, wave);
        }
        GRID_SYNC();
        TSTAMP(6);
        if (DBG_STOP == 7) { dbg_dump(PP(out), (const bf16_t*)(ws + WS_GATES), nullptr, nullptr, 3072); return; }
        {
            unsigned char* ws = launder(PP(ws)); bf16_t* XN = (bf16_t*)(ws + WS_XN);
            pg8::Gemm g{(const bf16_t*)(ws + WS_QA), (const bf16_t*)(ws + WS_WP), 1536, 512, 1536, 0, (size_t)(32 * MiB)}; pg8::StaticOrder S; S.init(MTOK, 1024, G, (int)blockIdx.x);
            pg8::EpiMerge3 E{(const bf16_t*)(ws + WS_GATES), XN};
            pg8::gemm_merge_phase(lds, g, S, E, wave);
        }
        GRID_SYNC();
        TSTAMP(7);
        if (DBG_STOP == 3) { dbg_dump(PP(out), (const bf16_t*)(ws + WS_XN), nullptr, nullptr, 1024); return; }
        {
            unsigned char* ws = launder(PP(ws)); bf16_t* XN = (bf16_t*)(ws + WS_XN);
            pg8::Gemm g{XN, (const bf16_t*)(ws + WS_WOUT), 1024, 1024, 1024, 0, 0}; pg8::StaticOrder S; S.init(MTOK, 1024, G, (int)blockIdx.x);
            pg8::EpiF32 E{(bf16_t*)(ws + WS_Y32)}; for (int rep_ = 0; rep_ < REP_GEMM; ++rep_) pg8::gemm_phase(lds, g, S, E, wave);
        }
        GRID_SYNC();
        TSTAMP(8);
        if (l == 0) row_phase<true, true, true, false, true>(PP(x), (const bf16_t*)(ws + WS_Y32), PP(mix_post_g), ws + WS_HB, PP(ffn_pre_g), XN, gw, ngw, lane);
        else row_phase<true, true, true, true, true>(ws + WS_HB, (const bf16_t*)(ws + WS_Y32), PP(mix_post_g) + DM, ws + WS_HB, PP(ffn_pre_g) + DM, XN, gw, ngw, lane);
        GRID_SYNC();
        TSTAMP(9);
        if (DBG_STOP == 4) return;
        {
            unsigned char* ws = launder(PP(ws)); bf16_t* XN = (bf16_t*)(ws + WS_XN);
            pg8::Gemm g{XN, (const bf16_t*)(ws + WS_WUP), 1024, 1024, 1024, 0, 0}; pg8::StaticOrder S; S.init(MTOK, DFF2, G, (int)blockIdx.x);
            pg8::EpiConv E{launder(PP(ffn_conv_w)) + (size_t)l * 3 * DFF2, launder(PP(ffn_conv_b)) + (size_t)l * DFF2, (bf16_t*)(ws + WS_ACT), (float*)(ws + WS_HEAD), (float*)(ws + WS_TAIL)};
            for (int rep_ = 0; rep_ < REP_GEMM; ++rep_) pg8::gemm_phase(lds, g, S, E, wave);
        }
        GRID_SYNC();
        TSTAMP(10);
        conv_fix(p, l, wave, ngt);
        GRID_SYNC();
        TSTAMP(11);
        if (DBG_STOP == 5) { dbg_dump(PP(out), (const bf16_t*)(ws + WS_ACT), nullptr, nullptr, 1024); return; }
        {
            unsigned char* ws = launder(PP(ws));
            pg8::Gemm g{(const bf16_t*)(ws + WS_ACT), (const bf16_t*)(ws + WS_WDN), DFF, DFF, DFF, 0, 0}; pg8::StaticOrder S; S.init(MTOK, 1024, G, (int)blockIdx.x);
            pg8::EpiF32 E{(bf16_t*)(ws + WS_Y32B)}; for (int rep_ = 0; rep_ < REP_GEMM; ++rep_) pg8::gemm_phase(lds, g, S, E, wave);
        }
        GRID_SYNC();
        TSTAMP(12);
        if (l == 0) {
            row_phase<true, true, true, true, true>(ws + WS_HB, (const bf16_t*)(ws + WS_Y32B), PP(ffn_post_g), ws + WS_HB, PP(mix_pre_g) + DM, XN, gw, ngw, lane);
            convert_weights(p, 1, lds, gw, ngw, wave, lane);
            if (PROBE & 1) convert_weights(p, 1, lds, gw, ngw, wave, lane);
            GRID_SYNC();
            TSTAMP(13);
            if (DBG_STOP == 6) return;
        } else {
            row_phase<true, true, false, true, false>(ws + WS_HB, (const bf16_t*)(ws + WS_Y32B), PP(ffn_post_g) + DM, PP(out), nullptr, nullptr, gw, ngw, lane);
        }
    }
    if (TS_PHASE >= 0) { TSTAMP(14); if (blockIdx.x == 0 && wave == 0 && lane_id_() == 0) { const unsigned long long t0_ = __builtin_amdgcn_s_memrealtime(); while (__builtin_amdgcn_s_memrealtime() - t0_ < tsel) __builtin_amdgcn_s_sleep(8); } }
}

extern "C" void kernel_launch(void* const* d_in, const int* in_sizes, int n_in, void* d_out, int out_size, void* d_ws, size_t ws_size, hipStream_t stream) {
    static int grid = 0;
    if (grid == 0) {
        if (n_in != 21 || out_size != MTOK * DM || ws_size < WS_END) { fprintf(stderr, "kernel_launch: unexpected shapes (n_in %d, out %d, ws %zu)\n", n_in, out_size, ws_size); grid = -1; return; }
        int dev = 0, cus = 0, per_cu = 0;
        hipGetDevice(&dev); hipDeviceGetAttribute(&cus, hipDeviceAttributeMultiprocessorCount, dev);
        if (hipFuncSetAttribute((const void*)mega_fwd, hipFuncAttributeMaxDynamicSharedMemorySize, LDS_BYTES) != hipSuccess) { fprintf(stderr, "kernel_launch: hipFuncSetAttribute failed\n"); grid = -1; return; }
        if (hipOccupancyMaxActiveBlocksPerMultiprocessor(&per_cu, (const void*)mega_fwd, 512, LDS_BYTES) != hipSuccess || per_cu < 1) { fprintf(stderr, "kernel_launch: occupancy query says %d blocks/CU\n", per_cu); per_cu = 1; }
        (void)hipGetLastError();
        if (cus > 512) cus = 512;
        grid = cus;
    }
    if (grid < 0) return;
    Params p{};
    const float** f = (const float**)&p;
    for (int i = 0; i < 21; ++i) f[i] = (const float*)d_in[i];
    p.out = (float*)d_out; p.ws = (unsigned char*)d_ws;
    (void)hipMemsetAsync(d_ws, 0, 65536, stream);
    void* args[] = {&p};
    hipError_t e = hipLaunchCooperativeKernel((const void*)mega_fwd, dim3(grid), dim3(512), args, LDS_BYTES, stream);
    if (e != hipSuccess) fprintf(stderr, "cooperative launch failed: %s (grid %d)\n", hipGetErrorString(e), grid);
}
```
